# Optimizing an MI355X kernel written in HIP

```python
import math
import jax, jax.numpy as jnp
from jax import lax
import numpy as np

D_MODEL = 2048
BATCH = 4
SEQ = 8192
DEPTH = 1
DEC_BATCH = 8
DEC_SEQ = 4096
PAST_LEN = 128

D_POOL = D_MODEL // 2
POOL_WINDOWS = (2, 4, 8, 16)
N_POOL_GROUPS = len(POOL_WINDOWS)
POOL_GROUP = D_POOL // N_POOL_GROUPS
D_HYENA = D_MODEL // 2
HYENA_ORDER = 2
SHORT_CONV = 3
FILTER_EMB = 33
FILTER_BANDS = (FILTER_EMB - 1) // 2
FILTER_HIDDEN = 64
DECAY_TARGET = 1e-2
FAST_DECAY_PCT = 0.3
SLOW_DECAY_PCT = 1.5
D_FF = int(math.ceil(8 * D_MODEL / 3 / 256)) * 256
D_IN = D_POOL + (HYENA_ORDER + 1) * D_HYENA + 2 * D_MODEL
EPS = 1e-6

kernel_name = "gated_pool_hyena_encoder"


def _rmsnorm(x, g):
    xf = x.astype(jnp.float32)
    y = xf * lax.rsqrt(jnp.mean(xf * xf, axis=-1, keepdims=True) + EPS)
    return (y * g.astype(jnp.float32)).astype(x.dtype)


def _centred_mean_minus_self(u, w):
    L = u.shape[1]
    cs = jnp.concatenate([jnp.zeros_like(u[:, :1]), jnp.cumsum(u, axis=1)], axis=1)
    t = jnp.arange(L)
    lo = jnp.clip(t - w // 2, 0, L)
    hi = jnp.clip(t + (w - w // 2), 0, L)
    cnt = (hi - lo).astype(jnp.float32)
    return (cs[:, hi] - cs[:, lo]) / cnt[None, :, None] - u


def _pool_mixer(u, pool_w, pool_scale):
    B, L, _ = u.shape
    ug = u.astype(jnp.float32).reshape(B, L, N_POOL_GROUPS, POOL_GROUP)
    pooled = jnp.stack(
        [_centred_mean_minus_self(ug[:, :, g], w) for g, w in enumerate(POOL_WINDOWS)], axis=2
    )
    mixed = jnp.einsum("blgc,gcd->blgd", pooled.astype(u.dtype), pool_w)
    return mixed.reshape(B, L, D_POOL) * pool_scale


def _short_conv3(u, w, b):
    up = jnp.pad(u, ((0, 0), (1, 1), (0, 0)))
    return up[:, :-2] * w[0] + up[:, 1:-1] * w[1] + up[:, 2:] * w[2] + b


def _hyena_filters(L, w1, b1, f1, w2, b2, f2, w3):
    f32 = jnp.float32
    t = jnp.linspace(0.0, 1.0, L, dtype=f32)[:, None]
    wt = 2.0 * math.pi * jnp.arange(L, dtype=f32)[:, None] / L
    bands = jnp.linspace(1e-4, FILTER_BANDS - 1, FILTER_BANDS, dtype=f32)[None, :]
    z = jnp.concatenate([t, jnp.cos(bands * wt), -jnp.sin(bands * wt)], axis=-1)
    h = jnp.sin(f1.astype(f32) * (z @ w1.astype(f32) + b1.astype(f32)))
    h = jnp.sin(f2.astype(f32) * (h @ w2.astype(f32) + b2.astype(f32)))
    h = (h @ w3.astype(f32)).reshape(L, HYENA_ORDER, 2, D_HYENA)
    max_decay = math.log(DECAY_TARGET) / FAST_DECAY_PCT
    min_decay = math.log(DECAY_TARGET) / SLOW_DECAY_PCT
    deltas = jnp.abs(jnp.linspace(min_decay, max_decay, D_HYENA, dtype=f32))
    h = h * jnp.exp(-t * deltas)[:, None, None, :]
    fwd, bwd = h[:, :, 0], h[:, :, 1]
    two = jnp.concatenate(
        [fwd[:1] + bwd[:1], fwd[1:], jnp.zeros_like(fwd[:1]), bwd[:0:-1]], axis=0
    )
    two = two * lax.rsqrt(jnp.sum(two * two, axis=0, keepdims=True) + EPS)
    return jnp.moveaxis(two, 1, 0)


def _long_conv(z, filt_f):
    L = z.shape[1]
    zf = jnp.fft.rfft(z, n=2 * L, axis=1)
    return jnp.fft.irfft(zf * filt_f[None], n=2 * L, axis=1)[:, :L]


def _hyena_mixer(u, conv_w, conv_b, w1, b1, f1, w2, b2, f2, w3, hyena_bias):
    dt = u.dtype
    L = u.shape[1]
    uc = _short_conv3(u, conv_w, conv_b).astype(jnp.float32)
    v, x1, x2 = jnp.split(uc, HYENA_ORDER + 1, axis=-1)
    filt_f = jnp.fft.rfft(_hyena_filters(L, w1, b1, f1, w2, b2, f2, w3), axis=1)
    bias = hyena_bias.astype(jnp.float32)
    z = v
    for o, gate in enumerate((x1, x2)):
        z = gate * (_long_conv(z, filt_f[o]) + bias[o] * z)
    return z.astype(dt)


def _trunk(x, g_mix, w_in, pool_w, pool_scale, conv_w, conv_b, filt_w1, filt_b1, filt_freq1,
           filt_w2, filt_b2, filt_freq2, filt_w3, hyena_bias, w_branch_a, w_branch_b, w_out,
           g_ffn, w_gate, w_up, w_down, g_final):
    s1 = D_POOL
    s2 = s1 + (HYENA_ORDER + 1) * D_HYENA
    s3 = s2 + D_MODEL
    for i in range(DEPTH):
        h = _rmsnorm(x, g_mix[i])
        p = h @ w_in[i]
        u_pool, u_hy, gate_a, gate_b = p[..., :s1], p[..., s1:s2], p[..., s2:s3], p[..., s3:]
        a = _pool_mixer(u_pool, pool_w[i], pool_scale[i])
        b = _hyena_mixer(u_hy, conv_w[i], conv_b[i], filt_w1[i], filt_b1[i], filt_freq1[i],
                         filt_w2[i], filt_b2[i], filt_freq2[i], filt_w3[i], hyena_bias[i])
        merged = (jax.nn.sigmoid(gate_a) * (a @ w_branch_a[i])
                  + jax.nn.sigmoid(gate_b) * (b @ w_branch_b[i]))
        x = x + merged @ w_out[i]
        h = _rmsnorm(x, g_ffn[i])
        x = x + (jax.nn.silu(h @ w_gate[i]) * (h @ w_up[i])) @ w_down[i]
    return _rmsnorm(x, g_final)


def setup_inputs(seed: int = 0) -> dict:
    key = jax.random.key(seed)
    ks = jax.random.split(key, 24)
    f32 = jnp.float32

    def nrm(k, shape, scale):
        return jax.random.normal(k, shape, f32) * scale

    return {
        "x_prompt": nrm(ks[0], (BATCH, SEQ, D_MODEL), 1.0),
        "x_sample": nrm(ks[1], (DEC_BATCH, DEC_SEQ, D_MODEL), 1.0),
        "g_mix": 1.0 + nrm(ks[2], (DEPTH, D_MODEL), 0.02),
        "w_in": nrm(ks[3], (DEPTH, D_MODEL, D_IN), D_MODEL ** -0.5),
        "pool_w": nrm(ks[4], (DEPTH, N_POOL_GROUPS, POOL_GROUP, POOL_GROUP), POOL_GROUP ** -0.5),
        "pool_scale": 1.0 + nrm(ks[5], (DEPTH, D_POOL), 0.02),
        "conv_w": nrm(ks[6], (DEPTH, SHORT_CONV, (HYENA_ORDER + 1) * D_HYENA), SHORT_CONV ** -0.5),
        "conv_b": nrm(ks[7], (DEPTH, (HYENA_ORDER + 1) * D_HYENA), 0.02),
        "filt_w1": nrm(ks[8], (DEPTH, FILTER_EMB, FILTER_HIDDEN), FILTER_EMB ** -0.5),
        "filt_b1": nrm(ks[9], (DEPTH, FILTER_HIDDEN), 0.02),
        "filt_freq1": 1.0 + nrm(ks[10], (DEPTH, FILTER_HIDDEN), 0.02),
        "filt_w2": nrm(ks[11], (DEPTH, FILTER_HIDDEN, FILTER_HIDDEN), FILTER_HIDDEN ** -0.5),
        "filt_b2": nrm(ks[12], (DEPTH, FILTER_HIDDEN), 0.02),
        "filt_freq2": 1.0 + nrm(ks[13], (DEPTH, FILTER_HIDDEN), 0.02),
        "filt_w3": nrm(ks[14], (DEPTH, FILTER_HIDDEN, HYENA_ORDER * 2 * D_HYENA), FILTER_HIDDEN ** -0.5),
        "hyena_bias": nrm(ks[15], (DEPTH, HYENA_ORDER, D_HYENA), 1.0),
        "w_branch_a": nrm(ks[16], (DEPTH, D_POOL, D_MODEL), D_POOL ** -0.5),
        "w_branch_b": nrm(ks[17], (DEPTH, D_HYENA, D_MODEL), D_HYENA ** -0.5),
        "w_out": nrm(ks[18], (DEPTH, D_MODEL, D_MODEL), D_MODEL ** -0.5),
        "g_ffn": 1.0 + nrm(ks[19], (DEPTH, D_MODEL), 0.02),
        "w_gate": nrm(ks[20], (DEPTH, D_MODEL, D_FF), D_MODEL ** -0.5),
        "w_up": nrm(ks[21], (DEPTH, D_MODEL, D_FF), D_MODEL ** -0.5),
        "w_down": nrm(ks[22], (DEPTH, D_FF, D_MODEL), D_FF ** -0.5),
        "g_final": 1.0 + nrm(ks[23], (D_MODEL,), 0.02),
    }


def reference(x_prompt, x_sample, g_mix, w_in, pool_w, pool_scale, conv_w, conv_b, filt_w1, filt_b1,
              filt_freq1, filt_w2, filt_b2, filt_freq2, filt_w3, hyena_bias, w_branch_a, w_branch_b,
              w_out, g_ffn, w_gate, w_up, w_down, g_final):
    y_prompt = _trunk(x_prompt, g_mix, w_in, pool_w, pool_scale, conv_w, conv_b, filt_w1, filt_b1,
                      filt_freq1, filt_w2, filt_b2, filt_freq2, filt_w3, hyena_bias, w_branch_a,
                      w_branch_b, w_out, g_ffn, w_gate, w_up, w_down, g_final)
    y_sample = _trunk(x_sample, g_mix, w_in, pool_w, pool_scale, conv_w, conv_b, filt_w1, filt_b1,
                      filt_freq1, filt_w2, filt_b2, filt_freq2, filt_w3, hyena_bias, w_branch_a,
                      w_branch_b, w_out, g_ffn, w_gate, w_up, w_down, g_final)
    return (y_prompt, y_sample)
```

```cpp
#include <hip/hip_runtime.h>
#include <hip/hip_cooperative_groups.h>
#include <cstdio>
namespace cg = cooperative_groups;

#ifndef MULTI_LAUNCH
#define MULTI_LAUNCH 0
#endif

#ifndef ONLY
#define ONLY -1
#endif
#define EN(x) (ONLY == -1 || ONLY == (x))
#define LAS __attribute__((address_space(3)))
typedef unsigned short bf16_t;
typedef short bf16x8 __attribute__((ext_vector_type(8)));
typedef float f32x4 __attribute__((ext_vector_type(4)));
typedef float f32x2 __attribute__((ext_vector_type(2)));
typedef unsigned u32x4 __attribute__((ext_vector_type(4)));
typedef unsigned u32x2 __attribute__((ext_vector_type(2)));

constexpr int DM = 2048, DFF = 5632, NTG = 32768, NGRP = 2;
constexpr int BM = 256, BK = 64, HALF = 128, HTB = HALF * BK * 2, NXCD = 8, WGM = 4;
constexpr int XPAD_ELEMS = 16384 + 512 * 5;
constexpr int LDS_X_BYTES = XPAD_ELEMS * 8;
constexpr int LDS_BYTES = LDS_X_BYTES + 2048;
constexpr int NPH = 2 + NGRP * 9;

constexpr size_t WS_WIN = 0;
constexpr size_t WS_WPOOL = WS_WIN + (size_t)8192 * 2048 * 2;
constexpr size_t WS_WA = WS_WPOOL + (size_t)1024 * 256 * 2;
constexpr size_t WS_WB = WS_WA + (size_t)2048 * 1024 * 2;
constexpr size_t WS_WO = WS_WB + (size_t)2048 * 1024 * 2;
constexpr size_t WS_WGU = WS_WO + (size_t)2048 * 2048 * 2;
constexpr size_t WS_WD = WS_WGU + (size_t)11264 * 2048 * 2;
constexpr size_t WS_HF8 = WS_WD + (size_t)2048 * 5632 * 2;
constexpr size_t WS_HF4 = WS_HF8 + (size_t)8192 * 64 * 4;
constexpr size_t WS_FS8 = WS_HF4 + (size_t)4096 * 64 * 4;
constexpr size_t WS_FS4 = WS_FS8 + (size_t)1024 * 16384 * 8;
constexpr size_t WS_Z1 = WS_FS4 + (size_t)1024 * 8192 * 8;
constexpr size_t WS_H = WS_Z1 + (size_t)256 * 65536;
constexpr size_t WS_UP = WS_H + (size_t)NTG * 2048 * 2;
constexpr size_t WS_G = WS_UP + (size_t)NTG * 1024 * 2;
constexpr size_t WS_UH = WS_G + (size_t)NTG * 4096 * 2;
constexpr size_t WS_W3T = WS_UH + (size_t)3072 * NTG * 2;
constexpr size_t WS_BAR = WS_W3T + (size_t)1024 * 256 * 2;
constexpr size_t WS_END = WS_BAR + 16384;
constexpr size_t WS_PL = WS_H;
constexpr size_t WS_BT = WS_H + (size_t)NTG * 1024 * 2;
constexpr size_t WS_AB = WS_UH;
constexpr size_t WS_ACT = WS_G;
static_assert((size_t)NTG * DFF * 2 <= (size_t)NTG * 4096 * 2 + (size_t)3072 * NTG * 2, "ACT must fit in G|UH");

struct Params {
    const float* x_prompt; const float* x_sample; const float* g_mix; const float* w_in; const float* pool_w; const float* pool_scale;
    const float* conv_w; const float* conv_b; const float* filt_w1; const float* filt_b1; const float* filt_f1; const float* filt_w2;
    const float* filt_b2; const float* filt_f2; const float* filt_w3; const float* hyena_bias; const float* w_a; const float* w_b;
    const float* w_out; const float* g_ffn; const float* w_gate; const float* w_up; const float* w_down; const float* g_final;
    float* out; unsigned char* ws;
};

struct Ctx { int tid, bid, nblk; };
__device__ __forceinline__ float bf2f(unsigned short b) { return __uint_as_float(((unsigned)b) << 16); }
__device__ __forceinline__ unsigned cvt_pk_bf16(float lo, float hi) { unsigned r; asm volatile("v_cvt_pk_bf16_f32 %0, %1, %2" : "=v"(r) : "v"(lo), "v"(hi)); return r; }
__device__ __forceinline__ float sigmoidf_(float v) { return __builtin_amdgcn_rcpf(1.0f + __builtin_amdgcn_exp2f(-1.4426950408889634f * v)); }
__device__ __forceinline__ float wave_sum(int tid, float v) {
#pragma unroll
    for (int o = 32; o > 0; o >>= 1) v += __int_as_float(__builtin_amdgcn_ds_bpermute(((tid ^ o) & 63) << 2, __float_as_int(v)));
    return v;
}

__device__ __forceinline__ int lds_byte(int r, int c) { const int st = (r >> 4) * 2 + (c >> 5), rr = r & 15, cc = c & 31, ob = rr * 64 + cc * 2; return st * 1024 + (ob ^ (((ob >> 9) & 1) << 5)); }
__device__ __forceinline__ void stage_rc(int b, int& R, int& C) { const int st = b / 1024, sb = b % 1024, swz = sb ^ (((sb >> 9) & 1) << 5); R = (st >> 1) * 16 + swz / 64; C = (st & 1) * 32 + (swz % 64) / 2; }
__device__ __forceinline__ int perm32(int rho) { const int n = rho >> 4, i = rho & 15; return 8 * (i >> 2) + 4 * n + (i & 3); }

struct Unit { int pm, pn; };
struct Gemm { const bf16_t* A; const bf16_t* Bt; int M, N, K, lda, ldb, a_pn_step, wgm; };

struct StaticOrder {
    int nM, nN, nwg, G, c, wgm;
    __device__ __forceinline__ void init(int M, int N, int G_, int c_, int wgm_) { nM = M / BM; nN = N / BM; nwg = nM * nN; G = G_; c = c_; wgm = wgm_; }
    __device__ __forceinline__ bool next(int i, Unit& u) const {
        const long L = (long)i * G + c; if (L >= nwg) return false;
        int wgid = (int)L; { const int q = nwg / NXCD, r = nwg % NXCD, xcd = wgid % NXCD, off = wgid / NXCD; wgid = (xcd < r ? xcd * (q + 1) : r * (q + 1) + (xcd - r) * q) + off; }
        const int nig = wgm * nN, gid = wgid / nig, fm = gid * wgm, gsz = (nM - fm) < wgm ? (nM - fm) : wgm;
        u.pm = fm + ((wgid % nig) % gsz); u.pn = (wgid % nig) / gsz; return true;
    }
};

template <class Epi, bool MID = false>
__device__ __forceinline__ void gemm_phase(const Ctx cx, LAS unsigned char* lds, const Gemm g, const Epi& E) {
    const int tid = cx.tid, wid = __builtin_amdgcn_readfirstlane(tid >> 6), lane = tid & 63, wr = wid >> 2, wc = wid & 3, fr = lane & 15, fq = lane >> 4;
    const int K = g.K, nt = K / BK;
    StaticOrder S; S.init(g.M, g.N, cx.nblk, cx.bid, g.wgm);
    unsigned voffA[2], voffB[2];
#pragma unroll
    for (int i = 0; i < 2; ++i) { int R, C; stage_rc(tid * 16 + i * 8192, R, C); const int Rb = Epi::PERM ? ((R & ~31) + perm32(R & 31)) : R;
        voffA[i] = (unsigned)(R * g.lda + C) * 2u; voffB[i] = (unsigned)(Rb * g.ldb + C) * 2u; }
    const size_t kstep = (size_t)(BK * 2);
    const size_t hstepA = (size_t)HALF * g.lda * 2, hstepB = (size_t)HALF * g.ldb * 2;
    const size_t tstepA = 2 * hstepA, tstepB = 2 * hstepB;
    const unsigned ldsw = (unsigned)wid * 1024u;
    const int aoff = lds_byte(wr * 64 + fr, fq * 8), boff = lds_byte(wc * 32 + fr, fq * 8);
#define PG8_SA(b, h) (((b) * 2 + (h)) * HTB)
#define PG8_SB(b, h) ((4 + (b) * 2 + (h)) * HTB)
#define PG8_STAGE(bufoff, gbase, voff) do { _Pragma("unroll") for (int _i = 0; _i < 2; ++_i) \
        __builtin_amdgcn_global_load_lds((const unsigned*)((const char*)(gbase) + (voff)[_i]), (LAS unsigned*)(lds + (bufoff) + ldsw + _i * 8192), 16, 0, 0); } while (0)
#define PG8_LDA(dst, b, h) do { _Pragma("unroll") for (int m = 0; m < 4; ++m) _Pragma("unroll") for (int k = 0; k < 2; ++k) dst[m][k] = *(const LAS bf16x8*)(lds + PG8_SA(b, h) + aoff + m * 2048 + k * 1024); } while (0)
#define PG8_LDB(dst, b, h) do { _Pragma("unroll") for (int n = 0; n < 2; ++n) _Pragma("unroll") for (int k = 0; k < 2; ++k) dst[n][k] = *(const LAS bf16x8*)(lds + PG8_SB(b, h) + boff + n * 2048 + k * 1024); } while (0)
#define PG8_MMA(ai, bj, At, Bt) do { __builtin_amdgcn_s_setprio(1); _Pragma("unroll") for (int m = 0; m < 4; ++m) _Pragma("unroll") for (int n = 0; n < 2; ++n) _Pragma("unroll") for (int k = 0; k < 2; ++k) \
        acc[ai][bj][m][n] = __builtin_amdgcn_mfma_f32_16x16x32_bf16(Bt[n][k], At[m][k], acc[ai][bj][m][n], 0, 0, 0); __builtin_amdgcn_s_setprio(0); } while (0)
#define PG8_WAIT_V(n) asm volatile("s_waitcnt vmcnt(" #n ")" ::: "memory")
#define PG8_WAIT_L(n) asm volatile("s_waitcnt lgkmcnt(" #n ")" ::: "memory")
#define PG8_BAR __builtin_amdgcn_s_barrier()
#define PG8_SCHED __builtin_amdgcn_sched_barrier(0)
    Unit cur, nxt; int ui = 0;
    if (!S.next(0, cur)) return;
    f32x4 acc[2][2][4][2];
#pragma unroll
    for (int a = 0; a < 2; ++a)
#pragma unroll
        for (int b = 0; b < 2; ++b)
#pragma unroll
            for (int m = 0; m < 4; ++m)
#pragma unroll
                for (int n = 0; n < 2; ++n) acc[a][b][m][n] = (f32x4){0.f, 0.f, 0.f, 0.f};
    bf16x8 At[4][2], B0[2][2], B1[2][2];
    const char* cA = (const char*)g.A + (size_t)cur.pm * tstepA + (size_t)cur.pn * (size_t)g.a_pn_step * 2; const char* cB = (const char*)g.Bt + (size_t)cur.pn * tstepB;
    PG8_STAGE(PG8_SB(0, 0), cB, voffB); PG8_STAGE(PG8_SA(0, 0), cA, voffA); PG8_STAGE(PG8_SB(0, 1), cB + hstepB, voffB); PG8_STAGE(PG8_SA(0, 1), cA + hstepA, voffA);
    if (wr == 1) PG8_BAR;
    PG8_WAIT_V(4); PG8_BAR;
    PG8_STAGE(PG8_SB(1, 0), cB + kstep, voffB); PG8_STAGE(PG8_SA(1, 0), cA + kstep, voffA); PG8_STAGE(PG8_SB(1, 1), cB + hstepB + kstep, voffB);
    PG8_WAIT_V(6); PG8_BAR;
    for (;;) {
        const bool has_next = S.next(ui + 1, nxt);
        const char* nA = has_next ? (const char*)g.A + (size_t)nxt.pm * tstepA + (size_t)nxt.pn * (size_t)g.a_pn_step * 2 : cA; const char* nB = has_next ? (const char*)g.Bt + (size_t)nxt.pn * tstepB : cB;
        for (int t = 0; t < nt; t += 2) {
            const bool last = (t == nt - 2);
            const char* a1 = cA + (size_t)(t + 1) * kstep;
            const char* a2 = last ? nA : cA + (size_t)(t + 2) * kstep; const char* b2 = last ? nB : cB + (size_t)(t + 2) * kstep;
            const char* a3 = a2 + kstep; const char* b3 = b2 + kstep;
            if constexpr (MID) if (t == (nt >> 1)) { int fr_ = fr, fq_ = fq; asm volatile("" : "+v"(fr_), "+v"(fq_)); E.mid(acc, cur, wr, wc, fr_, fq_); }
            PG8_LDB(B0, 0, 0); PG8_SCHED; PG8_LDA(At, 0, 0); PG8_STAGE(PG8_SA(1, 1), a1 + hstepA, voffA);
            PG8_WAIT_L(8); PG8_BAR; PG8_WAIT_L(0); PG8_MMA(0, 0, At, B0); PG8_BAR; PG8_SCHED;
            PG8_LDB(B1, 0, 1); PG8_STAGE(PG8_SB(0, 0), b2, voffB);
            PG8_BAR; PG8_WAIT_L(0); PG8_MMA(0, 1, At, B1); PG8_BAR;
            PG8_LDA(At, 0, 1); PG8_STAGE(PG8_SA(0, 0), a2, voffA);
            PG8_BAR; PG8_WAIT_L(0); PG8_MMA(1, 0, At, B0); PG8_BAR; PG8_SCHED;
            PG8_STAGE(PG8_SB(0, 1), b2 + hstepB, voffB);
            PG8_WAIT_V(6); PG8_BAR; PG8_MMA(1, 1, At, B1); PG8_BAR;
            PG8_LDB(B0, 1, 0); PG8_SCHED; PG8_LDA(At, 1, 0); PG8_STAGE(PG8_SA(0, 1), a2 + hstepA, voffA);
            PG8_WAIT_L(8); PG8_BAR; PG8_WAIT_L(0); PG8_MMA(0, 0, At, B0); PG8_BAR; PG8_SCHED;
            PG8_LDB(B1, 1, 1); PG8_STAGE(PG8_SB(1, 0), b3, voffB);
            PG8_BAR; PG8_WAIT_L(0); PG8_MMA(0, 1, At, B1); PG8_BAR;
            PG8_LDA(At, 1, 1); PG8_STAGE(PG8_SA(1, 0), a3, voffA);
            PG8_BAR; PG8_WAIT_L(0); PG8_MMA(1, 0, At, B0); PG8_BAR; PG8_SCHED;
            PG8_STAGE(PG8_SB(1, 1), b3 + hstepB, voffB);
            PG8_WAIT_V(6); PG8_BAR; PG8_MMA(1, 1, At, B1); PG8_BAR;
        }
        { int fr_ = fr, fq_ = fq; asm volatile("" : "+v"(fr_), "+v"(fq_));
          E(acc, cur, wr, wc, fr_, fq_); }
        if (!has_next) break;
#pragma unroll
        for (int a = 0; a < 2; ++a)
#pragma unroll
            for (int b = 0; b < 2; ++b)
#pragma unroll
                for (int m = 0; m < 4; ++m)
#pragma unroll
                    for (int n = 0; n < 2; ++n) acc[a][b][m][n] = (f32x4){0.f, 0.f, 0.f, 0.f};
        cur = nxt; cA = nA; cB = nB; ++ui;
    }
    PG8_WAIT_V(0);
    if (wr == 0) PG8_BAR;
    PG8_BAR;
#undef PG8_SA
#undef PG8_SB
#undef PG8_STAGE
#undef PG8_LDA
#undef PG8_LDB
#undef PG8_MMA
#undef PG8_WAIT_V
#undef PG8_WAIT_L
#undef PG8_BAR
#undef PG8_SCHED
}

typedef const f32x4 (&AccRef)[2][2][4][2];
__device__ __forceinline__ u32x4 pack8(f32x4 v0, f32x4 v1) { u32x4 w; w.x = cvt_pk_bf16(v0[0], v0[1]); w.y = cvt_pk_bf16(v0[2], v0[3]); w.z = cvt_pk_bf16(v1[0], v1[1]); w.w = cvt_pk_bf16(v1[2], v1[3]); return w; }
__device__ __forceinline__ void unpack8(u32x4 w, f32x4& v0, f32x4& v1) {
    v0[0] = __uint_as_float(w.x << 16); v0[1] = __uint_as_float(w.x & 0xffff0000u); v0[2] = __uint_as_float(w.y << 16); v0[3] = __uint_as_float(w.y & 0xffff0000u);
    v1[0] = __uint_as_float(w.z << 16); v1[1] = __uint_as_float(w.z & 0xffff0000u); v1[2] = __uint_as_float(w.w << 16); v1[3] = __uint_as_float(w.w & 0xffff0000u);
}

struct EpiUPG {
    static constexpr bool PERM = true; bf16_t* UP; bf16_t* G;
    __device__ __forceinline__ void operator()(AccRef acc, const Unit& u, int wr, int wc, int fr, int fq) const {
        const int row0 = u.pm * BM + wr * 64 + fr; const bool sg = u.pn >= 4;
        bf16_t* base = sg ? G : UP; const int ldc = sg ? 4096 : 1024; const int col0 = (sg ? u.pn * BM - 1024 : u.pn * BM) + wc * 32 + 8 * fq;
#pragma unroll
        for (int ai = 0; ai < 2; ++ai)
#pragma unroll
            for (int m = 0; m < 4; ++m) { bf16_t* rowp = base + (size_t)(row0 + ai * HALF + m * 16) * ldc + col0;
#pragma unroll
                for (int bj = 0; bj < 2; ++bj) { f32x4 v0 = acc[ai][bj][m][0], v1 = acc[ai][bj][m][1];
                    if (sg) {
#pragma unroll
                        for (int j = 0; j < 4; ++j) { v0[j] = sigmoidf_(v0[j]); v1[j] = sigmoidf_(v1[j]); } }
                    *(u32x4*)(rowp + bj * HALF) = pack8(v0, v1); }
                __builtin_amdgcn_sched_barrier(0); }
    }
};
struct EpiRaw {
    static constexpr bool PERM = true; bf16_t* O; int ldc;
    __device__ __forceinline__ void operator()(AccRef acc, const Unit& u, int wr, int wc, int fr, int fq) const {
        const int row0 = u.pm * BM + wr * 64 + fr; const int col0 = u.pn * BM + wc * 32 + 8 * fq;
#pragma unroll
        for (int ai = 0; ai < 2; ++ai)
#pragma unroll
            for (int m = 0; m < 4; ++m) { bf16_t* rowp = O + (size_t)(row0 + ai * HALF + m * 16) * ldc + col0;
#pragma unroll
                for (int bj = 0; bj < 2; ++bj) *(u32x4*)(rowp + bj * HALF) = pack8(acc[ai][bj][m][0], acc[ai][bj][m][1]);
                __builtin_amdgcn_sched_barrier(0); }
    }
};
struct EpiPool {
    static constexpr bool PERM = true; bf16_t* O; const float* scale;
    __device__ __forceinline__ void operator()(AccRef acc, const Unit& u, int wr, int wc, int fr, int fq) const {
        const int row0 = u.pm * BM + wr * 64 + fr; const int col0 = u.pn * BM + wc * 32 + 8 * fq;
        f32x4 s[2][2];
#pragma unroll
        for (int bj = 0; bj < 2; ++bj) { s[bj][0] = *(const f32x4*)(scale + col0 + bj * HALF); s[bj][1] = *(const f32x4*)(scale + col0 + bj * HALF + 4); }
#pragma unroll
        for (int ai = 0; ai < 2; ++ai)
#pragma unroll
            for (int m = 0; m < 4; ++m) { bf16_t* rowp = O + (size_t)(row0 + ai * HALF + m * 16) * 2048 + col0;
#pragma unroll
                for (int bj = 0; bj < 2; ++bj) *(u32x4*)(rowp + bj * HALF) = pack8(acc[ai][bj][m][0] * s[bj][0], acc[ai][bj][m][1] * s[bj][1]);
                __builtin_amdgcn_sched_barrier(0); }
    }
};
template <bool ADD> struct EpiGate {
    static constexpr bool PERM = true; const bf16_t* Gt; const bf16_t* T; bf16_t* O;
    __device__ __forceinline__ void operator()(AccRef acc, const Unit& u, int wr, int wc, int fr, int fq) const {
        const int row0 = u.pm * BM + wr * 64 + fr; const int col0 = u.pn * BM + wc * 32 + 8 * fq;
#pragma unroll
        for (int ai = 0; ai < 2; ++ai) {
            u32x4 gw[4][2], tw[4][2];
#pragma unroll
            for (int m = 0; m < 4; ++m)
#pragma unroll
                for (int bj = 0; bj < 2; ++bj) { const size_t row = (size_t)(row0 + ai * HALF + m * 16);
                    gw[m][bj] = *(const u32x4*)(Gt + row * 4096 + col0 + bj * HALF);
                    if (ADD) tw[m][bj] = *(const u32x4*)(T + row * 2048 + col0 + bj * HALF); }
#pragma unroll
            for (int m = 0; m < 4; ++m)
#pragma unroll
                for (int bj = 0; bj < 2; ++bj) { const size_t row = (size_t)(row0 + ai * HALF + m * 16);
                    f32x4 g0, g1; unpack8(gw[m][bj], g0, g1);
                    f32x4 v0 = acc[ai][bj][m][0] * g0, v1 = acc[ai][bj][m][1] * g1;
                    if (ADD) { f32x4 t0, t1; unpack8(tw[m][bj], t0, t1); v0 += t0; v1 += t1; }
                    *(u32x4*)(O + row * 2048 + col0 + bj * HALF) = pack8(v0, v1); }
            __builtin_amdgcn_sched_barrier(0);
        }
    }
};
struct EpiMerge {
    static constexpr bool PERM = true; const bf16_t* G; bf16_t* O;
    __device__ __forceinline__ void mid(f32x4 (&acc)[2][2][4][2], const Unit& u, int wr, int wc, int fr, int fq) const {
        const int row0 = u.pm * BM + wr * 64 + fr; const int col0 = u.pn * BM + wc * 32 + 8 * fq;
        u32x4 ga[2][2][2], gb[2][2][2];
#define MRG_LOAD(buf, k) do { _Pragma("unroll") for (int mm = 0; mm < 2; ++mm) _Pragma("unroll") for (int bj = 0; bj < 2; ++bj) { \
            const bf16_t* gp = G + (size_t)(row0 + ((k) >> 1) * HALF + (((k) & 1) * 2 + mm) * 16) * 4096 + col0 + bj * HALF; \
            ga[buf][mm][bj] = *(const u32x4*)gp; gb[buf][mm][bj] = *(const u32x4*)(gp + 2048); } } while (0)
        MRG_LOAD(0, 0);
#pragma unroll
        for (int k = 0; k < 4; ++k) {
            if (k < 3) MRG_LOAD((k + 1) & 1, k + 1);
            const int ai = k >> 1, mp = k & 1;
#pragma unroll
            for (int mm = 0; mm < 2; ++mm)
#pragma unroll
                for (int bj = 0; bj < 2; ++bj) { f32x4 a0, a1, b0, b1; unpack8(ga[k & 1][mm][bj], a0, a1); unpack8(gb[k & 1][mm][bj], b0, b1);
#pragma unroll
                    for (int j = 0; j < 4; ++j) { acc[ai][bj][mp * 2 + mm][0][j] *= a0[j] * __builtin_amdgcn_rcpf(b0[j]); acc[ai][bj][mp * 2 + mm][1][j] *= a1[j] * __builtin_amdgcn_rcpf(b1[j]); } }
            __builtin_amdgcn_sched_barrier(0);
        }
#undef MRG_LOAD
    }
    __device__ __forceinline__ void operator()(AccRef acc, const Unit& u, int wr, int wc, int fr, int fq) const {
        const int row0 = u.pm * BM + wr * 64 + fr; const int col0 = u.pn * BM + wc * 32 + 8 * fq;
#pragma unroll
        for (int ai = 0; ai < 2; ++ai) {
            u32x4 gw[4][2];
#pragma unroll
            for (int m = 0; m < 4; ++m)
#pragma unroll
                for (int bj = 0; bj < 2; ++bj) gw[m][bj] = *(const u32x4*)(G + (size_t)(row0 + ai * HALF + m * 16) * 4096 + 2048 + col0 + bj * HALF);
#pragma unroll
            for (int m = 0; m < 4; ++m)
#pragma unroll
                for (int bj = 0; bj < 2; ++bj) { f32x4 g0, g1; unpack8(gw[m][bj], g0, g1);
                    *(u32x4*)(O + (size_t)(row0 + ai * HALF + m * 16) * 2048 + col0 + bj * HALF) = pack8(acc[ai][bj][m][0] * g0, acc[ai][bj][m][1] * g1); }
            __builtin_amdgcn_sched_barrier(0);
        }
    }
};
struct EpiRes {
    static constexpr bool PERM = false; const float* R; float* O;
    __device__ __forceinline__ void operator()(AccRef acc, const Unit& u, int wr, int wc, int fr, int fq) const {
        const int row0 = u.pm * BM + wr * 64 + fr; const int col0 = u.pn * BM + wc * 32 + 4 * fq;
#pragma unroll
        for (int ai = 0; ai < 2; ++ai) {
            f32x4 r[4][2][2];
#pragma unroll
            for (int m = 0; m < 4; ++m)
#pragma unroll
                for (int bj = 0; bj < 2; ++bj)
#pragma unroll
                    for (int n = 0; n < 2; ++n) r[m][bj][n] = *(const f32x4*)(R + (size_t)(row0 + ai * HALF + m * 16) * 2048 + col0 + bj * HALF + n * 16);
#pragma unroll
            for (int m = 0; m < 4; ++m)
#pragma unroll
                for (int bj = 0; bj < 2; ++bj)
#pragma unroll
                    for (int n = 0; n < 2; ++n) *(f32x4*)(O + (size_t)(row0 + ai * HALF + m * 16) * 2048 + col0 + bj * HALF + n * 16) = r[m][bj][n] + acc[ai][bj][m][n];
            __builtin_amdgcn_sched_barrier(0);
        }
    }
};
struct EpiSwiGLU {
    static constexpr bool PERM = true; bf16_t* O;
    __device__ __forceinline__ void operator()(AccRef acc, const Unit& u, int wr, int wc, int fr, int fq) const {
        const int row0 = u.pm * BM + wr * 64 + fr; const int col0 = u.pn * HALF + wc * 32 + 8 * fq;
#pragma unroll
        for (int ai = 0; ai < 2; ++ai)
#pragma unroll
            for (int m = 0; m < 4; ++m) { f32x4 v0, v1;
#pragma unroll
                for (int j = 0; j < 4; ++j) { const float a0 = acc[ai][0][m][0][j], a1 = acc[ai][0][m][1][j];
                    v0[j] = a0 * sigmoidf_(a0) * acc[ai][1][m][0][j]; v1[j] = a1 * sigmoidf_(a1) * acc[ai][1][m][1][j]; }
                *(u32x4*)(O + (size_t)(row0 + ai * HALF + m * 16) * DFF + col0) = pack8(v0, v1);
                __builtin_amdgcn_sched_barrier(0); }
    }
};

__device__ __forceinline__ int rowmap(int mode, int n) {
    switch (mode) {
        case 1: return n < 1024 ? n : (n < 4096 ? n + 4096 : n - 3072);
        case 2: return ((n >> 7) << 8) + (n & 127);
        case 3: return ((n >> 7) << 8) + 128 + (n & 127);
        default: return n;
    }
}
__device__ __forceinline__ void transpose_cvt(const Ctx cx, LAS float* tile, const float* src, int K, int N, bf16_t* dst, int mode, int ldd, int koff) {
    constexpr int TB = 4;
    const int tid = cx.tid; const int tn = N >> 6, ntile = (K >> 6) * tn;
    for (int t4 = cx.bid * TB; t4 < ntile; t4 += cx.nblk * TB) {
        f32x4 v[TB][2];
#pragma unroll
        for (int u = 0; u < TB; ++u) { const int t = t4 + u, k0 = (t / tn) << 6, n0 = (t % tn) << 6;
#pragma unroll
            for (int i = 0; i < 2; ++i) { const int kk = (tid >> 4) + i * 32, nc = (tid & 15) << 2; v[u][i] = *(const f32x4*)(src + (size_t)(k0 + kk) * N + n0 + nc); } }
#pragma unroll
        for (int u = 0; u < TB; ++u)
#pragma unroll
            for (int i = 0; i < 2; ++i) { const int kk = (tid >> 4) + i * 32, nc = (tid & 15) << 2; LAS float* tp = tile + u * (64 * 65) + kk * 65 + nc;
                tp[0] = v[u][i][0]; tp[1] = v[u][i][1]; tp[2] = v[u][i][2]; tp[3] = v[u][i][3]; }
        __syncthreads();
#pragma unroll
        for (int u = 0; u < TB; ++u) { const int t = t4 + u, k0 = (t / tn) << 6, n0 = (t % tn) << 6;
            const int nn = tid >> 3, kc = (tid & 7) << 3; f32x4 a, b; const LAS float* tp = tile + u * (64 * 65);
#pragma unroll
            for (int j = 0; j < 4; ++j) { a[j] = tp[(kc + j) * 65 + nn]; b[j] = tp[(kc + 4 + j) * 65 + nn]; }
            *(u32x4*)(dst + (size_t)rowmap(mode, n0 + nn) * ldd + koff + k0 + kc) = pack8(a, b); }
        __syncthreads();
    }
}

__device__ __forceinline__ void filter_features(const Ctx cx, LAS float* sm, const float* fw1, const float* fb1, const float* ff1, const float* fw2, const float* fb2, const float* ff2, int L, bf16_t* Hfb) {
    const int tid = cx.tid, tt = tid >> 6, j = tid & 63;
    LAS float* zf = sm; LAS float* h1s = sm + 8 * 36;
    const float b1 = fb1[j], f1 = ff1[j], b2 = fb2[j], f2 = ff2[j];
    for (int t0 = cx.bid * 8; t0 < L; t0 += cx.nblk * 8) {
        const int t = t0 + tt;
        if (j < 33) { float z;
            if (j == 0) z = (float)t / (float)(L - 1);
            else { const int k = (j - 1) & 15; const float band = 1e-4f + (float)k * ((15.0f - 1e-4f) / 15.0f);
                double rv = (double)band * (double)t / (double)L; rv -= floor(rv); const float r = (float)rv;
                z = (j <= 16) ? __builtin_amdgcn_cosf(r) : -__builtin_amdgcn_sinf(r); }
            zf[tt * 36 + j] = z; }
        __syncthreads();
        { float a = b1; for (int i = 0; i < 33; ++i) a += zf[tt * 36 + i] * fw1[i * 64 + j];
          h1s[tt * 64 + j] = __builtin_amdgcn_sinf(f1 * a * 0.15915494309189535f); }
        __syncthreads();
        { float a = b2; for (int i = 0; i < 64; ++i) a += h1s[tt * 64 + i] * fw2[i * 64 + j];
          Hfb[(size_t)t * 64 + j] = (bf16_t)(cvt_pk_bf16(__builtin_amdgcn_sinf(f2 * a * 0.15915494309189535f), 0.f) & 0xffffu); }
        __syncthreads();
    }
}

__device__ __forceinline__ int PX(int i) { const int h = i >> 5; return i + h + (h << 2); }
__device__ __forceinline__ f32x2 cmul(f32x2 a, f32x2 b) { return (f32x2){a.x * b.x - a.y * b.y, a.x * b.y + a.y * b.x}; }
__device__ __forceinline__ f32x2 cis_rev(float rev) { return (f32x2){__builtin_amdgcn_cosf(rev), __builtin_amdgcn_sinf(rev)}; }
__device__ __forceinline__ f32x2 rot8(f32x2 v, int k, bool inv) {
    const float c = 0.70710678118654752f;
    if (!inv) { switch (k) { case 1: return (f32x2){c * (v.x + v.y), c * (v.y - v.x)}; case 2: return (f32x2){v.y, -v.x}; case 3: return (f32x2){c * (v.y - v.x), -c * (v.x + v.y)}; default: return v; } }
    else      { switch (k) { case 1: return (f32x2){c * (v.x - v.y), c * (v.x + v.y)}; case 2: return (f32x2){-v.y, v.x}; case 3: return (f32x2){-c * (v.x + v.y), c * (v.x - v.y)}; default: return v; } }
}
template <int LOGR> __device__ __forceinline__ void dif_bfly(f32x2 (&v)[1 << LOGR], int r, int logm) {
    constexpr int R = 1 << LOGR;
    f32x2 W = cis_rev(-(float)r * __uint_as_float((unsigned)(126 - logm) << 23));
#pragma unroll
    for (int s = 0; s < LOGR; ++s) {
        const int half = R >> (s + 1);
#pragma unroll
        for (int q = 0; q < R; ++q) if ((q & half) == 0) {
            const int qq = q & (half - 1);
            const f32x2 a = v[q], b = v[q + half];
            v[q] = a + b;
            v[q + half] = rot8(cmul(a - b, W), (qq << s) * (8 / R), false);
        }
        W = cmul(W, W);
    }
}
template <int LOGR> __device__ __forceinline__ void dit_bfly(f32x2 (&v)[1 << LOGR], int r, int logm0) {
    constexpr int R = 1 << LOGR;
    f32x2 Wt[LOGR];
    Wt[LOGR - 1] = cis_rev((float)r * __uint_as_float((unsigned)(127 - (logm0 + LOGR)) << 23));
#pragma unroll
    for (int s = LOGR - 2; s >= 0; --s) Wt[s] = cmul(Wt[s + 1], Wt[s + 1]);
#pragma unroll
    for (int s = 0; s < LOGR; ++s) {
        const int half = 1 << s;
        const f32x2 W = Wt[s];
#pragma unroll
        for (int q = 0; q < R; ++q) if ((q & half) == 0) {
            const int qq = q & (half - 1);
            const f32x2 a = v[q], b = rot8(cmul(v[q + half], W), qq * (4 >> s), true);
            v[q] = a + b; v[q + half] = a - b;
        }
    }
}
template <int LOGR> __device__ __forceinline__ void dif_pass(const Ctx cx, LAS f32x2* X, int logN, int logm) {
    constexpr int R = 1 << LOGR;
    const int logsub = logm - LOGR + 1, sub = 1 << logsub, ngroups = 1 << (logN - LOGR), psub = PX(sub);
#pragma unroll 2
    for (int g = cx.tid; g < ngroups; g += 512) {
        const int r = g & (sub - 1), blk = g >> logsub, base = (blk << (logm + 1)) + r, pb = PX(base);
        f32x2 v[R];
#pragma unroll
        for (int q = 0; q < R; ++q) v[q] = X[pb + ((sub >= 32) ? q * psub : (q * sub + 5 * ((q * sub) >> 5)))];
        dif_bfly<LOGR>(v, r, logm);
#pragma unroll
        for (int q = 0; q < R; ++q) X[pb + ((sub >= 32) ? q * psub : (q * sub + 5 * ((q * sub) >> 5)))] = v[q];
    }
}
template <int LOGR> __device__ __forceinline__ void dit_pass(const Ctx cx, LAS f32x2* X, int logN, int logm0) {
    constexpr int R = 1 << LOGR;
    const int sub = 1 << logm0, ngroups = 1 << (logN - LOGR), psub = PX(sub);
#pragma unroll 2
    for (int g = cx.tid; g < ngroups; g += 512) {
        const int r = g & (sub - 1), blk = g >> logm0, base = (blk << (logm0 + LOGR)) + r, pb = PX(base);
        f32x2 v[R];
#pragma unroll
        for (int q = 0; q < R; ++q) v[q] = X[pb + ((sub >= 32) ? q * psub : (q * sub + 5 * ((q * sub) >> 5)))];
        dit_bfly<LOGR>(v, r, logm0);
#pragma unroll
        for (int q = 0; q < R; ++q) X[pb + ((sub >= 32) ? q * psub : (q * sub + 5 * ((q * sub) >> 5)))] = v[q];
    }
}
__device__ __forceinline__ void fft_fwd(const Ctx cx, LAS f32x2* X, int logN) {
    int n8 = 0, n4 = 0; for (int rem = logN; rem > 0;) { if (rem > 4 || rem == 3) { ++n8; rem -= 3; } else { ++n4; rem -= 2; } }
    int logm = logN - 1;
    for (int i = 0; i < n8; ++i) { dif_pass<3>(cx, X, logN, logm); logm -= 3; __syncthreads(); }
    for (int i = 0; i < n4; ++i) { dif_pass<2>(cx, X, logN, logm); logm -= 2; __syncthreads(); }
}
__device__ __forceinline__ void fft_inv(const Ctx cx, LAS f32x2* X, int logN) {
    int n8 = 0, n4 = 0; for (int rem = logN; rem > 0;) { if (rem > 4 || rem == 3) { ++n8; rem -= 3; } else { ++n4; rem -= 2; } }
    int lm = 0;
    for (int i = 0; i < n4; ++i) { dit_pass<2>(cx, X, logN, lm); lm += 2; __syncthreads(); }
    for (int i = 0; i < n8; ++i) { dit_pass<3>(cx, X, logN, lm); lm += 3; __syncthreads(); }
}
__device__ __forceinline__ int fft_partner(int pp) { if (pp == 0) return 0; const int j = 31 - __builtin_clz(pp); return (3 << j) - 1 - pp; }

__device__ __forceinline__ void filter_spectrum(const Ctx cx, LAS unsigned char* lds, const bf16_t* W3T, int L, int logN2, const bf16_t* Hfb, f32x2* FS) {
    const int tid = cx.tid, N2 = 2 * L, wid = tid >> 6, lane = tid & 63, fr = lane & 15, fq = lane >> 4;
    LAS f32x2* X = (LAS f32x2*)lds; LAS float* red = (LAS float*)(lds + LDS_X_BYTES);
    const float min_decay = -3.0701134573253944f, max_decay = -15.350567286626972f;
    const float tscale = 1.0f / (float)(L - 1);
    for (int c = cx.bid; c < 1024; c += cx.nblk) {
        bf16x8 wf0 = (bf16x8){0, 0, 0, 0, 0, 0, 0, 0}, wf1 = wf0;
        if (fr < 4) { wf0 = *(const bf16x8*)(W3T + (size_t)c * 256 + fr * 64 + fq * 8); wf1 = *(const bf16x8*)(W3T + (size_t)c * 256 + fr * 64 + 32 + fq * 8); }
        if (tid == 0) X[PX(L)] = (f32x2){0.f, 0.f};
        const float delta = fabsf(min_decay + (max_decay - min_decay) * ((float)c / 1023.0f));
        float ss0 = 0.f, ss1 = 0.f;
#pragma unroll 8
        for (int tl = wid; tl < (L >> 4); tl += 8) {
            const int n = (tl << 4) + fr;
            const bf16x8 h0 = *(const bf16x8*)(Hfb + (size_t)n * 64 + fq * 8), h1 = *(const bf16x8*)(Hfb + (size_t)n * 64 + 32 + fq * 8);
            f32x4 acc = (f32x4){0.f, 0.f, 0.f, 0.f};
            acc = __builtin_amdgcn_mfma_f32_16x16x32_bf16(wf0, h0, acc, 0, 0, 0);
            acc = __builtin_amdgcn_mfma_f32_16x16x32_bf16(wf1, h1, acc, 0, 0, 0);
            if (fq == 0) {
                const float dec = __expf(-((float)n * tscale) * delta);
                const float f00 = acc[0] * dec, f01 = acc[1] * dec, f10 = acc[2] * dec, f11 = acc[3] * dec;
                if (n == 0) { const f32x2 v = (f32x2){f00 + f01, f10 + f11}; X[PX(0)] = v; ss0 += v.x * v.x; ss1 += v.y * v.y; }
                else { X[PX(n)] = (f32x2){f00, f10}; X[PX(N2 - n)] = (f32x2){f01, f11}; ss0 += f00 * f00 + f01 * f01; ss1 += f10 * f10 + f11 * f11; }
            }
        }
        ss0 = wave_sum(tid, ss0); ss1 = wave_sum(tid, ss1);
        if (lane == 0) { red[wid * 2] = ss0; red[wid * 2 + 1] = ss1; }
        __syncthreads();
        float t0 = 0.f, t1 = 0.f;
#pragma unroll
        for (int w = 0; w < 8; ++w) { t0 += red[w * 2]; t1 += red[w * 2 + 1]; }
        const float sc = 0.5f / (float)N2; const f32x2 rs = (f32x2){rsqrtf(t0 + 1e-6f) * sc, rsqrtf(t1 + 1e-6f) * sc};
        for (int n = tid; n < N2; n += 512) X[PX(n)] *= rs;
        __syncthreads();
        fft_fwd(cx, X, logN2);
        f32x2* dst = FS + (size_t)c * N2;
        for (int n = tid; n < N2; n += 512) dst[n] = X[PX(n)];
        __syncthreads();
    }
}

__device__ __forceinline__ float sconv(const bf16_t* row, int n, int L, float w0, float w1, float w2, float b) {
    const float um = n > 0 ? bf2f(row[n - 1]) : 0.f, u0 = bf2f(row[n]), up = (n + 1 < L) ? bf2f(row[n + 1]) : 0.f;
    return um * w0 + u0 * w1 + up * w2 + b;
}
template <int GW> __device__ __forceinline__ void convN(const bf16_t* row, int n0, int L, float w0, float w1, float w2, float b, float (&o)[GW]) {
    float u[GW + 2];
    u[0] = n0 > 0 ? bf2f(row[n0 - 1]) : 0.f;
    u[GW + 1] = (n0 + GW < L) ? bf2f(row[n0 + GW]) : 0.f;
    if (GW == 4) { const u32x2 w = *(const u32x2*)(row + n0); u[1] = __uint_as_float(w.x << 16); u[2] = __uint_as_float(w.x & 0xffff0000u); u[3] = __uint_as_float(w.y << 16); u[GW] = __uint_as_float(w.y & 0xffff0000u); }
    else { const unsigned w = *(const unsigned*)(row + n0); u[1] = __uint_as_float(w << 16); u[2] = __uint_as_float(w & 0xffff0000u); }
#pragma unroll
    for (int i = 0; i < GW; ++i) o[i] = u[i] * w0 + u[i + 1] * w1 + u[i + 2] * w2 + b;
}
template <int GW> __device__ __forceinline__ void hyena_p1(int tid, LAS f32x2* X, int logN2, int L, int order, const bf16_t* rowA, const bf16_t* rowB, float w0, float w1, float w2, float wb, f32x2* Z1) {
    const int lsub = logN2 - 3, sub = 1 << lsub;
    for (int t = tid; t < (sub / GW); t += 512) {
        const int r0 = t * GW, pb0 = PX(r0), psub = PX(sub);
        f32x2 v[GW][8];
#pragma unroll
        for (int q = 0; q < 4; ++q) { const int n0 = r0 + q * sub;
            if (order == 0) { float a[GW], b[GW]; convN<GW>(rowA, n0, L, w0, w1, w2, wb, a); convN<GW>(rowB, n0, L, w0, w1, w2, wb, b);
#pragma unroll
                for (int i = 0; i < GW; ++i) v[i][q] = (f32x2){a[i], b[i]};
#pragma unroll
                for (int i = 0; i < GW / 2; ++i) ((f32x4*)(Z1 + n0))[i] = (f32x4){a[2 * i], b[2 * i], a[2 * i + 1], b[2 * i + 1]}; }
            else {
#pragma unroll
                for (int i = 0; i < GW / 2; ++i) { const f32x4 z = ((const f32x4*)(Z1 + n0))[i]; v[2 * i][q] = (f32x2){z[0], z[1]}; v[2 * i + 1][q] = (f32x2){z[2], z[3]}; } } }
#pragma unroll
        for (int i = 0; i < GW; ++i) {
#pragma unroll
            for (int q = 4; q < 8; ++q) v[i][q] = (f32x2){0.f, 0.f};
            dif_bfly<3>(v[i], r0 + i, logN2 - 1); }
#pragma unroll
        for (int q = 0; q < 8; ++q)
#pragma unroll
            for (int i = 0; i < GW; ++i) X[pb0 + i + q * psub] = v[i][q];
    }
}
template <int GW> __device__ __forceinline__ void hyena_p9(int tid, LAS f32x2* X, int logN2, int L, int order, const bf16_t* rowA, const bf16_t* rowB, float w0, float w1, float w2, float wb, float hb, f32x2* Z1, bf16_t* outA, bf16_t* outB) {
    const int lsub = logN2 - 3, sub = 1 << lsub;
    for (int t = tid; t < (sub / GW); t += 512) {
        const int r0 = t * GW, pb0 = PX(r0), psub = PX(sub);
        f32x2 v[GW][8];
#pragma unroll
        for (int q = 0; q < 8; ++q)
#pragma unroll
            for (int i = 0; i < GW; ++i) v[i][q] = X[pb0 + i + q * psub];
#pragma unroll
        for (int i = 0; i < GW; ++i) dit_bfly<3>(v[i], r0 + i, lsub);
#pragma unroll
        for (int q = 0; q < 4; ++q) { const int n0 = r0 + q * sub;
            float xa[GW], xb[GW]; convN<GW>(rowA, n0, L, w0, w1, w2, wb, xa); convN<GW>(rowB, n0, L, w0, w1, w2, wb, xb);
            f32x2 zo[GW];
#pragma unroll
            for (int i = 0; i < GW / 2; ++i) { const f32x4 z = ((const f32x4*)(Z1 + n0))[i];
                zo[2 * i] = (f32x2){xa[2 * i] * (v[2 * i][q].x + hb * z[0]), xb[2 * i] * (v[2 * i][q].y + hb * z[1])};
                zo[2 * i + 1] = (f32x2){xa[2 * i + 1] * (v[2 * i + 1][q].x + hb * z[2]), xb[2 * i + 1] * (v[2 * i + 1][q].y + hb * z[3])}; }
            if (order == 0) {
#pragma unroll
                for (int i = 0; i < GW / 2; ++i) ((f32x4*)(Z1 + n0))[i] = (f32x4){zo[2 * i].x, zo[2 * i].y, zo[2 * i + 1].x, zo[2 * i + 1].y}; }
            else if (GW == 4) { u32x2 wa, wb2; wa.x = cvt_pk_bf16(zo[0].x, zo[1].x); wa.y = cvt_pk_bf16(zo[2].x, zo[GW - 1].x); wb2.x = cvt_pk_bf16(zo[0].y, zo[1].y); wb2.y = cvt_pk_bf16(zo[2].y, zo[GW - 1].y);
                *(u32x2*)(outA + n0) = wa; *(u32x2*)(outB + n0) = wb2; }
            else { *(unsigned*)(outA + n0) = cvt_pk_bf16(zo[0].x, zo[1].x); *(unsigned*)(outB + n0) = cvt_pk_bf16(zo[0].y, zo[1].y); }
        }
    }
}
__device__ __forceinline__ void hyena_phase(const Ctx cx, LAS unsigned char* lds, const float* conv_w, const float* conv_b, const float* hbias, int L, int logN2, int nbatch, const f32x2* FS, const bf16_t* UH, bf16_t* BT, f32x2* Z1) {
    const int tid = cx.tid, N2 = 2 * L;
    LAS f32x2* X = (LAS f32x2*)lds;
    int n8 = 0, n4 = 0; for (int rem = logN2; rem > 0;) { if (rem > 4 || rem == 3) { ++n8; rem -= 3; } else { ++n4; rem -= 2; } }
    const int lsub = logN2 - 3, sub = 1 << lsub;
    for (int c = cx.bid; c < 1024; c += cx.nblk) {
        const f32x2* FSc = FS + (size_t)c * N2;
        const float v0 = conv_w[c], v1 = conv_w[3072 + c], v2 = conv_w[6144 + c], v3 = conv_b[c];
        const float bias0 = hbias[c], bias1 = hbias[1024 + c];
        const bf16_t* uv = UH + (size_t)c * NTG;
        for (int pair = 0; pair < nbatch / 2; ++pair) {
            const int tA = (2 * pair) * L, tB = tA + L;
            for (int order = 0; order < 2; ++order) {
                const int gch = (order + 1) * 1024 + c;
                const bf16_t* ug = UH + (size_t)gch * NTG;
                const float g0 = conv_w[gch], g1 = conv_w[3072 + gch], g2 = conv_w[6144 + gch], g3 = conv_b[gch];
                const float hb = order ? bias1 : bias0;
                if (logN2 == 14) hyena_p1<4>(tid, X, logN2, L, order, uv + tA, uv + tB, v0, v1, v2, v3, Z1);
                else             hyena_p1<2>(tid, X, logN2, L, order, uv + tA, uv + tB, v0, v1, v2, v3, Z1);
                __syncthreads();
                { int logm = logN2 - 4;
                  for (int i = 1; i < n8; ++i) { dif_pass<3>(cx, X, logN2, logm); logm -= 3; __syncthreads(); }
                  for (int i = 0; i < n4 - 1; ++i) { dif_pass<2>(cx, X, logN2, logm); logm -= 2; __syncthreads(); } }
#pragma unroll 2
                for (int g = tid; g < (N2 >> 2); g += 512) {
                    const int base = g << 2, pbase = PX(base);
                    f32x2 v[4];
#pragma unroll
                    for (int q = 0; q < 4; ++q) v[q] = X[pbase + q];
                    const int pb = base ? ((3 << (31 - __builtin_clz(base))) - 4 - base) : 0;
                    const f32x4 a01 = *(const f32x4*)(FSc + base), a23 = *(const f32x4*)(FSc + base + 2);
                    const f32x4 b01 = *(const f32x4*)(FSc + pb), b23 = *(const f32x4*)(FSc + pb + 2);
                    { f32x2 a = v[0], b = v[2]; v[0] = a + b; v[2] = a - b; a = v[1]; b = v[3]; v[1] = a + b; v[3] = rot8(a - b, 2, false);
                      a = v[0]; b = v[1]; v[0] = a + b; v[1] = a - b; a = v[2]; b = v[3]; v[2] = a + b; v[3] = a - b; }
                    f32x2 A[4], Bn[4];
                    A[0] = (f32x2){a01[0], a01[1]}; A[1] = (f32x2){a01[2], a01[3]}; A[2] = (f32x2){a23[0], a23[1]}; A[3] = (f32x2){a23[2], a23[3]};
                    if (base) { Bn[0] = (f32x2){b23[2], b23[3]}; Bn[1] = (f32x2){b23[0], b23[1]}; Bn[2] = (f32x2){b01[2], b01[3]}; Bn[3] = (f32x2){b01[0], b01[1]}; }
                    else      { Bn[0] = (f32x2){b01[0], b01[1]}; Bn[1] = (f32x2){b01[2], b01[3]}; Bn[2] = (f32x2){b23[2], b23[3]}; Bn[3] = (f32x2){b23[0], b23[1]}; }
#pragma unroll
                    for (int q = 0; q < 4; ++q) { const f32x2 Hq = order ? (f32x2){A[q].y + Bn[q].y, Bn[q].x - A[q].x} : (f32x2){A[q].x + Bn[q].x, A[q].y - Bn[q].y};
                        v[q] = cmul(v[q], Hq); }
                    { f32x2 a = v[0], b = v[1]; v[0] = a + b; v[1] = a - b; a = v[2]; b = v[3]; v[2] = a + b; v[3] = a - b;
                      a = v[0]; b = v[2]; v[0] = a + b; v[2] = a - b; a = v[1]; b = rot8(v[3], 2, true); v[1] = a + b; v[3] = a - b; }
#pragma unroll
                    for (int q = 0; q < 4; ++q) X[pbase + q] = v[q];
                }
                __syncthreads();
                { int lm = 2;
                  for (int i = 1; i < n4; ++i) { dit_pass<2>(cx, X, logN2, lm); lm += 2; __syncthreads(); }
                  for (int i = 0; i < n8 - 1; ++i) { dit_pass<3>(cx, X, logN2, lm); lm += 3; __syncthreads(); } }
                if (logN2 == 14) hyena_p9<4>(tid, X, logN2, L, order, ug + tA, ug + tB, g0, g1, g2, g3, hb, Z1, BT + (size_t)c * NTG + tA, BT + (size_t)c * NTG + tB);
                else             hyena_p9<2>(tid, X, logN2, L, order, ug + tA, ug + tB, g0, g1, g2, g3, hb, Z1, BT + (size_t)c * NTG + tA, BT + (size_t)c * NTG + tB);
                __syncthreads();
            }
        }
    }
}

template <int HW> __device__ __forceinline__ void pool_item(const bf16_t* UP, bf16_t* PL, int L, int tok, int ch0) {
    const int t = tok & (L - 1);
    const bf16_t* basep = UP + (size_t)(tok - t) * 1024 + ch0;
    u32x4 w[2 * HW];
#pragma unroll
    for (int i = 0; i < 2 * HW; ++i) { const int s = t - HW + i; const int sc = s < 0 ? 0 : (s >= L ? L - 1 : s); w[i] = *(const u32x4*)(basep + (size_t)sc * 1024); }
    f32x4 s0 = (f32x4){0.f, 0.f, 0.f, 0.f}, s1 = s0;
#pragma unroll
    for (int i = 0; i < 2 * HW; ++i) { const int s = t - HW + i; f32x4 a, b; unpack8(w[i], a, b); const float m = (s >= 0 && s < L) ? 1.0f : 0.0f; s0 += a * m; s1 += b * m; }
    f32x4 a, b; unpack8(w[HW], a, b);
    const int lo = (t - HW) < 0 ? 0 : (t - HW), hi = (t + HW) > L ? L : (t + HW);
    const float inv = 1.0f / (float)(hi - lo);
    *(u32x4*)(PL + (size_t)tok * 1024 + ch0) = pack8(s0 * inv - a, s1 * inv - b);
}
__device__ __forceinline__ void pool_phase(const Ctx cx, const bf16_t* UP, bf16_t* PL, int L) {
    const int total = NTG * 128;
    for (int idx = cx.bid * 512 + cx.tid; idx < total; idx += cx.nblk * 512) {
        const int grp = idx / (NTG * 32), rem = idx - grp * (NTG * 32), tok = rem >> 5, ch0 = grp * 256 + ((rem & 31) << 3);
        switch (grp) {
            case 0: pool_item<1>(UP, PL, L, tok, ch0); break;
            case 1: pool_item<2>(UP, PL, L, tok, ch0); break;
            case 2: pool_item<4>(UP, PL, L, tok, ch0); break;
            default: pool_item<8>(UP, PL, L, tok, ch0); break;
        }
    }
}

__device__ __forceinline__ void bt_transpose(const Ctx cx, LAS unsigned short* tile, const bf16_t* BT, bf16_t* AB) {
    constexpr int TB = 4;
    const int tid = cx.tid;
    constexpr int NTT = NTG / 64;
    for (int t4 = cx.bid * TB; t4 < 16 * NTT; t4 += cx.nblk * TB) {
        u32x4 w[TB];
#pragma unroll
        for (int u = 0; u < TB; ++u) { const int t = t4 + u, c0 = (t / NTT) << 6, k0 = (t % NTT) << 6; const int r = tid >> 3, cc = (tid & 7) << 3;
            w[u] = *(const u32x4*)(BT + (size_t)(c0 + r) * NTG + k0 + cc); }
#pragma unroll
        for (int u = 0; u < TB; ++u) { const int r = tid >> 3, cc = (tid & 7) << 3; LAS unsigned short* d = tile + u * (64 * 72) + r * 72 + cc;
            d[0] = (unsigned short)(w[u].x & 0xffff); d[1] = (unsigned short)(w[u].x >> 16); d[2] = (unsigned short)(w[u].y & 0xffff); d[3] = (unsigned short)(w[u].y >> 16);
            d[4] = (unsigned short)(w[u].z & 0xffff); d[5] = (unsigned short)(w[u].z >> 16); d[6] = (unsigned short)(w[u].w & 0xffff); d[7] = (unsigned short)(w[u].w >> 16); }
        __syncthreads();
#pragma unroll
        for (int u = 0; u < TB; ++u) { const int t = t4 + u, c0 = (t / NTT) << 6, k0 = (t % NTT) << 6; const int tk = tid >> 3, ch = (tid & 7) << 3; const LAS unsigned short* tp = tile + u * (64 * 72); u32x4 o;
            o.x = (unsigned)tp[(ch + 0) * 72 + tk] | ((unsigned)tp[(ch + 1) * 72 + tk] << 16); o.y = (unsigned)tp[(ch + 2) * 72 + tk] | ((unsigned)tp[(ch + 3) * 72 + tk] << 16);
            o.z = (unsigned)tp[(ch + 4) * 72 + tk] | ((unsigned)tp[(ch + 5) * 72 + tk] << 16); o.w = (unsigned)tp[(ch + 6) * 72 + tk] | ((unsigned)tp[(ch + 7) * 72 + tk] << 16);
            *(u32x4*)(AB + (size_t)(k0 + tk) * 2048 + 1024 + c0 + ch) = o; }
        __syncthreads();
    }
}

template <bool OUTF32> __device__ __forceinline__ void rmsnorm_phase(const Ctx cx, const float* x, const float* g, void* outp, int nrows) {
    constexpr int RB = 4;
    const int wave = cx.tid >> 6, lane = cx.tid & 63;
    const int nw = cx.nblk * 8;
    for (int row0 = (cx.bid * 8 + wave) * RB; row0 < nrows; row0 += nw * RB) {
        f32x4 v[RB][8];
#pragma unroll
        for (int rb = 0; rb < RB; ++rb) { const f32x4* xr = (const f32x4*)(x + (size_t)(row0 + rb) * DM);
#pragma unroll
            for (int i = 0; i < 8; ++i) v[rb][i] = __builtin_nontemporal_load(xr + lane + 64 * i); }
        float rs[RB];
#pragma unroll
        for (int rb = 0; rb < RB; ++rb) { float ss = 0.f;
#pragma unroll
            for (int i = 0; i < 8; ++i) ss += v[rb][i][0] * v[rb][i][0] + v[rb][i][1] * v[rb][i][1] + v[rb][i][2] * v[rb][i][2] + v[rb][i][3] * v[rb][i][3];
            ss = wave_sum(cx.tid, ss); rs[rb] = rsqrtf(ss * (1.0f / DM) + 1e-6f); }
#pragma unroll
        for (int i = 0; i < 8; ++i) { const f32x4 gv = ((const f32x4*)g)[lane + 64 * i];
#pragma unroll
            for (int rb = 0; rb < RB; ++rb) { const f32x4 o = v[rb][i] * rs[rb] * gv;
                if (OUTF32) __builtin_nontemporal_store(o, (f32x4*)((float*)outp + (size_t)(row0 + rb) * DM) + lane + 64 * i);
                else { u32x2 w; w.x = cvt_pk_bf16(o[0], o[1]); w.y = cvt_pk_bf16(o[2], o[3]); ((u32x2*)((bf16_t*)outp + (size_t)(row0 + rb) * DM))[lane + 64 * i] = w; } } }
    }
}

#define XB_TMO      128
#define XB_XCNT(j)  (256  + 64 * (j))
#define XB_XSUB(j)  (1280 + 64 * (j))
#define XB_XGEN(j)  (2304 + 64 * (j))
#define XB_TOP      3328
#define XB_TOPGEN   3392
#define XCD_BAR_WORDS 3456
#define XB_SPIN_CAP (1u << 18)
__device__ __forceinline__ unsigned xb_ld(unsigned* p)              { return __hip_atomic_load(p, __ATOMIC_RELAXED, __HIP_MEMORY_SCOPE_AGENT); }
__device__ __forceinline__ unsigned xb_add(unsigned* p, unsigned v) { return __hip_atomic_fetch_add(p, v, __ATOMIC_RELAXED, __HIP_MEMORY_SCOPE_AGENT); }
__device__ __forceinline__ unsigned xb_xcc_id() { return (unsigned)__builtin_amdgcn_s_getreg((3 << 11) | 20) & 0xFu; }
#define XB_SPIN(cond, bar) do { unsigned _sp = 0; while (cond) { __builtin_amdgcn_s_sleep(1); \
    if ((++_sp & 255u) == 0u) { if (xb_ld(&(bar)[XB_TMO])) break; if (_sp > XB_SPIN_CAP) { atomicAdd(&(bar)[XB_TMO], 1u); break; } } } } while (0)
__device__ __forceinline__ void xcd_barrier_complete(unsigned* bar, unsigned x, unsigned G, unsigned& nloc, unsigned& nx) {
    unsigned sum, cnt, mine, sp = 0u;
    for (;;) {
        sum = 0u; cnt = 0u; mine = 0u;
#pragma unroll
        for (unsigned j = 0; j < 16; ++j) { const unsigned c = xb_ld(&bar[XB_XCNT(j)]); sum += c; cnt += (c > 0u) ? 1u : 0u; mine = (j == x) ? c : mine; }
        if (sum == G) break;
        __builtin_amdgcn_s_sleep(1);
        if ((++sp & 255u) == 0u) { if (xb_ld(&bar[XB_TMO])) break; if (sp > XB_SPIN_CAP) { atomicAdd(&bar[XB_TMO], 1u); break; } }
    }
    nloc = mine > 0u ? mine : 1u; nx = cnt > 0u ? cnt : 1u;
}
__device__ __forceinline__ void xcd_barrier(unsigned* bar, volatile LAS unsigned* st, bool leader, unsigned G) {
    asm volatile("s_waitcnt vmcnt(0)" ::: "memory");
    __syncthreads();
    if (leader) {
        __builtin_amdgcn_s_waitcnt(0);
        const unsigned x = xb_xcc_id();
        unsigned nloc = st[0], nx = st[1];
        if (nloc == 0u) { xcd_barrier_complete(bar, x, G, nloc, nx); st[0] = nloc; st[1] = nx; }
        const unsigned old = xb_add(&bar[XB_XSUB(x)], 1u);
        const unsigned gen = old / nloc;
        if (old + 1u == (gen + 1u) * nloc) {
            __builtin_amdgcn_fence(__ATOMIC_RELEASE, "agent");
            asm volatile("s_waitcnt vmcnt(0)" ::: "memory");
            const unsigned og = xb_add(&bar[XB_TOP], 1u);
            const unsigned tg = og / nx;
            if (og + 1u == (tg + 1u) * nx) xb_add(&bar[XB_TOPGEN], 1u);
            else XB_SPIN(xb_ld(&bar[XB_TOPGEN]) == tg, bar);
            __builtin_amdgcn_fence(__ATOMIC_ACQUIRE, "agent");
            xb_add(&bar[XB_XGEN(x)], 1u);
            asm volatile("s_waitcnt vmcnt(0)" ::: "memory");
        } else {
            XB_SPIN(xb_ld(&bar[XB_XGEN(x)]) == gen, bar);
            __builtin_amdgcn_fence(__ATOMIC_ACQUIRE, "agent");
            asm volatile("s_waitcnt vmcnt(0)" ::: "memory");
        }
    }
    __syncthreads();
}

typedef const __attribute__((address_space(4))) Params* PP;
__device__ __forceinline__ const float* grp_x(PP p, int g) { return g == 0 ? p->x_prompt : p->x_sample; }

__device__ __forceinline__ void run_phase(const Ctx cx, PP p, int ph, LAS unsigned char* lds) {
    unsigned char* ws = p->ws;
    bf16_t* WinT = (bf16_t*)(ws + WS_WIN); bf16_t* WpT = (bf16_t*)(ws + WS_WPOOL); bf16_t* WaT = (bf16_t*)(ws + WS_WA); bf16_t* WbT = (bf16_t*)(ws + WS_WB);
    bf16_t* WoT = (bf16_t*)(ws + WS_WO); bf16_t* WguT = (bf16_t*)(ws + WS_WGU); bf16_t* WdT = (bf16_t*)(ws + WS_WD);
    bf16_t* HF8 = (bf16_t*)(ws + WS_HF8); bf16_t* HF4 = (bf16_t*)(ws + WS_HF4); bf16_t* W3T = (bf16_t*)(ws + WS_W3T); f32x2* FS8 = (f32x2*)(ws + WS_FS8); f32x2* FS4 = (f32x2*)(ws + WS_FS4);
    f32x2* Z1 = (f32x2*)(ws + WS_Z1) + (size_t)cx.bid * 8192;
    bf16_t* H = (bf16_t*)(ws + WS_H); bf16_t* UP = (bf16_t*)(ws + WS_UP); bf16_t* G = (bf16_t*)(ws + WS_G); bf16_t* UH = (bf16_t*)(ws + WS_UH);
    bf16_t* PL = (bf16_t*)(ws + WS_PL); bf16_t* BT = (bf16_t*)(ws + WS_BT); bf16_t* AB = (bf16_t*)(ws + WS_AB); bf16_t* ACT = (bf16_t*)(ws + WS_ACT);
    if (EN(100) && ph == 0) {
        LAS float* tile = (LAS float*)lds;
        for (int job = 0; job < 11; ++job) {
            const float* s; int K, N, mode = 0, ldd = 0, koff = 0; bf16_t* d;
            switch (job) {
                case 0: s = p->w_in; K = 2048; N = 8192; d = WinT; mode = 1; break;
                case 1: s = p->w_a; K = 1024; N = 2048; d = WaT; ldd = 2048; break;
                case 2: s = p->w_b; K = 1024; N = 2048; d = WaT; ldd = 2048; koff = 1024; break;
                case 3: s = p->w_out; K = 2048; N = 2048; d = WoT; break;
                case 4: s = p->w_gate; K = 2048; N = DFF; d = WguT; mode = 2; break;
                case 5: s = p->w_up; K = 2048; N = DFF; d = WguT; mode = 3; break;
                case 6: s = p->w_down; K = DFF; N = 2048; d = WdT; break;
                default: s = p->pool_w + (size_t)(job - 7) * 65536; K = 256; N = 256; d = WpT + (size_t)(job - 7) * 65536; break;
            }
            transpose_cvt(cx, tile, s, K, N, d, mode, ldd ? ldd : K, koff);
        }
        for (int idx = cx.bid * 512 + cx.tid; idx < 262144; idx += cx.nblk * 512)
            W3T[idx] = (bf16_t)(cvt_pk_bf16(p->filt_w3[(size_t)(idx & 63) * 4096 + ((idx >> 6) & 3) * 1024 + (idx >> 8)], 0.f) & 0xffffu);
        for (int v = 0; v < 2; ++v)
            filter_features(cx, (LAS float*)lds, p->filt_w1, p->filt_b1, p->filt_f1, p->filt_w2, p->filt_b2, p->filt_f2, v ? 4096 : 8192, v ? HF4 : HF8);
        return;
    }
    if (EN(101) && ph == 1) {
        for (int v = 0; v < 2; ++v) filter_spectrum(cx, lds, W3T, v ? 4096 : 8192, v ? 13 : 14, v ? HF4 : HF8, v ? FS4 : FS8);
        rmsnorm_phase<false>(cx, grp_x(p, 0), p->g_mix, H, NTG);
        return;
    }
    const int g = (ph - 2) / 9, k = (ph - 2) % 9;
    const int L = g == 0 ? 8192 : 4096, logN2 = g == 0 ? 14 : 13, nb = g == 0 ? 4 : 8;
    float* outg = p->out + (size_t)g * NTG * DM;
    switch (k) {
        case 0: if (EN(0)) {
            Gemm ga{H, WinT, NTG, 5120, 2048, 2048, 2048, 0, WGM}; EpiUPG ea{UP, G}; gemm_phase(cx, lds, ga, ea);
            Gemm gb{WinT + (size_t)5120 * 2048, H, 3072, NTG, 2048, 2048, 2048, 0, 6}; EpiRaw eb{UH, NTG}; gemm_phase(cx, lds, gb, eb);
        } break;
        case 1: if (EN(1)) {
            hyena_phase(cx, lds, p->conv_w, p->conv_b, p->hyena_bias, L, logN2, nb, g == 0 ? FS8 : FS4, UH, BT, Z1);
            pool_phase(cx, UP, PL, L);
        } break;
        case 2: if (EN(2)) {
            Gemm gp{PL, WpT, NTG, 1024, 256, 1024, 256, 256, WGM}; EpiPool ep{AB, p->pool_scale}; gemm_phase(cx, lds, gp, ep);
            bt_transpose(cx, (LAS unsigned short*)lds, BT, AB);
        } break;
        case 3: if (EN(3)) {
            Gemm g1{AB, WaT, NTG, 2048, 2048, 2048, 2048, 0, WGM}; EpiMerge e1{G, H}; gemm_phase<EpiMerge, true>(cx, lds, g1, e1);
        } break;
        case 4: if (EN(4)) {
            Gemm go{H, WoT, NTG, 2048, 2048, 2048, 2048, 0, WGM}; EpiRes eo{grp_x(p, g), outg}; gemm_phase(cx, lds, go, eo);
        } break;
        case 5: if (EN(5)) rmsnorm_phase<false>(cx, outg, p->g_ffn, H, NTG); break;
        case 6: if (EN(6)) {
            Gemm gg{H, WguT, NTG, 11264, 2048, 2048, 2048, 0, 8}; EpiSwiGLU eg{ACT}; gemm_phase(cx, lds, gg, eg);
        } break;
        case 7: if (EN(7)) {
            Gemm gd{ACT, WdT, NTG, 2048, DFF, DFF, DFF, 0, WGM}; EpiRes ed{outg, outg}; gemm_phase(cx, lds, gd, ed);
        } break;
        case 8: if (EN(8)) {
            rmsnorm_phase<true>(cx, outg, p->g_final, outg, NTG);
            if (g + 1 < NGRP) rmsnorm_phase<false>(cx, grp_x(p, g + 1), p->g_mix, H, NTG);
        } break;
    }
}

__global__ __launch_bounds__(512, 2) void mega(Params p, int ph_lo, int ph_hi) {
    extern __shared__ __attribute__((aligned(16))) unsigned char smem_raw[];
    LAS unsigned char* lds = (LAS unsigned char*)smem_raw;
    const int wid_s = __builtin_amdgcn_readfirstlane((int)threadIdx.x >> 6);
    volatile LAS unsigned* bst = (volatile LAS unsigned*)(lds + LDS_X_BYTES + 1024);
    { unsigned* bar0 = (unsigned*)(((PP)__builtin_amdgcn_kernarg_segment_ptr())->ws + WS_BAR);
      if (threadIdx.x == 0) { bst[0] = 0u; bst[1] = 0u; (void)xb_add(&bar0[XB_XCNT(xb_xcc_id())], 1u); }
      __syncthreads(); }
    for (int ph = ph_lo; ph < ph_hi; ++ph) {
        int nrep = 1;
#ifdef PROBE_DUP
        if ((PROBE_DUP >= 100 && ph == PROBE_DUP - 100) || (PROBE_DUP < 100 && ph >= 2 && (ph - 2) % 9 == PROBE_DUP)) nrep = 2;
#endif
        for (int r = 0; r < nrep; ++r) {
            if (r) __syncthreads();
            PP pp = (PP)__builtin_amdgcn_kernarg_segment_ptr(); asm volatile("" : "+s"(pp));
            Ctx cx; cx.bid = blockIdx.x; cx.nblk = gridDim.x;
            { int lane_; asm volatile("v_mbcnt_lo_u32_b32 %0, -1, 0\n\tv_mbcnt_hi_u32_b32 %0, -1, %0" : "=&v"(lane_)); cx.tid = (wid_s << 6) | lane_; }
            asm volatile("" : "+v"(cx.tid)); asm volatile("" : "+s"(cx.bid)); asm volatile("" : "+s"(cx.nblk));
            run_phase(cx, pp, ph, lds);
        }
        if (ph + 1 < ph_hi) {
            if (ph_lo < 0) cg::this_grid().sync();
            { int lane_; asm volatile("v_mbcnt_lo_u32_b32 %0, -1, 0\n\tv_mbcnt_hi_u32_b32 %0, -1, %0" : "=&v"(lane_));
                   unsigned* bar = (unsigned*)(((PP)__builtin_amdgcn_kernarg_segment_ptr())->ws + WS_BAR);
                   xcd_barrier(bar, bst, wid_s == 0 && lane_ == 0, gridDim.x); }
        }
    }
}

extern "C" void kernel_launch(void* const* d_in, const int* in_sizes, int n_in, void* d_out, int out_size, void* d_ws, size_t ws_size, hipStream_t stream) {
    static int grid = 0;
    if (grid == 0) {
        if (n_in != 24 || ws_size < WS_END) { fprintf(stderr, "kernel_launch: unexpected n_in %d or ws_size %zu (< %zu)\n", n_in, ws_size, (size_t)WS_END); grid = -1; return; }
        int dev = 0, cus = 0, per_cu = 0;
        hipGetDevice(&dev); hipDeviceGetAttribute(&cus, hipDeviceAttributeMultiprocessorCount, dev);
        if (hipFuncSetAttribute((const void*)mega, hipFuncAttributeMaxDynamicSharedMemorySize, LDS_BYTES) != hipSuccess) { fprintf(stderr, "kernel_launch: hipFuncSetAttribute failed\n"); grid = -1; return; }
        if (hipOccupancyMaxActiveBlocksPerMultiprocessor(&per_cu, (const void*)mega, 512, LDS_BYTES) != hipSuccess || per_cu < 1) { fprintf(stderr, "kernel_launch: occupancy query says %d\n", per_cu); per_cu = 1; }
        (void)hipGetLastError();
        grid = cus; if (grid > 256) grid = 256; if (grid < 1) grid = 256;
    }
    if (grid < 0) return;
    Params p{};
    const float** pp = (const float**)&p;
    for (int i = 0; i < 24; ++i) pp[i] = (const float*)d_in[i];
    p.out = (float*)d_out; p.ws = (unsigned char*)d_ws;
    if (hipMemsetAsync((char*)d_ws + WS_BAR, 0, 16384, stream) != hipSuccess) { fprintf(stderr, "kernel_launch: memset of barrier words failed\n"); return; }
#if MULTI_LAUNCH
    for (int ph = 0; ph < NPH; ++ph) hipLaunchKernelGGL(mega, dim3(grid), dim3(512), LDS_BYTES, stream, p, ph, ph + 1);
#else
    int lo = 0, hi = NPH; void* args[] = {&p, &lo, &hi};
    hipError_t e = hipLaunchCooperativeKernel((const void*)mega, dim3(grid), dim3(512), args, LDS_BYTES, stream);
    if (e != hipSuccess) fprintf(stderr, "kernel_launch: cooperative launch failed: %s (grid %d)\n", hipGetErrorString(e), grid);
#endif
}
```

```cpp
#include <hip/hip_runtime.h>
#include <hip/hip_cooperative_groups.h>
#include <cstdio>
namespace cg = cooperative_groups;

#ifndef MULTI_LAUNCH
#define MULTI_LAUNCH 0
#endif

#ifndef ONLY
#define ONLY -1
#endif
#define EN(x) (ONLY == -1 || ONLY == (x))
#define LAS __attribute__((address_space(3)))
typedef unsigned short bf16_t;
typedef short bf16x8 __attribute__((ext_vector_type(8)));
typedef float f32x4 __attribute__((ext_vector_type(4)));
typedef float f32x2 __attribute__((ext_vector_type(2)));
typedef unsigned u32x4 __attribute__((ext_vector_type(4)));
typedef unsigned u32x2 __attribute__((ext_vector_type(2)));

constexpr int DM = 2048, DFF = 5632, NTG = 32768, NGRP = 2;
constexpr int BM = 256, BK = 64, HALF = 128, HTB = HALF * BK * 2, NXCD = 8, WGM = 4;
constexpr int XPAD_ELEMS = 16384 + 512 * 5;
constexpr int LDS_X_BYTES = XPAD_ELEMS * 8;
constexpr int LDS_BYTES = LDS_X_BYTES + 2048;
constexpr int NPH = 2 + NGRP * 9;

constexpr size_t WS_WIN = 0;
constexpr size_t WS_WPOOL = WS_WIN + (size_t)8192 * 2048 * 2;
constexpr size_t WS_WA = WS_WPOOL + (size_t)1024 * 256 * 2;
constexpr size_t WS_WB = WS_WA + (size_t)2048 * 1024 * 2;
constexpr size_t WS_WO = WS_WB + (size_t)2048 * 1024 * 2;
constexpr size_t WS_WGU = WS_WO + (size_t)2048 * 2048 * 2;
constexpr size_t WS_WD = WS_WGU + (size_t)11264 * 2048 * 2;
constexpr size_t WS_HF8 = WS_WD + (size_t)2048 * 5632 * 2;
constexpr size_t WS_HF4 = WS_HF8 + (size_t)8192 * 64 * 4;
constexpr size_t WS_FS8 = WS_HF4 + (size_t)4096 * 64 * 4;
constexpr size_t WS_FS4 = WS_FS8 + (size_t)1024 * 16384 * 8;
constexpr size_t WS_Z1 = WS_FS4 + (size_t)1024 * 8192 * 8;
constexpr size_t WS_H = WS_Z1 + (size_t)256 * 65536;
constexpr size_t WS_UP = WS_H + (size_t)NTG * 2048 * 2;
constexpr size_t WS_G = WS_UP + (size_t)NTG * 1024 * 2;
constexpr size_t WS_UH = WS_G + (size_t)NTG * 4096 * 2;
constexpr size_t WS_W3T = WS_UH + (size_t)3072 * NTG * 2;
constexpr size_t WS_BAR = WS_W3T + (size_t)1024 * 256 * 2;
constexpr size_t WS_END = WS_BAR + 16384;
constexpr size_t WS_PL = WS_H;
constexpr size_t WS_BT = WS_H + (size_t)NTG * 1024 * 2;
constexpr size_t WS_AB = WS_UH;
constexpr size_t WS_ACT = WS_G;
static_assert((size_t)NTG * DFF * 2 <= (size_t)NTG * 4096 * 2 + (size_t)3072 * NTG * 2, "ACT must fit in G|UH");

struct Params {
    const float* x_prompt; const float* x_sample; const float* g_mix; const float* w_in; const float* pool_w; const float* pool_scale;
    const float* conv_w; const float* conv_b; const float* filt_w1; const float* filt_b1; const float* filt_f1; const float* filt_w2;
    const float* filt_b2; const float* filt_f2; const float* filt_w3; const float* hyena_bias; const float* w_a; const float* w_b;
    const float* w_out; const float* g_ffn; const float* w_gate; const float* w_up; const float* w_down; const float* g_final;
    float* out; unsigned char* ws;
};

struct Ctx { int tid, bid, nblk; };
__device__ __forceinline__ float bf2f(unsigned short b) { return __uint_as_float(((unsigned)b) << 16); }
__device__ __forceinline__ unsigned cvt_pk_bf16(float lo, float hi) { unsigned r; asm volatile("v_cvt_pk_bf16_f32 %0, %1, %2" : "=v"(r) : "v"(lo), "v"(hi)); return r; }
__device__ __forceinline__ float sigmoidf_(float v) { return __builtin_amdgcn_rcpf(1.0f + __builtin_amdgcn_exp2f(-1.4426950408889634f * v)); }
__device__ __forceinline__ float wave_sum(int tid, float v) {
#pragma unroll
    for (int o = 32; o > 0; o >>= 1) v += __int_as_float(__builtin_amdgcn_ds_bpermute(((tid ^ o) & 63) << 2, __float_as_int(v)));
    return v;
}

__device__ __forceinline__ int lds_byte(int r, int c) { const int st = (r >> 4) * 2 + (c >> 5), rr = r & 15, cc = c & 31, ob = rr * 64 + cc * 2; return st * 1024 + (ob ^ (((ob >> 9) & 1) << 5)); }
__device__ __forceinline__ void stage_rc(int b, int& R, int& C) { const int st = b / 1024, sb = b % 1024, swz = sb ^ (((sb >> 9) & 1) << 5); R = (st >> 1) * 16 + swz / 64; C = (st & 1) * 32 + (swz % 64) / 2; }
__device__ __forceinline__ int perm32(int rho) { const int n = rho >> 4, i = rho & 15; return 8 * (i >> 2) + 4 * n + (i & 3); }

struct Unit { int pm, pn; };
struct Gemm { const bf16_t* A; const bf16_t* Bt; int M, N, K, lda, ldb, a_pn_step, wgm; };

struct StaticOrder {
    int nM, nN, nwg, G, c, wgm;
    __device__ __forceinline__ void init(int M, int N, int G_, int c_, int wgm_) { nM = M / BM; nN = N / BM; nwg = nM * nN; G = G_; c = c_; wgm = wgm_; }
    __device__ __forceinline__ bool next(int i, Unit& u) const {
        const long L = (long)i * G + c; if (L >= nwg) return false;
        int wgid = (int)L; { const int q = nwg / NXCD, r = nwg % NXCD, xcd = wgid % NXCD, off = wgid / NXCD; wgid = (xcd < r ? xcd * (q + 1) : r * (q + 1) + (xcd - r) * q) + off; }
        const int nig = wgm * nN, gid = wgid / nig, fm = gid * wgm, gsz = (nM - fm) < wgm ? (nM - fm) : wgm;
        u.pm = fm + ((wgid % nig) % gsz); u.pn = (wgid % nig) / gsz; return true;
    }
};

template <class Epi, bool MID = false>
__device__ __forceinline__ void gemm_phase(const Ctx cx, LAS unsigned char* lds, const Gemm g, const Epi& E) {
    const int tid = cx.tid, wid = __builtin_amdgcn_readfirstlane(tid >> 6), lane = tid & 63, wr = wid >> 2, wc = wid & 3, fr = lane & 15, fq = lane >> 4;
    const int K = g.K, nt = K / BK;
    StaticOrder S; S.init(g.M, g.N, cx.nblk, cx.bid, g.wgm);
    unsigned voffA[2], voffB[2];
#pragma unroll
    for (int i = 0; i < 2; ++i) { int R, C; stage_rc(tid * 16 + i * 8192, R, C); const int Rb = Epi::PERM ? ((R & ~31) + perm32(R & 31)) : R;
        voffA[i] = (unsigned)(R * g.lda + C) * 2u; voffB[i] = (unsigned)(Rb * g.ldb + C) * 2u; }
    const size_t kstep = (size_t)(BK * 2);
    const size_t hstepA = (size_t)HALF * g.lda * 2, hstepB = (size_t)HALF * g.ldb * 2;
    const size_t tstepA = 2 * hstepA, tstepB = 2 * hstepB;
    const unsigned ldsw = (unsigned)wid * 1024u;
    const int aoff = lds_byte(wr * 64 + fr, fq * 8), boff = lds_byte(wc * 32 + fr, fq * 8);
#define PG8_SA(b, h) (((b) * 2 + (h)) * HTB)
#define PG8_SB(b, h) ((4 + (b) * 2 + (h)) * HTB)
#define PG8_STAGE(bufoff, gbase, voff) do { _Pragma("unroll") for (int _i = 0; _i < 2; ++_i) \
        __builtin_amdgcn_global_load_lds((const unsigned*)((const char*)(gbase) + (voff)[_i]), (LAS unsigned*)(lds + (bufoff) + ldsw + _i * 8192), 16, 0, 0); } while (0)
#define PG8_LDA(dst, b, h) do { _Pragma("unroll") for (int m = 0; m < 4; ++m) _Pragma("unroll") for (int k = 0; k < 2; ++k) dst[m][k] = *(const LAS bf16x8*)(lds + PG8_SA(b, h) + aoff + m * 2048 + k * 1024); } while (0)
#define PG8_LDB(dst, b, h) do { _Pragma("unroll") for (int n = 0; n < 2; ++n) _Pragma("unroll") for (int k = 0; k < 2; ++k) dst[n][k] = *(const LAS bf16x8*)(lds + PG8_SB(b, h) + boff + n * 2048 + k * 1024); } while (0)
#define PG8_MMA(ai, bj, At, Bt) do { __builtin_amdgcn_s_setprio(1); _Pragma("unroll") for (int m = 0; m < 4; ++m) _Pragma("unroll") for (int n = 0; n < 2; ++n) _Pragma("unroll") for (int k = 0; k < 2; ++k) \
        acc[ai][bj][m][n] = __builtin_amdgcn_mfma_f32_16x16x32_bf16(Bt[n][k], At[m][k], acc[ai][bj][m][n], 0, 0, 0); __builtin_amdgcn_s_setprio(0); } while (0)
#define PG8_WAIT_V(n) asm volatile("s_waitcnt vmcnt(" #n ")" ::: "memory")
#define PG8_WAIT_L(n) asm volatile("s_waitcnt lgkmcnt(" #n ")" ::: "memory")
#define PG8_BAR __builtin_amdgcn_s_barrier()
#define PG8_SCHED __builtin_amdgcn_sched_barrier(0)
    Unit cur, nxt; int ui = 0;
    if (!S.next(0, cur)) return;
    f32x4 acc[2][2][4][2];
#pragma unroll
    for (int a = 0; a < 2; ++a)
#pragma unroll
        for (int b = 0; b < 2; ++b)
#pragma unroll
            for (int m = 0; m < 4; ++m)
#pragma unroll
                for (int n = 0; n < 2; ++n) acc[a][b][m][n] = (f32x4){0.f, 0.f, 0.f, 0.f};
    bf16x8 At[4][2], B0[2][2], B1[2][2];
    const char* cA = (const char*)g.A + (size_t)cur.pm * tstepA + (size_t)cur.pn * (size_t)g.a_pn_step * 2; const char* cB = (const char*)g.Bt + (size_t)cur.pn * tstepB;
    PG8_STAGE(PG8_SB(0, 0), cB, voffB); PG8_STAGE(PG8_SA(0, 0), cA, voffA); PG8_STAGE(PG8_SB(0, 1), cB + hstepB, voffB); PG8_STAGE(PG8_SA(0, 1), cA + hstepA, voffA);
    if (wr == 1) PG8_BAR;
    PG8_WAIT_V(4); PG8_BAR;
    PG8_STAGE(PG8_SB(1, 0), cB + kstep, voffB); PG8_STAGE(PG8_SA(1, 0), cA + kstep, voffA); PG8_STAGE(PG8_SB(1, 1), cB + hstepB + kstep, voffB);
    PG8_WAIT_V(6); PG8_BAR;
    for (;;) {
        const bool has_next = S.next(ui + 1, nxt);
        const char* nA = has_next ? (const char*)g.A + (size_t)nxt.pm * tstepA + (size_t)nxt.pn * (size_t)g.a_pn_step * 2 : cA; const char* nB = has_next ? (const char*)g.Bt + (size_t)nxt.pn * tstepB : cB;
        for (int t = 0; t < nt; t += 2) {
            const bool last = (t == nt - 2);
            const char* a1 = cA + (size_t)(t + 1) * kstep;
            const char* a2 = last ? nA : cA + (size_t)(t + 2) * kstep; const char* b2 = last ? nB : cB + (size_t)(t + 2) * kstep;
            const char* a3 = a2 + kstep; const char* b3 = b2 + kstep;
            if constexpr (MID) if (t == (nt >> 1)) { int fr_ = fr, fq_ = fq; asm volatile("" : "+v"(fr_), "+v"(fq_)); E.mid(acc, cur, wr, wc, fr_, fq_); }
            PG8_LDB(B0, 0, 0); PG8_SCHED; PG8_LDA(At, 0, 0); PG8_STAGE(PG8_SA(1, 1), a1 + hstepA, voffA);
            PG8_WAIT_L(8); PG8_BAR; PG8_WAIT_L(0); PG8_MMA(0, 0, At, B0); PG8_BAR; PG8_SCHED;
            PG8_LDB(B1, 0, 1); PG8_STAGE(PG8_SB(0, 0), b2, voffB);
            PG8_BAR; PG8_WAIT_L(0); PG8_MMA(0, 1, At, B1); PG8_BAR;
            PG8_LDA(At, 0, 1); PG8_STAGE(PG8_SA(0, 0), a2, voffA);
            PG8_BAR; PG8_WAIT_L(0); PG8_MMA(1, 0, At, B0); PG8_BAR; PG8_SCHED;
            PG8_STAGE(PG8_SB(0, 1), b2 + hstepB, voffB);
            PG8_WAIT_V(6); PG8_BAR; PG8_MMA(1, 1, At, B1); PG8_BAR;
            PG8_LDB(B0, 1, 0); PG8_SCHED; PG8_LDA(At, 1, 0); PG8_STAGE(PG8_SA(0, 1), a2 + hstepA, voffA);
            PG8_WAIT_L(8); PG8_BAR; PG8_WAIT_L(0); PG8_MMA(0, 0, At, B0); PG8_BAR; PG8_SCHED;
            PG8_LDB(B1, 1, 1); PG8_STAGE(PG8_SB(1, 0), b3, voffB);
            PG8_BAR; PG8_WAIT_L(0); PG8_MMA(0, 1, At, B1); PG8_BAR;
            PG8_LDA(At, 1, 1); PG8_STAGE(PG8_SA(1, 0), a3, voffA);
            PG8_BAR; PG8_WAIT_L(0); PG8_MMA(1, 0, At, B0); PG8_BAR; PG8_SCHED;
            PG8_STAGE(PG8_SB(1, 1), b3 + hstepB, voffB);
            PG8_WAIT_V(6); PG8_BAR; PG8_MMA(1, 1, At, B1); PG8_BAR;
        }
        { int fr_ = fr, fq_ = fq; asm volatile("" : "+v"(fr_), "+v"(fq_));
          E(acc, cur, wr, wc, fr_, fq_); }
        if (!has_next) break;
#pragma unroll
        for (int a = 0; a < 2; ++a)
#pragma unroll
            for (int b = 0; b < 2; ++b)
#pragma unroll
                for (int m = 0; m < 4; ++m)
#pragma unroll
                    for (int n = 0; n < 2; ++n) acc[a][b][m][n] = (f32x4){0.f, 0.f, 0.f, 0.f};
        cur = nxt; cA = nA; cB = nB; ++ui;
    }
    PG8_WAIT_V(0);
    if (wr == 0) PG8_BAR;
    PG8_BAR;
#undef PG8_SA
#undef PG8_SB
#undef PG8_STAGE
#undef PG8_LDA
#undef PG8_LDB
#undef PG8_MMA
#undef PG8_WAIT_V
#undef PG8_WAIT_L
#undef PG8_BAR
#undef PG8_SCHED
}

typedef const f32x4 (&AccRef)[2][2][4][2];
__device__ __forceinline__ u32x4 pack8(f32x4 v0, f32x4 v1) { u32x4 w; w.x = cvt_pk_bf16(v0[0], v0[1]); w.y = cvt_pk_bf16(v0[2], v0[3]); w.z = cvt_pk_bf16(v1[0], v1[1]); w.w = cvt_pk_bf16(v1[2], v1[3]); return w; }
__device__ __forceinline__ void unpack8(u32x4 w, f32x4& v0, f32x4& v1) {
    v0[0] = __uint_as_float(w.x << 16); v0[1] = __uint_as_float(w.x & 0xffff0000u); v0[2] = __uint_as_float(w.y << 16); v0[3] = __uint_as_float(w.y & 0xffff0000u);
    v1[0] = __uint_as_float(w.z << 16); v1[1] = __uint_as_float(w.z & 0xffff0000u); v1[2] = __uint_as_float(w.w << 16); v1[3] = __uint_as_float(w.w & 0xffff0000u);
}

struct EpiUPG {
    static constexpr bool PERM = true; bf16_t* UP; bf16_t* G;
    __device__ __forceinline__ void operator()(AccRef acc, const Unit& u, int wr, int wc, int fr, int fq) const {
        const int row0 = u.pm * BM + wr * 64 + fr; const bool sg = u.pn >= 4;
        bf16_t* base = sg ? G : UP; const int ldc = sg ? 4096 : 1024; const int col0 = (sg ? u.pn * BM - 1024 : u.pn * BM) + wc * 32 + 8 * fq;
#pragma unroll
        for (int ai = 0; ai < 2; ++ai)
#pragma unroll
            for (int m = 0; m < 4; ++m) { bf16_t* rowp = base + (size_t)(row0 + ai * HALF + m * 16) * ldc + col0;
#pragma unroll
                for (int bj = 0; bj < 2; ++bj) { f32x4 v0 = acc[ai][bj][m][0], v1 = acc[ai][bj][m][1];
                    if (sg) {
#pragma unroll
                        for (int j = 0; j < 4; ++j) { v0[j] = sigmoidf_(v0[j]); v1[j] = sigmoidf_(v1[j]); } }
                    *(u32x4*)(rowp + bj * HALF) = pack8(v0, v1); }
                __builtin_amdgcn_sched_barrier(0); }
    }
};
struct EpiRaw {
    static constexpr bool PERM = true; bf16_t* O; int ldc;
    __device__ __forceinline__ void operator()(AccRef acc, const Unit& u, int wr, int wc, int fr, int fq) const {
        const int row0 = u.pm * BM + wr * 64 + fr; const int col0 = u.pn * BM + wc * 32 + 8 * fq;
#pragma unroll
        for (int ai = 0; ai < 2; ++ai)
#pragma unroll
            for (int m = 0; m < 4; ++m) { bf16_t* rowp = O + (size_t)(row0 + ai * HALF + m * 16) * ldc + col0;
#pragma unroll
                for (int bj = 0; bj < 2; ++bj) *(u32x4*)(rowp + bj * HALF) = pack8(acc[ai][bj][m][0], acc[ai][bj][m][1]);
                __builtin_amdgcn_sched_barrier(0); }
    }
};
struct EpiPool {
    static constexpr bool PERM = true; bf16_t* O; const float* scale;
    __device__ __forceinline__ void operator()(AccRef acc, const Unit& u, int wr, int wc, int fr, int fq) const {
        const int row0 = u.pm * BM + wr * 64 + fr; const int col0 = u.pn * BM + wc * 32 + 8 * fq;
        f32x4 s[2][2];
#pragma unroll
        for (int bj = 0; bj < 2; ++bj) { s[bj][0] = *(const f32x4*)(scale + col0 + bj * HALF); s[bj][1] = *(const f32x4*)(scale + col0 + bj * HALF + 4); }
#pragma unroll
        for (int ai = 0; ai < 2; ++ai)
#pragma unroll
            for (int m = 0; m < 4; ++m) { bf16_t* rowp = O + (size_t)(row0 + ai * HALF + m * 16) * 2048 + col0;
#pragma unroll
                for (int bj = 0; bj < 2; ++bj) *(u32x4*)(rowp + bj * HALF) = pack8(acc[ai][bj][m][0] * s[bj][0], acc[ai][bj][m][1] * s[bj][1]);
                __builtin_amdgcn_sched_barrier(0); }
    }
};
template <bool ADD> struct EpiGate {
    static constexpr bool PERM = true; const bf16_t* Gt; const bf16_t* T; bf16_t* O;
    __device__ __forceinline__ void operator()(AccRef acc, const Unit& u, int wr, int wc, int fr, int fq) const {
        const int row0 = u.pm * BM + wr * 64 + fr; const int col0 = u.pn * BM + wc * 32 + 8 * fq;
#pragma unroll
        for (int ai = 0; ai < 2; ++ai) {
            u32x4 gw[4][2], tw[4][2];
#pragma unroll
            for (int m = 0; m < 4; ++m)
#pragma unroll
                for (int bj = 0; bj < 2; ++bj) { const size_t row = (size_t)(row0 + ai * HALF + m * 16);
                    gw[m][bj] = *(const u32x4*)(Gt + row * 4096 + col0 + bj * HALF);
                    if (ADD) tw[m][bj] = *(const u32x4*)(T + row * 2048 + col0 + bj * HALF); }
#pragma unroll
            for (int m = 0; m < 4; ++m)
#pragma unroll
                for (int bj = 0; bj < 2; ++bj) { const size_t row = (size_t)(row0 + ai * HALF + m * 16);
                    f32x4 g0, g1; unpack8(gw[m][bj], g0, g1);
                    f32x4 v0 = acc[ai][bj][m][0] * g0, v1 = acc[ai][bj][m][1] * g1;
                    if (ADD) { f32x4 t0, t1; unpack8(tw[m][bj], t0, t1); v0 += t0; v1 += t1; }
                    *(u32x4*)(O + row * 2048 + col0 + bj * HALF) = pack8(v0, v1); }
            __builtin_amdgcn_sched_barrier(0);
        }
    }
};
struct EpiMerge {
    static constexpr bool PERM = true; const bf16_t* G; bf16_t* O;
    __device__ __forceinline__ void mid(f32x4 (&acc)[2][2][4][2], const Unit& u, int wr, int wc, int fr, int fq) const {
        const int row0 = u.pm * BM + wr * 64 + fr; const int col0 = u.pn * BM + wc * 32 + 8 * fq;
        u32x4 ga[2][2][2], gb[2][2][2];
#define MRG_LOAD(buf, k) do { _Pragma("unroll") for (int mm = 0; mm < 2; ++mm) _Pragma("unroll") for (int bj = 0; bj < 2; ++bj) { \
            const bf16_t* gp = G + (size_t)(row0 + ((k) >> 1) * HALF + (((k) & 1) * 2 + mm) * 16) * 4096 + col0 + bj * HALF; \
            ga[buf][mm][bj] = *(const u32x4*)gp; gb[buf][mm][bj] = *(const u32x4*)(gp + 2048); } } while (0)
        MRG_LOAD(0, 0);
#pragma unroll
        for (int k = 0; k < 4; ++k) {
            if (k < 3) MRG_LOAD((k + 1) & 1, k + 1);
            const int ai = k >> 1, mp = k & 1;
#pragma unroll
            for (int mm = 0; mm < 2; ++mm)
#pragma unroll
                for (int bj = 0; bj < 2; ++bj) { f32x4 a0, a1, b0, b1; unpack8(ga[k & 1][mm][bj], a0, a1); unpack8(gb[k & 1][mm][bj], b0, b1);
#pragma unroll
                    for (int j = 0; j < 4; ++j) { acc[ai][bj][mp * 2 + mm][0][j] *= a0[j] * __builtin_amdgcn_rcpf(b0[j]); acc[ai][bj][mp * 2 + mm][1][j] *= a1[j] * __builtin_amdgcn_rcpf(b1[j]); } }
            __builtin_amdgcn_sched_barrier(0);
        }
#undef MRG_LOAD
    }
    __device__ __forceinline__ void operator()(AccRef acc, const Unit& u, int wr, int wc, int fr, int fq) const {
        const int row0 = u.pm * BM + wr * 64 + fr; const int col0 = u.pn * BM + wc * 32 + 8 * fq;
#pragma unroll
        for (int ai = 0; ai < 2; ++ai) {
            u32x4 gw[4][2];
#pragma unroll
            for (int m = 0; m < 4; ++m)
#pragma unroll
                for (int bj = 0; bj < 2; ++bj) gw[m][bj] = *(const u32x4*)(G + (size_t)(row0 + ai * HALF + m * 16) * 4096 + 2048 + col0 + bj * HALF);
#pragma unroll
            for (int m = 0; m < 4; ++m)
#pragma unroll
                for (int bj = 0; bj < 2; ++bj) { f32x4 g0, g1; unpack8(gw[m][bj], g0, g1);
                    *(u32x4*)(O + (size_t)(row0 + ai * HALF + m * 16) * 2048 + col0 + bj * HALF) = pack8(acc[ai][bj][m][0] * g0, acc[ai][bj][m][1] * g1); }
            __builtin_amdgcn_sched_barrier(0);
        }
    }
};
struct EpiRes {
    static constexpr bool PERM = false; const float* R; float* O;
    __device__ __forceinline__ void operator()(AccRef acc, const Unit& u, int wr, int wc, int fr, int fq) const {
        const int row0 = u.pm * BM + wr * 64 + fr; const int col0 = u.pn * BM + wc * 32 + 4 * fq;
#pragma unroll
        for (int ai = 0; ai < 2; ++ai) {
            f32x4 r[4][2][2];
#pragma unroll
            for (int m = 0; m < 4; ++m)
#pragma unroll
                for (int bj = 0; bj < 2; ++bj)
#pragma unroll
                    for (int n = 0; n < 2; ++n) r[m][bj][n] = *(const f32x4*)(R + (size_t)(row0 + ai * HALF + m * 16) * 2048 + col0 + bj * HALF + n * 16);
#pragma unroll
            for (int m = 0; m < 4; ++m)
#pragma unroll
                for (int bj = 0; bj < 2; ++bj)
#pragma unroll
                    for (int n = 0; n < 2; ++n) *(f32x4*)(O + (size_t)(row0 + ai * HALF + m * 16) * 2048 + col0 + bj * HALF + n * 16) = r[m][bj][n] + acc[ai][bj][m][n];
            __builtin_amdgcn_sched_barrier(0);
        }
    }
};
struct EpiSwiGLU {
    static constexpr bool PERM = true; bf16_t* O;
    __device__ __forceinline__ void operator()(AccRef acc, const Unit& u, int wr, int wc, int fr, int fq) const {
        const int row0 = u.pm * BM + wr * 64 + fr; const int col0 = u.pn * HALF + wc * 32 + 8 * fq;
#pragma unroll
        for (int ai = 0; ai < 2; ++ai)
#pragma unroll
            for (int m = 0; m < 4; ++m) { f32x4 v0, v1;
#pragma unroll
                for (int j = 0; j < 4; ++j) { const float a0 = acc[ai][0][m][0][j], a1 = acc[ai][0][m][1][j];
                    v0[j] = a0 * sigmoidf_(a0) * acc[ai][1][m][0][j]; v1[j] = a1 * sigmoidf_(a1) * acc[ai][1][m][1][j]; }
                *(u32x4*)(O + (size_t)(row0 + ai * HALF + m * 16) * DFF + col0) = pack8(v0, v1);
                __builtin_amdgcn_sched_barrier(0); }
    }
};

__device__ __forceinline__ int rowmap(int mode, int n) {
    switch (mode) {
        case 1: return n < 1024 ? n : (n < 4096 ? n + 4096 : n - 3072);
        case 2: return ((n >> 7) << 8) + (n & 127);
        case 3: return ((n >> 7) << 8) + 128 + (n & 127);
        default: return n;
    }
}
__device__ __forceinline__ void transpose_cvt(const Ctx cx, LAS float* tile, const float* src, int K, int N, bf16_t* dst, int mode, int ldd, int koff) {
    constexpr int TB = 4;
    const int tid = cx.tid; const int tn = N >> 6, ntile = (K >> 6) * tn;
    for (int t4 = cx.bid * TB; t4 < ntile; t4 += cx.nblk * TB) {
        f32x4 v[TB][2];
#pragma unroll
        for (int u = 0; u < TB; ++u) { const int t = t4 + u, k0 = (t / tn) << 6, n0 = (t % tn) << 6;
#pragma unroll
            for (int i = 0; i < 2; ++i) { const int kk = (tid >> 4) + i * 32, nc = (tid & 15) << 2; v[u][i] = *(const f32x4*)(src + (size_t)(k0 + kk) * N + n0 + nc); } }
#pragma unroll
        for (int u = 0; u < TB; ++u)
#pragma unroll
            for (int i = 0; i < 2; ++i) { const int kk = (tid >> 4) + i * 32, nc = (tid & 15) << 2; LAS float* tp = tile + u * (64 * 65) + kk * 65 + nc;
                tp[0] = v[u][i][0]; tp[1] = v[u][i][1]; tp[2] = v[u][i][2]; tp[3] = v[u][i][3]; }
        __syncthreads();
#pragma unroll
        for (int u = 0; u < TB; ++u) { const int t = t4 + u, k0 = (t / tn) << 6, n0 = (t % tn) << 6;
            const int nn = tid >> 3, kc = (tid & 7) << 3; f32x4 a, b; const LAS float* tp = tile + u * (64 * 65);
#pragma unroll
            for (int j = 0; j < 4; ++j) { a[j] = tp[(kc + j) * 65 + nn]; b[j] = tp[(kc + 4 + j) * 65 + nn]; }
            *(u32x4*)(dst + (size_t)rowmap(mode, n0 + nn) * ldd + koff + k0 + kc) = pack8(a, b); }
        __syncthreads();
    }
}

__device__ __forceinline__ void filter_features(const Ctx cx, LAS float* sm, const float* fw1, const float* fb1, const float* ff1, const float* fw2, const float* fb2, const float* ff2, int L, bf16_t* Hfb) {
    const int tid = cx.tid, tt = tid >> 6, j = tid & 63;
    LAS float* zf = sm; LAS float* h1s = sm + 8 * 36;
    const float b1 = fb1[j], f1 = ff1[j], b2 = fb2[j], f2 = ff2[j];
    for (int t0 = cx.bid * 8; t0 < L; t0 += cx.nblk * 8) {
        const int t = t0 + tt;
        if (j < 33) { float z;
            if (j == 0) z = (float)t / (float)(L - 1);
            else { const int k = (j - 1) & 15; const float band = 1e-4f + (float)k * ((15.0f - 1e-4f) / 15.0f);
                double rv = (double)band * (double)t / (double)L; rv -= floor(rv); const float r = (float)rv;
                z = (j <= 16) ? __builtin_amdgcn_cosf(r) : -__builtin_amdgcn_sinf(r); }
            zf[tt * 36 + j] = z; }
        __syncthreads();
        { float a = b1; for (int i = 0; i < 33; ++i) a += zf[tt * 36 + i] * fw1[i * 64 + j];
          h1s[tt * 64 + j] = __builtin_amdgcn_sinf(f1 * a * 0.15915494309189535f); }
        __syncthreads();
        { float a = b2; for (int i = 0; i < 64; ++i) a += h1s[tt * 64 + i] * fw2[i * 64 + j];
          Hfb[(size_t)t * 64 + j] = (bf16_t)(cvt_pk_bf16(__builtin_amdgcn_sinf(f2 * a * 0.15915494309189535f), 0.f) & 0xffffu); }
        __syncthreads();
    }
}

__device__ __forceinline__ int PX(int i) { const int h = i >> 5; return i + h + (h << 2); }
__device__ __forceinline__ f32x2 cmul(f32x2 a, f32x2 b) { return (f32x2){a.x * b.x - a.y * b.y, a.x * b.y + a.y * b.x}; }
__device__ __forceinline__ f32x2 cis_rev(float rev) { return (f32x2){__builtin_amdgcn_cosf(rev), __builtin_amdgcn_sinf(rev)}; }
__device__ __forceinline__ f32x2 rot8(f32x2 v, int k, bool inv) {
    const float c = 0.70710678118654752f;
    if (!inv) { switch (k) { case 1: return (f32x2){c * (v.x + v.y), c * (v.y - v.x)}; case 2: return (f32x2){v.y, -v.x}; case 3: return (f32x2){c * (v.y - v.x), -c * (v.x + v.y)}; default: return v; } }
    else      { switch (k) { case 1: return (f32x2){c * (v.x - v.y), c * (v.x + v.y)}; case 2: return (f32x2){-v.y, v.x}; case 3: return (f32x2){-c * (v.x + v.y), c * (v.x - v.y)}; default: return v; } }
}
template <int LOGR> __device__ __forceinline__ void dif_bfly(f32x2 (&v)[1 << LOGR], int r, int logm) {
    constexpr int R = 1 << LOGR;
    f32x2 W = cis_rev(-(float)r * __uint_as_float((unsigned)(126 - logm) << 23));
#pragma unroll
    for (int s = 0; s < LOGR; ++s) {
        const int half = R >> (s + 1);
#pragma unroll
        for (int q = 0; q < R; ++q) if ((q & half) == 0) {
            const int qq = q & (half - 1);
            const f32x2 a = v[q], b = v[q + half];
            v[q] = a + b;
            v[q + half] = rot8(cmul(a - b, W), (qq << s) * (8 / R), false);
        }
        W = cmul(W, W);
    }
}
template <int LOGR> __device__ __forceinline__ void dit_bfly(f32x2 (&v)[1 << LOGR], int r, int logm0) {
    constexpr int R = 1 << LOGR;
    f32x2 Wt[LOGR];
    Wt[LOGR - 1] = cis_rev((float)r * __uint_as_float((unsigned)(127 - (logm0 + LOGR)) << 23));
#pragma unroll
    for (int s = LOGR - 2; s >= 0; --s) Wt[s] = cmul(Wt[s + 1], Wt[s + 1]);
#pragma unroll
    for (int s = 0; s < LOGR; ++s) {
        const int half = 1 << s;
        const f32x2 W = Wt[s];
#pragma unroll
        for (int q = 0; q < R; ++q) if ((q & half) == 0) {
            const int qq = q & (half - 1);
            const f32x2 a = v[q], b = rot8(cmul(v[q + half], W), qq * (4 >> s), true);
            v[q] = a + b; v[q + half] = a - b;
        }
    }
}
template <int LOGR> __device__ __forceinline__ void dif_pass(const Ctx cx, LAS f32x2* X, int logN, int logm) {
    constexpr int R = 1 << LOGR;
    const int logsub = logm - LOGR + 1, sub = 1 << logsub, ngroups = 1 << (logN - LOGR), psub = PX(sub);
#pragma unroll 2
    for (int g = cx.tid; g < ngroups; g += 512) {
        const int r = g & (sub - 1), blk = g >> logsub, base = (blk << (logm + 1)) + r, pb = PX(base);
        f32x2 v[R];
#pragma unroll
        for (int q = 0; q < R; ++q) v[q] = X[pb + ((sub >= 32) ? q * psub : (q * sub + 5 * ((q * sub) >> 5)))];
        dif_bfly<LOGR>(v, r, logm);
#pragma unroll
        for (int q = 0; q < R; ++q) X[pb + ((sub >= 32) ? q * psub : (q * sub + 5 * ((q * sub) >> 5)))] = v[q];
    }
}
template <int LOGR> __device__ __forceinline__ void dit_pass(const Ctx cx, LAS f32x2* X, int logN, int logm0) {
    constexpr int R = 1 << LOGR;
    const int sub = 1 << logm0, ngroups = 1 << (logN - LOGR), psub = PX(sub);
#pragma unroll 2
    for (int g = cx.tid; g < ngroups; g += 512) {
        const int r = g & (sub - 1), blk = g >> logm0, base = (blk << (logm0 + LOGR)) + r, pb = PX(base);
        f32x2 v[R];
#pragma unroll
        for (int q = 0; q < R; ++q) v[q] = X[pb + ((sub >= 32) ? q * psub : (q * sub + 5 * ((q * sub) >> 5)))];
        dit_bfly<LOGR>(v, r, logm0);
#pragma unroll
        for (int q = 0; q < R; ++q) X[pb + ((sub >= 32) ? q * psub : (q * sub + 5 * ((q * sub) >> 5)))] = v[q];
    }
}
__device__ __forceinline__ void fft_fwd(const Ctx cx, LAS f32x2* X, int logN) {
    int n8 = 0, n4 = 0; for (int rem = logN; rem > 0;) { if (rem > 4 || rem == 3) { ++n8; rem -= 3; } else { ++n4; rem -= 2; } }
    int logm = logN - 1;
    for (int i = 0; i < n8; ++i) { dif_pass<3>(cx, X, logN, logm); logm -= 3; __syncthreads(); }
    for (int i = 0; i < n4; ++i) { dif_pass<2>(cx, X, logN, logm); logm -= 2; __syncthreads(); }
}
__device__ __forceinline__ void fft_inv(const Ctx cx, LAS f32x2* X, int logN) {
    int n8 = 0, n4 = 0; for (int rem = logN; rem > 0;) { if (rem > 4 || rem == 3) { ++n8; rem -= 3; } else { ++n4; rem -= 2; } }
    int lm = 0;
    for (int i = 0; i < n4; ++i) { dit_pass<2>(cx, X, logN, lm); lm += 2; __syncthreads(); }
    for (int i = 0; i < n8; ++i) { dit_pass<3>(cx, X, logN, lm); lm += 3; __syncthreads(); }
}
__device__ __forceinline__ int fft_partner(int pp) { if (pp == 0) return 0; const int j = 31 - __builtin_clz(pp); return (3 << j) - 1 - pp; }

__device__ __forceinline__ void filter_spectrum(const Ctx cx, LAS unsigned char* lds, const bf16_t* W3T, int L, int logN2, const bf16_t* Hfb, f32x2* FS) {
    const int tid = cx.tid, N2 = 2 * L, wid = tid >> 6, lane = tid & 63, fr = lane & 15, fq = lane >> 4;
    LAS f32x2* X = (LAS f32x2*)lds; LAS float* red = (LAS float*)(lds + LDS_X_BYTES);
    const float min_decay = -3.0701134573253944f, max_decay = -15.350567286626972f;
    const float tscale = 1.0f / (float)(L - 1);
    for (int c = cx.bid; c < 1024; c += cx.nblk) {
        bf16x8 wf0 = (bf16x8){0, 0, 0, 0, 0, 0, 0, 0}, wf1 = wf0;
        if (fr < 4) { wf0 = *(const bf16x8*)(W3T + (size_t)c * 256 + fr * 64 + fq * 8); wf1 = *(const bf16x8*)(W3T + (size_t)c * 256 + fr * 64 + 32 + fq * 8); }
        if (tid == 0) X[PX(L)] = (f32x2){0.f, 0.f};
        const float delta = fabsf(min_decay + (max_decay - min_decay) * ((float)c / 1023.0f));
        float ss0 = 0.f, ss1 = 0.f;
#pragma unroll 8
        for (int tl = wid; tl < (L >> 4); tl += 8) {
            const int n = (tl << 4) + fr;
            const bf16x8 h0 = *(const bf16x8*)(Hfb + (size_t)n * 64 + fq * 8), h1 = *(const bf16x8*)(Hfb + (size_t)n * 64 + 32 + fq * 8);
            f32x4 acc = (f32x4){0.f, 0.f, 0.f, 0.f};
            acc = __builtin_amdgcn_mfma_f32_16x16x32_bf16(wf0, h0, acc, 0, 0, 0);
            acc = __builtin_amdgcn_mfma_f32_16x16x32_bf16(wf1, h1, acc, 0, 0, 0);
            if (fq == 0) {
                const float dec = __expf(-((float)n * tscale) * delta);
                const float f00 = acc[0] * dec, f01 = acc[1] * dec, f10 = acc[2] * dec, f11 = acc[3] * dec;
                if (n == 0) { const f32x2 v = (f32x2){f00 + f01, f10 + f11}; X[PX(0)] = v; ss0 += v.x * v.x; ss1 += v.y * v.y; }
                else { X[PX(n)] = (f32x2){f00, f10}; X[PX(N2 - n)] = (f32x2){f01, f11}; ss0 += f00 * f00 + f01 * f01; ss1 += f10 * f10 + f11 * f11; }
            }
        }
        ss0 = wave_sum(tid, ss0); ss1 = wave_sum(tid, ss1);
        if (lane == 0) { red[wid * 2] = ss0; red[wid * 2 + 1] = ss1; }
        __syncthreads();
        float t0 = 0.f, t1 = 0.f;
#pragma unroll
        for (int w = 0; w < 8; ++w) { t0 += red[w * 2]; t1 += red[w * 2 + 1]; }
        const float sc = 0.5f / (float)N2; const f32x2 rs = (f32x2){rsqrtf(t0 + 1e-6f) * sc, rsqrtf(t1 + 1e-6f) * sc};
        for (int n = tid; n < N2; n += 512) X[PX(n)] *= rs;
        __syncthreads();
        fft_fwd(cx, X, logN2);
        f32x2* dst = FS + (size_t)c * N2;
        for (int n = tid; n < N2; n += 512) dst[n] = X[PX(n)];
        __syncthreads();
    }
}

__device__ __forceinline__ float sconv(const bf16_t* row, int n, int L, float w0, float w1, float w2, float b) {
    const float um = n > 0 ? bf2f(row[n - 1]) : 0.f, u0 = bf2f(row[n]), up = (n + 1 < L) ? bf2f(row[n + 1]) : 0.f;
    return um * w0 + u0 * w1 + up * w2 + b;
}
template <int GW> __device__ __forceinline__ void convN(const bf16_t* row, int n0, int L, float w0, float w1, float w2, float b, float (&o)[GW]) {
    float u[GW + 2];
    u[0] = n0 > 0 ? bf2f(row[n0 - 1]) : 0.f;
    u[GW + 1] = (n0 + GW < L) ? bf2f(row[n0 + GW]) : 0.f;
    if (GW == 4) { const u32x2 w = *(const u32x2*)(row + n0); u[1] = __uint_as_float(w.x << 16); u[2] = __uint_as_float(w.x & 0xffff0000u); u[3] = __uint_as_float(w.y << 16); u[GW] = __uint_as_float(w.y & 0xffff0000u); }
    else { const unsigned w = *(const unsigned*)(row + n0); u[1] = __uint_as_float(w << 16); u[2] = __uint_as_float(w & 0xffff0000u); }
#pragma unroll
    for (int i = 0; i < GW; ++i) o[i] = u[i] * w0 + u[i + 1] * w1 + u[i + 2] * w2 + b;
}
template <int GW> __device__ __forceinline__ void hyena_p1(int tid, LAS f32x2* X, int logN2, int L, int order, const bf16_t* rowA, const bf16_t* rowB, float w0, float w1, float w2, float wb, f32x2* Z1) {
    const int lsub = logN2 - 3, sub = 1 << lsub;
    for (int t = tid; t < (sub / GW); t += 512) {
        const int r0 = t * GW, pb0 = PX(r0), psub = PX(sub);
        f32x2 v[GW][8];
#pragma unroll
        for (int q = 0; q < 4; ++q) { const int n0 = r0 + q * sub;
            if (order == 0) { float a[GW], b[GW]; convN<GW>(rowA, n0, L, w0, w1, w2, wb, a); convN<GW>(rowB, n0, L, w0, w1, w2, wb, b);
#pragma unroll
                for (int i = 0; i < GW; ++i) v[i][q] = (f32x2){a[i], b[i]};
#pragma unroll
                for (int i = 0; i < GW / 2; ++i) ((f32x4*)(Z1 + n0))[i] = (f32x4){a[2 * i], b[2 * i], a[2 * i + 1], b[2 * i + 1]}; }
            else {
#pragma unroll
                for (int i = 0; i < GW / 2; ++i) { const f32x4 z = ((const f32x4*)(Z1 + n0))[i]; v[2 * i][q] = (f32x2){z[0], z[1]}; v[2 * i + 1][q] = (f32x2){z[2], z[3]}; } } }
#pragma unroll
        for (int i = 0; i < GW; ++i) {
#pragma unroll
            for (int q = 4; q < 8; ++q) v[i][q] = (f32x2){0.f, 0.f};
            dif_bfly<3>(v[i], r0 + i, logN2 - 1); }
#pragma unroll
        for (int q = 0; q < 8; ++q)
#pragma unroll
            for (int i = 0; i < GW; ++i) X[pb0 + i + q * psub] = v[i][q];
    }
}
template <int GW> __device__ __forceinline__ void hyena_p9(int tid, LAS f32x2* X, int logN2, int L, int order, const bf16_t* rowA, const bf16_t* rowB, float w0, float w1, float w2, float wb, float hb, f32x2* Z1, bf16_t* outA, bf16_t* outB) {
    const int lsub = logN2 - 3, sub = 1 << lsub;
    for (int t = tid; t < (sub / GW); t += 512) {
        const int r0 = t * GW, pb0 = PX(r0), psub = PX(sub);
        f32x2 v[GW][8];
#pragma unroll
        for (int q = 0; q < 8; ++q)
#pragma unroll
            for (int i = 0; i < GW; ++i) v[i][q] = X[pb0 + i + q * psub];
#pragma unroll
        for (int i = 0; i < GW; ++i) dit_bfly<3>(v[i], r0 + i, lsub);
#pragma unroll
        for (int q = 0; q < 4; ++q) { const int n0 = r0 + q * sub;
            float xa[GW], xb[GW]; convN<GW>(rowA, n0, L, w0, w1, w2, wb, xa); convN<GW>(rowB, n0, L, w0, w1, w2, wb, xb);
            f32x2 zo[GW];
#pragma unroll
            for (int i = 0; i < GW / 2; ++i) { const f32x4 z = ((const f32x4*)(Z1 + n0))[i];
                zo[2 * i] = (f32x2){xa[2 * i] * (v[2 * i][q].x + hb * z[0]), xb[2 * i] * (v[2 * i][q].y + hb * z[1])};
                zo[2 * i + 1] = (f32x2){xa[2 * i + 1] * (v[2 * i + 1][q].x + hb * z[2]), xb[2 * i + 1] * (v[2 * i + 1][q].y + hb * z[3])}; }
            if (order == 0) {
#pragma unroll
                for (int i = 0; i < GW / 2; ++i) ((f32x4*)(Z1 + n0))[i] = (f32x4){zo[2 * i].x, zo[2 * i].y, zo[2 * i + 1].x, zo[2 * i + 1].y}; }
            else if (GW == 4) { u32x2 wa, wb2; wa.x = cvt_pk_bf16(zo[0].x, zo[1].x); wa.y = cvt_pk_bf16(zo[2].x, zo[GW - 1].x); wb2.x = cvt_pk_bf16(zo[0].y, zo[1].y); wb2.y = cvt_pk_bf16(zo[2].y, zo[GW - 1].y);
                *(u32x2*)(outA + n0) = wa; *(u32x2*)(outB + n0) = wb2; }
            else { *(unsigned*)(outA + n0) = cvt_pk_bf16(zo[0].x, zo[1].x); *(unsigned*)(outB + n0) = cvt_pk_bf16(zo[0].y, zo[1].y); }
        }
    }
}
__device__ __forceinline__ void hyena_phase(const Ctx cx, LAS unsigned char* lds, const float* conv_w, const float* conv_b, const float* hbias, int L, int logN2, int nbatch, const f32x2* FS, const bf16_t* UH, bf16_t* BT, f32x2* Z1) {
    const int tid = cx.tid, N2 = 2 * L;
    LAS f32x2* X = (LAS f32x2*)lds;
    int n8 = 0, n4 = 0; for (int rem = logN2; rem > 0;) { if (rem > 4 || rem == 3) { ++n8; rem -= 3; } else { ++n4; rem -= 2; } }
    const int lsub = logN2 - 3, sub = 1 << lsub;
    for (int c = cx.bid; c < 1024; c += cx.nblk) {
        const f32x2* FSc = FS + (size_t)c * N2;
        const float v0 = conv_w[c], v1 = conv_w[3072 + c], v2 = conv_w[6144 + c], v3 = conv_b[c];
        const float bias0 = hbias[c], bias1 = hbias[1024 + c];
        const bf16_t* uv = UH + (size_t)c * NTG;
        for (int pair = 0; pair < nbatch / 2; ++pair) {
            const int tA = (2 * pair) * L, tB = tA + L;
            for (int order = 0; order < 2; ++order) {
                const int gch = (order + 1) * 1024 + c;
                const bf16_t* ug = UH + (size_t)gch * NTG;
                const float g0 = conv_w[gch], g1 = conv_w[3072 + gch], g2 = conv_w[6144 + gch], g3 = conv_b[gch];
                const float hb = order ? bias1 : bias0;
                if (logN2 == 14) hyena_p1<4>(tid, X, logN2, L, order, uv + tA, uv + tB, v0, v1, v2, v3, Z1);
                else             hyena_p1<2>(tid, X, logN2, L, order, uv + tA, uv + tB, v0, v1, v2, v3, Z1);
                __syncthreads();
                { int logm = logN2 - 4;
                  for (int i = 1; i < n8; ++i) { dif_pass<3>(cx, X, logN2, logm); logm -= 3; __syncthreads(); }
                  for (int i = 0; i < n4 - 1; ++i) { dif_pass<2>(cx, X, logN2, logm); logm -= 2; __syncthreads(); } }
#pragma unroll 2
                for (int g = tid; g < (N2 >> 2); g += 512) {
                    const int base = g << 2, pbase = PX(base);
                    f32x2 v[4];
#pragma unroll
                    for (int q = 0; q < 4; ++q) v[q] = X[pbase + q];
                    const int pb = base ? ((3 << (31 - __builtin_clz(base))) - 4 - base) : 0;
                    const f32x4 a01 = *(const f32x4*)(FSc + base), a23 = *(const f32x4*)(FSc + base + 2);
                    const f32x4 b01 = *(const f32x4*)(FSc + pb), b23 = *(const f32x4*)(FSc + pb + 2);
                    { f32x2 a = v[0], b = v[2]; v[0] = a + b; v[2] = a - b; a = v[1]; b = v[3]; v[1] = a + b; v[3] = rot8(a - b, 2, false);
                      a = v[0]; b = v[1]; v[0] = a + b; v[1] = a - b; a = v[2]; b = v[3]; v[2] = a + b; v[3] = a - b; }
                    f32x2 A[4], Bn[4];
                    A[0] = (f32x2){a01[0], a01[1]}; A[1] = (f32x2){a01[2], a01[3]}; A[2] = (f32x2){a23[0], a23[1]}; A[3] = (f32x2){a23[2], a23[3]};
                    if (base) { Bn[0] = (f32x2){b23[2], b23[3]}; Bn[1] = (f32x2){b23[0], b23[1]}; Bn[2] = (f32x2){b01[2], b01[3]}; Bn[3] = (f32x2){b01[0], b01[1]}; }
                    else      { Bn[0] = (f32x2){b01[0], b01[1]}; Bn[1] = (f32x2){b01[2], b01[3]}; Bn[2] = (f32x2){b23[2], b23[3]}; Bn[3] = (f32x2){b23[0], b23[1]}; }
#pragma unroll
                    for (int q = 0; q < 4; ++q) { const f32x2 Hq = order ? (f32x2){A[q].y + Bn[q].y, Bn[q].x - A[q].x} : (f32x2){A[q].x + Bn[q].x, A[q].y - Bn[q].y};
                        v[q] = cmul(v[q], Hq); }
                    { f32x2 a = v[0], b = v[1]; v[0] = a + b; v[1] = a - b; a = v[2]; b = v[3]; v[2] = a + b; v[3] = a - b;
                      a = v[0]; b = v[2]; v[0] = a + b; v[2] = a - b; a = v[1]; b = rot8(v[3], 2, true); v[1] = a + b; v[3] = a - b; }
#pragma unroll
                    for (int q = 0; q < 4; ++q) X[pbase + q] = v[q];
                }
                __syncthreads();
                { int lm = 2;
                  for (int i = 1; i < n4; ++i) { dit_pass<2>(cx, X, logN2, lm); lm += 2; __syncthreads(); }
                  for (int i = 0; i < n8 - 1; ++i) { dit_pass<3>(cx, X, logN2, lm); lm += 3; __syncthreads(); } }
                if (logN2 == 14) hyena_p9<4>(tid, X, logN2, L, order, ug + tA, ug + tB, g0, g1, g2, g3, hb, Z1, BT + (size_t)c * NTG + tA, BT + (size_t)c * NTG + tB);
                else             hyena_p9<2>(tid, X, logN2, L, order, ug + tA, ug + tB, g0, g1, g2, g3, hb, Z1, BT + (size_t)c * NTG + tA, BT + (size_t)c * NTG + tB);
                __syncthreads();
            }
        }
    }
}

template <int HW> __device__ __forceinline__ void pool_item(const bf16_t* UP, bf16_t* PL, int L, int tok, int ch0) {
    const int t = tok & (L - 1);
    const bf16_t* basep = UP + (size_t)(tok - t) * 1024 + ch0;
    u32x4 w[2 * HW];
#pragma unroll
    for (int i = 0; i < 2 * HW; ++i) { const int s = t - HW + i; const int sc = s < 0 ? 0 : (s >= L ? L - 1 : s); w[i] = *(const u32x4*)(basep + (size_t)sc * 1024); }
    f32x4 s0 = (f32x4){0.f, 0.f, 0.f, 0.f}, s1 = s0;
#pragma unroll
    for (int i = 0; i < 2 * HW; ++i) { const int s = t - HW + i; f32x4 a, b; unpack8(w[i], a, b); const float m = (s >= 0 && s < L) ? 1.0f : 0.0f; s0 += a * m; s1 += b * m; }
    f32x4 a, b; unpack8(w[HW], a, b);
    const int lo = (t - HW) < 0 ? 0 : (t - HW), hi = (t + HW) > L ? L : (t + HW);
    const float inv = 1.0f / (float)(hi - lo);
    *(u32x4*)(PL + (size_t)tok * 2048 + ch0) = pack8(s0 * inv - a, s1 * inv - b);
}
__device__ __forceinline__ void pool_phase(const Ctx cx, const bf16_t* UP, bf16_t* PL, int L) {
    const int total = NTG * 128;
    for (int idx = cx.bid * 512 + cx.tid; idx < total; idx += cx.nblk * 512) {
        const int grp = idx / (NTG * 32), rem = idx - grp * (NTG * 32), tok = rem >> 5, ch0 = grp * 256 + ((rem & 31) << 3);
        switch (grp) {
            case 0: pool_item<1>(UP, PL, L, tok, ch0); break;
            case 1: pool_item<2>(UP, PL, L, tok, ch0); break;
            case 2: pool_item<4>(UP, PL, L, tok, ch0); break;
            default: pool_item<8>(UP, PL, L, tok, ch0); break;
        }
    }
}

__device__ __forceinline__ void bt_transpose(const Ctx cx, LAS unsigned short* tile, const bf16_t* BT, bf16_t* AB) {
    constexpr int TB = 4;
    const int tid = cx.tid;
    constexpr int NTT = NTG / 64;
    for (int t4 = cx.bid * TB; t4 < 16 * NTT; t4 += cx.nblk * TB) {
        u32x4 w[TB];
#pragma unroll
        for (int u = 0; u < TB; ++u) { const int t = t4 + u, c0 = (t / NTT) << 6, k0 = (t % NTT) << 6; const int r = tid >> 3, cc = (tid & 7) << 3;
            w[u] = *(const u32x4*)(BT + (size_t)(c0 + r) * NTG + k0 + cc); }
#pragma unroll
        for (int u = 0; u < TB; ++u) { const int r = tid >> 3, cc = (tid & 7) << 3; LAS unsigned short* d = tile + u * (64 * 72) + r * 72 + cc;
            d[0] = (unsigned short)(w[u].x & 0xffff); d[1] = (unsigned short)(w[u].x >> 16); d[2] = (unsigned short)(w[u].y & 0xffff); d[3] = (unsigned short)(w[u].y >> 16);
            d[4] = (unsigned short)(w[u].z & 0xffff); d[5] = (unsigned short)(w[u].z >> 16); d[6] = (unsigned short)(w[u].w & 0xffff); d[7] = (unsigned short)(w[u].w >> 16); }
        __syncthreads();
#pragma unroll
        for (int u = 0; u < TB; ++u) { const int t = t4 + u, c0 = (t / NTT) << 6, k0 = (t % NTT) << 6; const int tk = tid >> 3, ch = (tid & 7) << 3; const LAS unsigned short* tp = tile + u * (64 * 72); u32x4 o;
            o.x = (unsigned)tp[(ch + 0) * 72 + tk] | ((unsigned)tp[(ch + 1) * 72 + tk] << 16); o.y = (unsigned)tp[(ch + 2) * 72 + tk] | ((unsigned)tp[(ch + 3) * 72 + tk] << 16);
            o.z = (unsigned)tp[(ch + 4) * 72 + tk] | ((unsigned)tp[(ch + 5) * 72 + tk] << 16); o.w = (unsigned)tp[(ch + 6) * 72 + tk] | ((unsigned)tp[(ch + 7) * 72 + tk] << 16);
            *(u32x4*)(AB + (size_t)(k0 + tk) * 2048 + 1024 + c0 + ch) = o; }
        __syncthreads();
    }
}

template <bool OUTF32> __device__ __forceinline__ void rmsnorm_phase(const Ctx cx, const float* x, const float* g, void* outp, int nrows) {
    constexpr int RB = 4;
    const int wave = cx.tid >> 6, lane = cx.tid & 63;
    const int nw = cx.nblk * 8;
    for (int row0 = (cx.bid * 8 + wave) * RB; row0 < nrows; row0 += nw * RB) {
        f32x4 v[RB][8];
#pragma unroll
        for (int rb = 0; rb < RB; ++rb) { const f32x4* xr = (const f32x4*)(x + (size_t)(row0 + rb) * DM);
#pragma unroll
            for (int i = 0; i < 8; ++i) v[rb][i] = __builtin_nontemporal_load(xr + lane + 64 * i); }
        float rs[RB];
#pragma unroll
        for (int rb = 0; rb < RB; ++rb) { float ss = 0.f;
#pragma unroll
            for (int i = 0; i < 8; ++i) ss += v[rb][i][0] * v[rb][i][0] + v[rb][i][1] * v[rb][i][1] + v[rb][i][2] * v[rb][i][2] + v[rb][i][3] * v[rb][i][3];
            ss = wave_sum(cx.tid, ss); rs[rb] = rsqrtf(ss * (1.0f / DM) + 1e-6f); }
#pragma unroll
        for (int i = 0; i < 8; ++i) { const f32x4 gv = ((const f32x4*)g)[lane + 64 * i];
#pragma unroll
            for (int rb = 0; rb < RB; ++rb) { const f32x4 o = v[rb][i] * rs[rb] * gv;
                if (OUTF32) __builtin_nontemporal_store(o, (f32x4*)((float*)outp + (size_t)(row0 + rb) * DM) + lane + 64 * i);
                else { u32x2 w; w.x = cvt_pk_bf16(o[0], o[1]); w.y = cvt_pk_bf16(o[2], o[3]); ((u32x2*)((bf16_t*)outp + (size_t)(row0 + rb) * DM))[lane + 64 * i] = w; } } }
    }
}

#define XB_TMO      128
#define XB_XCNT(j)  (256  + 64 * (j))
#define XB_XSUB(j)  (1280 + 64 * (j))
#define XB_XGEN(j)  (2304 + 64 * (j))
#define XB_TOP      3328
#define XB_TOPGEN   3392
#define XCD_BAR_WORDS 3456
#define XB_SPIN_CAP (1u << 18)
__device__ __forceinline__ unsigned xb_ld(unsigned* p)              { return __hip_atomic_load(p, __ATOMIC_RELAXED, __HIP_MEMORY_SCOPE_AGENT); }
__device__ __forceinline__ unsigned xb_add(unsigned* p, unsigned v) { return __hip_atomic_fetch_add(p, v, __ATOMIC_RELAXED, __HIP_MEMORY_SCOPE_AGENT); }
__device__ __forceinline__ unsigned xb_xcc_id() { return (unsigned)__builtin_amdgcn_s_getreg((3 << 11) | 20) & 0xFu; }
#define XB_SPIN(cond, bar) do { unsigned _sp = 0; while (cond) { __builtin_amdgcn_s_sleep(1); \
    if ((++_sp & 255u) == 0u) { if (xb_ld(&(bar)[XB_TMO])) break; if (_sp > XB_SPIN_CAP) { atomicAdd(&(bar)[XB_TMO], 1u); break; } } } } while (0)
__device__ __forceinline__ void xcd_barrier_complete(unsigned* bar, unsigned x, unsigned G, unsigned& nloc, unsigned& nx) {
    unsigned sum, cnt, mine, sp = 0u;
    for (;;) {
        sum = 0u; cnt = 0u; mine = 0u;
#pragma unroll
        for (unsigned j = 0; j < 16; ++j) { const unsigned c = xb_ld(&bar[XB_XCNT(j)]); sum += c; cnt += (c > 0u) ? 1u : 0u; mine = (j == x) ? c : mine; }
        if (sum == G) break;
        __builtin_amdgcn_s_sleep(1);
        if ((++sp & 255u) == 0u) { if (xb_ld(&bar[XB_TMO])) break; if (sp > XB_SPIN_CAP) { atomicAdd(&bar[XB_TMO], 1u); break; } }
    }
    nloc = mine > 0u ? mine : 1u; nx = cnt > 0u ? cnt : 1u;
}
__device__ __forceinline__ void xcd_barrier(unsigned* bar, volatile LAS unsigned* st, bool leader, unsigned G) {
    asm volatile("s_waitcnt vmcnt(0)" ::: "memory");
    __syncthreads();
    if (leader) {
        __builtin_amdgcn_s_waitcnt(0);
        const unsigned x = xb_xcc_id();
        unsigned nloc = st[0], nx = st[1];
        if (nloc == 0u) { xcd_barrier_complete(bar, x, G, nloc, nx); st[0] = nloc; st[1] = nx; }
        const unsigned old = xb_add(&bar[XB_XSUB(x)], 1u);
        const unsigned gen = old / nloc;
        if (old + 1u == (gen + 1u) * nloc) {
            __builtin_amdgcn_fence(__ATOMIC_RELEASE, "agent");
            asm volatile("s_waitcnt vmcnt(0)" ::: "memory");
            const unsigned og = xb_add(&bar[XB_TOP], 1u);
            const unsigned tg = og / nx;
            if (og + 1u == (tg + 1u) * nx) xb_add(&bar[XB_TOPGEN], 1u);
            else XB_SPIN(xb_ld(&bar[XB_TOPGEN]) == tg, bar);
            __builtin_amdgcn_fence(__ATOMIC_ACQUIRE, "agent");
            xb_add(&bar[XB_XGEN(x)], 1u);
            asm volatile("s_waitcnt vmcnt(0)" ::: "memory");
        } else {
            XB_SPIN(xb_ld(&bar[XB_XGEN(x)]) == gen, bar);
            __builtin_amdgcn_fence(__ATOMIC_ACQUIRE, "agent");
            asm volatile("s_waitcnt vmcnt(0)" ::: "memory");
        }
    }
    __syncthreads();
}

typedef const __attribute__((address_space(4))) Params* PP;
__device__ __forceinline__ const float* grp_x(PP p, int g) { return g == 0 ? p->x_prompt : p->x_sample; }

__device__ __forceinline__ void run_phase(const Ctx cx, PP p, int ph, LAS unsigned char* lds) {
    unsigned char* ws = p->ws;
    bf16_t* WinT = (bf16_t*)(ws + WS_WIN); bf16_t* WpT = (bf16_t*)(ws + WS_WPOOL); bf16_t* WaT = (bf16_t*)(ws + WS_WA); bf16_t* WbT = (bf16_t*)(ws + WS_WB);
    bf16_t* WoT = (bf16_t*)(ws + WS_WO); bf16_t* WguT = (bf16_t*)(ws + WS_WGU); bf16_t* WdT = (bf16_t*)(ws + WS_WD);
    bf16_t* HF8 = (bf16_t*)(ws + WS_HF8); bf16_t* HF4 = (bf16_t*)(ws + WS_HF4); bf16_t* W3T = (bf16_t*)(ws + WS_W3T); f32x2* FS8 = (f32x2*)(ws + WS_FS8); f32x2* FS4 = (f32x2*)(ws + WS_FS4);
    f32x2* Z1 = (f32x2*)(ws + WS_Z1) + (size_t)cx.bid * 8192;
    bf16_t* H = (bf16_t*)(ws + WS_H); bf16_t* UP = (bf16_t*)(ws + WS_UP); bf16_t* G = (bf16_t*)(ws + WS_G); bf16_t* UH = (bf16_t*)(ws + WS_UH);
    bf16_t* PL = (bf16_t*)(ws + WS_PL); bf16_t* BT = (bf16_t*)(ws + WS_BT); bf16_t* AB = (bf16_t*)(ws + WS_AB); bf16_t* ACT = (bf16_t*)(ws + WS_ACT);
    if (EN(100) && ph == 0) {
        LAS float* tile = (LAS float*)lds;
        for (int job = 0; job < 7; ++job) {
            const float* s; int K, N, mode = 0, ldd = 0, koff = 0; bf16_t* d;
            switch (job) {
                case 0: s = p->w_in; K = 2048; N = 8192; d = WinT; mode = 1; break;
                case 1: s = p->w_a; K = 1024; N = 2048; d = UP; break;
                case 2: s = p->w_b; K = 1024; N = 2048; d = WaT; ldd = 2048; koff = 1024; break;
                case 3: s = p->w_out; K = 2048; N = 2048; d = WoT; break;
                case 4: s = p->w_gate; K = 2048; N = DFF; d = WguT; mode = 2; break;
                case 5: s = p->w_up; K = 2048; N = DFF; d = WguT; mode = 3; break;
                case 6: s = p->w_down; K = DFF; N = 2048; d = WdT; break;
                default: s = p->pool_w + (size_t)(job - 7) * 65536; K = 256; N = 256; d = WpT + (size_t)(job - 7) * 65536; break;
            }
            transpose_cvt(cx, tile, s, K, N, d, mode, ldd ? ldd : K, koff);
        }
        for (int idx = cx.bid * 512 + cx.tid; idx < 262144; idx += cx.nblk * 512)
            WpT[idx] = (bf16_t)(cvt_pk_bf16(p->pool_w[idx] * p->pool_scale[((idx >> 16) << 8) + (idx & 255)], 0.f) & 0xffffu);
        for (int idx = cx.bid * 512 + cx.tid; idx < 262144; idx += cx.nblk * 512)
            W3T[idx] = (bf16_t)(cvt_pk_bf16(p->filt_w3[(size_t)(idx & 63) * 4096 + ((idx >> 6) & 3) * 1024 + (idx >> 8)], 0.f) & 0xffffu);
        for (int v = 0; v < 2; ++v)
            filter_features(cx, (LAS float*)lds, p->filt_w1, p->filt_b1, p->filt_f1, p->filt_w2, p->filt_b2, p->filt_f2, v ? 4096 : 8192, v ? HF4 : HF8);
        return;
    }
    if (EN(101) && ph == 1) {
        { Gemm gf{UP, WpT, 2048, 1024, 256, 1024, 256, 256, WGM}; EpiRaw ef{WaT, 2048}; gemm_phase(cx, lds, gf, ef); }
        for (int v = 0; v < 2; ++v) filter_spectrum(cx, lds, W3T, v ? 4096 : 8192, v ? 13 : 14, v ? HF4 : HF8, v ? FS4 : FS8);
        rmsnorm_phase<false>(cx, grp_x(p, 0), p->g_mix, H, NTG);
        return;
    }
    const int g = (ph - 2) / 9, k = (ph - 2) % 9;
    const int L = g == 0 ? 8192 : 4096, logN2 = g == 0 ? 14 : 13, nb = g == 0 ? 4 : 8;
    float* outg = p->out + (size_t)g * NTG * DM;
    switch (k) {
        case 0: if (EN(0)) {
            Gemm ga{H, WinT, NTG, 5120, 2048, 2048, 2048, 0, WGM}; EpiUPG ea{UP, G}; gemm_phase(cx, lds, ga, ea);
            Gemm gb{WinT + (size_t)5120 * 2048, H, 3072, NTG, 2048, 2048, 2048, 0, 6}; EpiRaw eb{UH, NTG}; gemm_phase(cx, lds, gb, eb);
        } break;
        case 1: if (EN(1)) {
            hyena_phase(cx, lds, p->conv_w, p->conv_b, p->hyena_bias, L, logN2, nb, g == 0 ? FS8 : FS4, UH, BT, Z1);
        } break;
        case 2: if (EN(2)) {
            pool_phase(cx, UP, AB, L);
            bt_transpose(cx, (LAS unsigned short*)lds, BT, AB);
        } break;
        case 3: if (EN(3)) {
            Gemm g1{AB, WaT, NTG, 2048, 2048, 2048, 2048, 0, WGM}; EpiMerge e1{G, H}; gemm_phase<EpiMerge, true>(cx, lds, g1, e1);
        } break;
        case 4: if (EN(4)) {
            Gemm go{H, WoT, NTG, 2048, 2048, 2048, 2048, 0, WGM}; EpiRes eo{grp_x(p, g), outg}; gemm_phase(cx, lds, go, eo);
        } break;
        case 5: if (EN(5)) rmsnorm_phase<false>(cx, outg, p->g_ffn, H, NTG); break;
        case 6: if (EN(6)) {
            Gemm gg{H, WguT, NTG, 11264, 2048, 2048, 2048, 0, 8}; EpiSwiGLU eg{ACT}; gemm_phase(cx, lds, gg, eg);
        } break;
        case 7: if (EN(7)) {
            Gemm gd{ACT, WdT, NTG, 2048, DFF, DFF, DFF, 0, WGM}; EpiRes ed{outg, outg}; gemm_phase(cx, lds, gd, ed);
        } break;
        case 8: if (EN(8)) {
            rmsnorm_phase<true>(cx, outg, p->g_final, outg, NTG);
            if (g + 1 < NGRP) rmsnorm_phase<false>(cx, grp_x(p, g + 1), p->g_mix, H, NTG);
        } break;
    }
}

__global__ __launch_bounds__(512, 2) void mega(Params p, int ph_lo, int ph_hi) {
    extern __shared__ __attribute__((aligned(16))) unsigned char smem_raw[];
    LAS unsigned char* lds = (LAS unsigned char*)smem_raw;
    const int wid_s = __builtin_amdgcn_readfirstlane((int)threadIdx.x >> 6);
    volatile LAS unsigned* bst = (volatile LAS unsigned*)(lds + LDS_X_BYTES + 1024);
    { unsigned* bar0 = (unsigned*)(((PP)__builtin_amdgcn_kernarg_segment_ptr())->ws + WS_BAR);
      if (threadIdx.x == 0) { bst[0] = 0u; bst[1] = 0u; (void)xb_add(&bar0[XB_XCNT(xb_xcc_id())], 1u); }
      __syncthreads(); }
    for (int ph = ph_lo; ph < ph_hi; ++ph) {
        int nrep = 1;
#ifdef PROBE_DUP
        if ((PROBE_DUP >= 100 && ph == PROBE_DUP - 100) || (PROBE_DUP < 100 && ph >= 2 && (ph - 2) % 9 == PROBE_DUP)) nrep = 2;
#endif
        for (int r = 0; r < nrep; ++r) {
            if (r) __syncthreads();
            PP pp = (PP)__builtin_amdgcn_kernarg_segment_ptr(); asm volatile("" : "+s"(pp));
            Ctx cx; cx.bid = blockIdx.x; cx.nblk = gridDim.x;
            { int lane_; asm volatile("v_mbcnt_lo_u32_b32 %0, -1, 0\n\tv_mbcnt_hi_u32_b32 %0, -1, %0" : "=&v"(lane_)); cx.tid = (wid_s << 6) | lane_; }
            asm volatile("" : "+v"(cx.tid)); asm volatile("" : "+s"(cx.bid)); asm volatile("" : "+s"(cx.nblk));
            run_phase(cx, pp, ph, lds);
        }
        if (ph + 1 < ph_hi) {
            if (ph_lo < 0) cg::this_grid().sync();
            { int lane_; asm volatile("v_mbcnt_lo_u32_b32 %0, -1, 0\n\tv_mbcnt_hi_u32_b32 %0, -1, %0" : "=&v"(lane_));
                   unsigned* bar = (unsigned*)(((PP)__builtin_amdgcn_kernarg_segment_ptr())->ws + WS_BAR);
                   xcd_barrier(bar, bst, wid_s == 0 && lane_ == 0, gridDim.x); }
        }
    }
}

extern "C" void kernel_launch(void* const* d_in, const int* in_sizes, int n_in, void* d_out, int out_size, void* d_ws, size_t ws_size, hipStream_t stream) {
    static int grid = 0;
    if (grid == 0) {
        if (n_in != 24 || ws_size < WS_END) { fprintf(stderr, "kernel_launch: unexpected n_in %d or ws_size %zu (< %zu)\n", n_in, ws_size, (size_t)WS_END); grid = -1; return; }
        int dev = 0, cus = 0, per_cu = 0;
        hipGetDevice(&dev); hipDeviceGetAttribute(&cus, hipDeviceAttributeMultiprocessorCount, dev);
        if (hipFuncSetAttribute((const void*)mega, hipFuncAttributeMaxDynamicSharedMemorySize, LDS_BYTES) != hipSuccess) { fprintf(stderr, "kernel_launch: hipFuncSetAttribute failed\n"); grid = -1; return; }
        if (hipOccupancyMaxActiveBlocksPerMultiprocessor(&per_cu, (const void*)mega, 512, LDS_BYTES) != hipSuccess || per_cu < 1) { fprintf(stderr, "kernel_launch: occupancy query says %d\n", per_cu); per_cu = 1; }
        (void)hipGetLastError();
        grid = cus; if (grid > 256) grid = 256; if (grid < 1) grid = 256;
    }
    if (grid < 0) return;
    Params p{};
    const float** pp = (const float**)&p;
    for (int i = 0; i < 24; ++i) pp[i] = (const float*)d_in[i];
    p.out = (float*)d_out; p.ws = (unsigned char*)d_ws;
    if (hipMemsetAsync((char*)d_ws + WS_BAR, 0, 16384, stream) != hipSuccess) { fprintf(stderr, "kernel_launch: memset of barrier words failed\n"); return; }
#if MULTI_LAUNCH
    for (int ph = 0; ph < NPH; ++ph) hipLaunchKernelGGL(mega, dim3(grid), dim3(512), LDS_BYTES, stream, p, ph, ph + 1);
#else
    int lo = 0, hi = NPH; void* args[] = {&p, &lo, &hi};
    hipError_t e = hipLaunchCooperativeKernel((const void*)mega, dim3(grid), dim3(512), args, LDS_BYTES, stream);
    if (e != hipSuccess) fprintf(stderr, "kernel_launch: cooperative launch failed: %s (grid %d)\n", hipGetErrorString(e), grid);
#endif
}
```

```cpp
#include <hip/hip_runtime.h>
#include <hip/hip_cooperative_groups.h>
#include <cstdio>
namespace cg = cooperative_groups;

#ifndef MULTI_LAUNCH
#define MULTI_LAUNCH 0
#endif

#ifndef ONLY
#define ONLY -1
#endif
#define EN(x) (ONLY == -1 || ONLY == (x))
#define LAS __attribute__((address_space(3)))
typedef unsigned short bf16_t;
typedef short bf16x8 __attribute__((ext_vector_type(8)));
typedef float f32x4 __attribute__((ext_vector_type(4)));
typedef float f32x2 __attribute__((ext_vector_type(2)));
typedef unsigned u32x4 __attribute__((ext_vector_type(4)));
typedef unsigned u32x2 __attribute__((ext_vector_type(2)));

constexpr int DM = 2048, DFF = 5632, NTG = 32768, NGRP = 2;
constexpr int BM = 256, BK = 64, HALF = 128, HTB = HALF * BK * 2, NXCD = 8, WGM = 4;
constexpr int XPAD_ELEMS = 16384 + 512 * 5;
constexpr int LDS_X_BYTES = XPAD_ELEMS * 8;
constexpr int LDS_BYTES = LDS_X_BYTES + 2048;
constexpr int NPH = 2 + NGRP * 9;

constexpr size_t WS_WIN = 0;
constexpr size_t WS_WPOOL = WS_WIN + (size_t)8192 * 2048 * 2;
constexpr size_t WS_WA = WS_WPOOL + (size_t)1024 * 256 * 2;
constexpr size_t WS_WB = WS_WA + (size_t)2048 * 1024 * 2;
constexpr size_t WS_WO = WS_WB + (size_t)2048 * 1024 * 2;
constexpr size_t WS_WGU = WS_WO + (size_t)2048 * 2048 * 2;
constexpr size_t WS_WD = WS_WGU + (size_t)11264 * 2048 * 2;
constexpr size_t WS_HF8 = WS_WD + (size_t)2048 * 5632 * 2;
constexpr size_t WS_HF4 = WS_HF8 + (size_t)8192 * 64 * 4;
constexpr size_t WS_FS8 = WS_HF4 + (size_t)4096 * 64 * 4;
constexpr size_t WS_FS4 = WS_FS8 + (size_t)1024 * 16384 * 8;
constexpr size_t WS_Z1 = WS_FS4 + (size_t)1024 * 8192 * 8;
constexpr size_t WS_H = WS_Z1 + (size_t)256 * 65536;
constexpr size_t WS_UP = WS_H + (size_t)NTG * 2048 * 2;
constexpr size_t WS_G = WS_UP + (size_t)NTG * 1024 * 2;
constexpr size_t WS_UH = WS_G + (size_t)NTG * 4096 * 2;
constexpr size_t WS_W3T = WS_UH + (size_t)3072 * NTG * 2;
constexpr size_t WS_BAR = WS_W3T + (size_t)1024 * 256 * 2;
constexpr size_t WS_END = WS_BAR + 16384;
constexpr size_t WS_PL = WS_H;
constexpr size_t WS_BT = WS_H + (size_t)NTG * 1024 * 2;
constexpr size_t WS_AB = WS_UH;
constexpr size_t WS_ACT = WS_G;
static_assert((size_t)NTG * DFF * 2 <= (size_t)NTG * 4096 * 2 + (size_t)3072 * NTG * 2, "ACT must fit in G|UH");

struct Params {
    const float* x_prompt; const float* x_sample; const float* g_mix; const float* w_in; const float* pool_w; const float* pool_scale;
    const float* conv_w; const float* conv_b; const float* filt_w1; const float* filt_b1; const float* filt_f1; const float* filt_w2;
    const float* filt_b2; const float* filt_f2; const float* filt_w3; const float* hyena_bias; const float* w_a; const float* w_b;
    const float* w_out; const float* g_ffn; const float* w_gate; const float* w_up; const float* w_down; const float* g_final;
    float* out; unsigned char* ws;
};

struct Ctx { int tid, bid, nblk; };
__device__ __forceinline__ float bf2f(unsigned short b) { return __uint_as_float(((unsigned)b) << 16); }
__device__ __forceinline__ unsigned cvt_pk_bf16(float lo, float hi) { unsigned r; asm volatile("v_cvt_pk_bf16_f32 %0, %1, %2" : "=v"(r) : "v"(lo), "v"(hi)); return r; }
__device__ __forceinline__ float sigmoidf_(float v) { return __builtin_amdgcn_rcpf(1.0f + __builtin_amdgcn_exp2f(-1.4426950408889634f * v)); }
__device__ __forceinline__ float wave_sum(int tid, float v) {
#pragma unroll
    for (int o = 32; o > 0; o >>= 1) v += __int_as_float(__builtin_amdgcn_ds_bpermute(((tid ^ o) & 63) << 2, __float_as_int(v)));
    return v;
}

__device__ __forceinline__ int lds_byte(int r, int c) { const int st = (r >> 4) * 2 + (c >> 5), rr = r & 15, cc = c & 31, ob = rr * 64 + cc * 2; return st * 1024 + (ob ^ (((ob >> 9) & 1) << 5)); }
__device__ __forceinline__ void stage_rc(int b, int& R, int& C) { const int st = b / 1024, sb = b % 1024, swz = sb ^ (((sb >> 9) & 1) << 5); R = (st >> 1) * 16 + swz / 64; C = (st & 1) * 32 + (swz % 64) / 2; }
__device__ __forceinline__ int perm32(int rho) { const int n = rho >> 4, i = rho & 15; return 8 * (i >> 2) + 4 * n + (i & 3); }

struct Unit { int pm, pn; };
struct Gemm { const bf16_t* A; const bf16_t* Bt; int M, N, K, lda, ldb, a_pn_step, wgm; };

struct StaticOrder {
    int nM, nN, nwg, G, c, wgm;
    __device__ __forceinline__ void init(int M, int N, int G_, int c_, int wgm_) { nM = M / BM; nN = N / BM; nwg = nM * nN; G = G_; c = c_; wgm = wgm_; }
    __device__ __forceinline__ bool next(int i, Unit& u) const {
        const long L = (long)i * G + c; if (L >= nwg) return false;
        int wgid = (int)L; { const int q = nwg / NXCD, r = nwg % NXCD, xcd = wgid % NXCD, off = wgid / NXCD; wgid = (xcd < r ? xcd * (q + 1) : r * (q + 1) + (xcd - r) * q) + off; }
        const int nig = wgm * nN, gid = wgid / nig, fm = gid * wgm, gsz = (nM - fm) < wgm ? (nM - fm) : wgm;
        u.pm = fm + ((wgid % nig) % gsz); u.pn = (wgid % nig) / gsz; return true;
    }
};

template <class Epi, bool MID = false>
__device__ __forceinline__ void gemm_phase(const Ctx cx, LAS unsigned char* lds, const Gemm g, const Epi& E) {
    const int tid = cx.tid, wid = __builtin_amdgcn_readfirstlane(tid >> 6), lane = tid & 63, wr = wid >> 2, wc = wid & 3, fr = lane & 15, fq = lane >> 4;
    const int K = g.K, nt = K / BK;
    StaticOrder S; S.init(g.M, g.N, cx.nblk, cx.bid, g.wgm);
    unsigned voffA[2], voffB[2];
#pragma unroll
    for (int i = 0; i < 2; ++i) { int R, C; stage_rc(tid * 16 + i * 8192, R, C); const int Rb = Epi::PERM ? ((R & ~31) + perm32(R & 31)) : R;
        voffA[i] = (unsigned)(R * g.lda + C) * 2u; voffB[i] = (unsigned)(Rb * g.ldb + C) * 2u; }
    const size_t kstep = (size_t)(BK * 2);
    const size_t hstepA = (size_t)HALF * g.lda * 2, hstepB = (size_t)HALF * g.ldb * 2;
    const size_t tstepA = 2 * hstepA, tstepB = 2 * hstepB;
    const unsigned ldsw = (unsigned)wid * 1024u;
    const int aoff = lds_byte(wr * 64 + fr, fq * 8), boff = lds_byte(wc * 32 + fr, fq * 8);
#define PG8_SA(b, h) (((b) * 2 + (h)) * HTB)
#define PG8_SB(b, h) ((4 + (b) * 2 + (h)) * HTB)
#define PG8_STAGE(bufoff, gbase, voff) do { _Pragma("unroll") for (int _i = 0; _i < 2; ++_i) \
        __builtin_amdgcn_global_load_lds((const unsigned*)((const char*)(gbase) + (voff)[_i]), (LAS unsigned*)(lds + (bufoff) + ldsw + _i * 8192), 16, 0, 0); } while (0)
#define PG8_LDA(dst, b, h) do { _Pragma("unroll") for (int m = 0; m < 4; ++m) _Pragma("unroll") for (int k = 0; k < 2; ++k) dst[m][k] = *(const LAS bf16x8*)(lds + PG8_SA(b, h) + aoff + m * 2048 + k * 1024); } while (0)
#define PG8_LDB(dst, b, h) do { _Pragma("unroll") for (int n = 0; n < 2; ++n) _Pragma("unroll") for (int k = 0; k < 2; ++k) dst[n][k] = *(const LAS bf16x8*)(lds + PG8_SB(b, h) + boff + n * 2048 + k * 1024); } while (0)
#define PG8_MMA(ai, bj, At, Bt) do { __builtin_amdgcn_s_setprio(1); _Pragma("unroll") for (int m = 0; m < 4; ++m) _Pragma("unroll") for (int n = 0; n < 2; ++n) _Pragma("unroll") for (int k = 0; k < 2; ++k) \
        acc[ai][bj][m][n] = __builtin_amdgcn_mfma_f32_16x16x32_bf16(Bt[n][k], At[m][k], acc[ai][bj][m][n], 0, 0, 0); __builtin_amdgcn_s_setprio(0); } while (0)
#define PG8_WAIT_V(n) asm volatile("s_waitcnt vmcnt(" #n ")" ::: "memory")
#define PG8_WAIT_L(n) asm volatile("s_waitcnt lgkmcnt(" #n ")" ::: "memory")
#define PG8_BAR __builtin_amdgcn_s_barrier()
#define PG8_SCHED __builtin_amdgcn_sched_barrier(0)
    Unit cur, nxt; int ui = 0;
    if (!S.next(0, cur)) return;
    f32x4 acc[2][2][4][2];
#pragma unroll
    for (int a = 0; a < 2; ++a)
#pragma unroll
        for (int b = 0; b < 2; ++b)
#pragma unroll
            for (int m = 0; m < 4; ++m)
#pragma unroll
                for (int n = 0; n < 2; ++n) acc[a][b][m][n] = (f32x4){0.f, 0.f, 0.f, 0.f};
    bf16x8 At[4][2], B0[2][2], B1[2][2];
    const char* cA = (const char*)g.A + (size_t)cur.pm * tstepA + (size_t)cur.pn * (size_t)g.a_pn_step * 2; const char* cB = (const char*)g.Bt + (size_t)cur.pn * tstepB;
    PG8_STAGE(PG8_SB(0, 0), cB, voffB); PG8_STAGE(PG8_SA(0, 0), cA, voffA); PG8_STAGE(PG8_SB(0, 1), cB + hstepB, voffB); PG8_STAGE(PG8_SA(0, 1), cA + hstepA, voffA);
    if (wr == 1) PG8_BAR;
    PG8_WAIT_V(4); PG8_BAR;
    PG8_STAGE(PG8_SB(1, 0), cB + kstep, voffB); PG8_STAGE(PG8_SA(1, 0), cA + kstep, voffA); PG8_STAGE(PG8_SB(1, 1), cB + hstepB + kstep, voffB);
    PG8_WAIT_V(6); PG8_BAR;
    for (;;) {
        const bool has_next = S.next(ui + 1, nxt);
        const char* nA = has_next ? (const char*)g.A + (size_t)nxt.pm * tstepA + (size_t)nxt.pn * (size_t)g.a_pn_step * 2 : cA; const char* nB = has_next ? (const char*)g.Bt + (size_t)nxt.pn * tstepB : cB;
        for (int t = 0; t < nt; t += 2) {
            const bool last = (t == nt - 2);
            const char* a1 = cA + (size_t)(t + 1) * kstep;
            const char* a2 = last ? nA : cA + (size_t)(t + 2) * kstep; const char* b2 = last ? nB : cB + (size_t)(t + 2) * kstep;
            const char* a3 = a2 + kstep; const char* b3 = b2 + kstep;
            if constexpr (MID) if (t == (nt >> 1)) { int fr_ = fr, fq_ = fq; asm volatile("" : "+v"(fr_), "+v"(fq_)); E.mid(acc, cur, wr, wc, fr_, fq_); }
            PG8_LDB(B0, 0, 0); PG8_SCHED; PG8_LDA(At, 0, 0); PG8_STAGE(PG8_SA(1, 1), a1 + hstepA, voffA);
            PG8_WAIT_L(8); PG8_BAR; PG8_WAIT_L(0); PG8_MMA(0, 0, At, B0); PG8_BAR; PG8_SCHED;
            PG8_LDB(B1, 0, 1); PG8_STAGE(PG8_SB(0, 0), b2, voffB);
            PG8_BAR; PG8_WAIT_L(0); PG8_MMA(0, 1, At, B1); PG8_BAR;
            PG8_LDA(At, 0, 1); PG8_STAGE(PG8_SA(0, 0), a2, voffA);
            PG8_BAR; PG8_WAIT_L(0); PG8_MMA(1, 0, At, B0); PG8_BAR; PG8_SCHED;
            PG8_STAGE(PG8_SB(0, 1), b2 + hstepB, voffB);
            PG8_WAIT_V(6); PG8_BAR; PG8_MMA(1, 1, At, B1); PG8_BAR;
            PG8_LDB(B0, 1, 0); PG8_SCHED; PG8_LDA(At, 1, 0); PG8_STAGE(PG8_SA(0, 1), a2 + hstepA, voffA);
            PG8_WAIT_L(8); PG8_BAR; PG8_WAIT_L(0); PG8_MMA(0, 0, At, B0); PG8_BAR; PG8_SCHED;
            PG8_LDB(B1, 1, 1); PG8_STAGE(PG8_SB(1, 0), b3, voffB);
            PG8_BAR; PG8_WAIT_L(0); PG8_MMA(0, 1, At, B1); PG8_BAR;
            PG8_LDA(At, 1, 1); PG8_STAGE(PG8_SA(1, 0), a3, voffA);
            PG8_BAR; PG8_WAIT_L(0); PG8_MMA(1, 0, At, B0); PG8_BAR; PG8_SCHED;
            PG8_STAGE(PG8_SB(1, 1), b3 + hstepB, voffB);
            PG8_WAIT_V(6); PG8_BAR; PG8_MMA(1, 1, At, B1); PG8_BAR;
        }
        { int fr_ = fr, fq_ = fq; asm volatile("" : "+v"(fr_), "+v"(fq_));
          E(acc, cur, wr, wc, fr_, fq_); }
        if (!has_next) break;
#pragma unroll
        for (int a = 0; a < 2; ++a)
#pragma unroll
            for (int b = 0; b < 2; ++b)
#pragma unroll
                for (int m = 0; m < 4; ++m)
#pragma unroll
                    for (int n = 0; n < 2; ++n) acc[a][b][m][n] = (f32x4){0.f, 0.f, 0.f, 0.f};
        cur = nxt; cA = nA; cB = nB; ++ui;
    }
    PG8_WAIT_V(0);
    if (wr == 0) PG8_BAR;
    PG8_BAR;
#undef PG8_SA
#undef PG8_SB
#undef PG8_STAGE
#undef PG8_LDA
#undef PG8_LDB
#undef PG8_MMA
#undef PG8_WAIT_V
#undef PG8_WAIT_L
#undef PG8_BAR
#undef PG8_SCHED
}

typedef const f32x4 (&AccRef)[2][2][4][2];
__device__ __forceinline__ u32x4 pack8(f32x4 v0, f32x4 v1) { u32x4 w; w.x = cvt_pk_bf16(v0[0], v0[1]); w.y = cvt_pk_bf16(v0[2], v0[3]); w.z = cvt_pk_bf16(v1[0], v1[1]); w.w = cvt_pk_bf16(v1[2], v1[3]); return w; }
__device__ __forceinline__ void unpack8(u32x4 w, f32x4& v0, f32x4& v1) {
    v0[0] = __uint_as_float(w.x << 16); v0[1] = __uint_as_float(w.x & 0xffff0000u); v0[2] = __uint_as_float(w.y << 16); v0[3] = __uint_as_float(w.y & 0xffff0000u);
    v1[0] = __uint_as_float(w.z << 16); v1[1] = __uint_as_float(w.z & 0xffff0000u); v1[2] = __uint_as_float(w.w << 16); v1[3] = __uint_as_float(w.w & 0xffff0000u);
}

struct EpiUPG {
    static constexpr bool PERM = true; bf16_t* UP; bf16_t* G;
    __device__ __forceinline__ void operator()(AccRef acc, const Unit& u, int wr, int wc, int fr, int fq) const {
        const int row0 = u.pm * BM + wr * 64 + fr; const bool sg = u.pn >= 4;
        bf16_t* base = sg ? G : UP; const int ldc = sg ? 4096 : 1024; const int col0 = (sg ? u.pn * BM - 1024 : u.pn * BM) + wc * 32 + 8 * fq;
#pragma unroll
        for (int ai = 0; ai < 2; ++ai)
#pragma unroll
            for (int m = 0; m < 4; ++m) { bf16_t* rowp = base + (size_t)(row0 + ai * HALF + m * 16) * ldc + col0;
#pragma unroll
                for (int bj = 0; bj < 2; ++bj) { f32x4 v0 = acc[ai][bj][m][0], v1 = acc[ai][bj][m][1];
                    if (sg) {
#pragma unroll
                        for (int j = 0; j < 4; ++j) { v0[j] = sigmoidf_(v0[j]); v1[j] = sigmoidf_(v1[j]); } }
                    *(u32x4*)(rowp + bj * HALF) = pack8(v0, v1); }
                __builtin_amdgcn_sched_barrier(0); }
    }
};
struct EpiRaw {
    static constexpr bool PERM = true; bf16_t* O; int ldc;
    __device__ __forceinline__ void operator()(AccRef acc, const Unit& u, int wr, int wc, int fr, int fq) const {
        const int row0 = u.pm * BM + wr * 64 + fr; const int col0 = u.pn * BM + wc * 32 + 8 * fq;
#pragma unroll
        for (int ai = 0; ai < 2; ++ai)
#pragma unroll
            for (int m = 0; m < 4; ++m) { bf16_t* rowp = O + (size_t)(row0 + ai * HALF + m * 16) * ldc + col0;
#pragma unroll
                for (int bj = 0; bj < 2; ++bj) *(u32x4*)(rowp + bj * HALF) = pack8(acc[ai][bj][m][0], acc[ai][bj][m][1]);
                __builtin_amdgcn_sched_barrier(0); }
    }
};
struct EpiPool {
    static constexpr bool PERM = true; bf16_t* O; const float* scale;
    __device__ __forceinline__ void operator()(AccRef acc, const Unit& u, int wr, int wc, int fr, int fq) const {
        const int row0 = u.pm * BM + wr * 64 + fr; const int col0 = u.pn * BM + wc * 32 + 8 * fq;
        f32x4 s[2][2];
#pragma unroll
        for (int bj = 0; bj < 2; ++bj) { s[bj][0] = *(const f32x4*)(scale + col0 + bj * HALF); s[bj][1] = *(const f32x4*)(scale + col0 + bj * HALF + 4); }
#pragma unroll
        for (int ai = 0; ai < 2; ++ai)
#pragma unroll
            for (int m = 0; m < 4; ++m) { bf16_t* rowp = O + (size_t)(row0 + ai * HALF + m * 16) * 2048 + col0;
#pragma unroll
                for (int bj = 0; bj < 2; ++bj) *(u32x4*)(rowp + bj * HALF) = pack8(acc[ai][bj][m][0] * s[bj][0], acc[ai][bj][m][1] * s[bj][1]);
                __builtin_amdgcn_sched_barrier(0); }
    }
};
template <bool ADD> struct EpiGate {
    static constexpr bool PERM = true; const bf16_t* Gt; const bf16_t* T; bf16_t* O;
    __device__ __forceinline__ void operator()(AccRef acc, const Unit& u, int wr, int wc, int fr, int fq) const {
        const int row0 = u.pm * BM + wr * 64 + fr; const int col0 = u.pn * BM + wc * 32 + 8 * fq;
#pragma unroll
        for (int ai = 0; ai < 2; ++ai) {
            u32x4 gw[4][2], tw[4][2];
#pragma unroll
            for (int m = 0; m < 4; ++m)
#pragma unroll
                for (int bj = 0; bj < 2; ++bj) { const size_t row = (size_t)(row0 + ai * HALF + m * 16);
                    gw[m][bj] = *(const u32x4*)(Gt + row * 4096 + col0 + bj * HALF);
                    if (ADD) tw[m][bj] = *(const u32x4*)(T + row * 2048 + col0 + bj * HALF); }
#pragma unroll
            for (int m = 0; m < 4; ++m)
#pragma unroll
                for (int bj = 0; bj < 2; ++bj) { const size_t row = (size_t)(row0 + ai * HALF + m * 16);
                    f32x4 g0, g1; unpack8(gw[m][bj], g0, g1);
                    f32x4 v0 = acc[ai][bj][m][0] * g0, v1 = acc[ai][bj][m][1] * g1;
                    if (ADD) { f32x4 t0, t1; unpack8(tw[m][bj], t0, t1); v0 += t0; v1 += t1; }
                    *(u32x4*)(O + row * 2048 + col0 + bj * HALF) = pack8(v0, v1); }
            __builtin_amdgcn_sched_barrier(0);
        }
    }
};
struct EpiMerge {
    static constexpr bool PERM = true; const bf16_t* G; bf16_t* O;
    __device__ __forceinline__ void mid(f32x4 (&acc)[2][2][4][2], const Unit& u, int wr, int wc, int fr, int fq) const {
        const int row0 = u.pm * BM + wr * 64 + fr; const int col0 = u.pn * BM + wc * 32 + 8 * fq;
        u32x4 ga[2][2][2], gb[2][2][2];
#define MRG_LOAD(buf, k) do { _Pragma("unroll") for (int mm = 0; mm < 2; ++mm) _Pragma("unroll") for (int bj = 0; bj < 2; ++bj) { \
            const bf16_t* gp = G + (size_t)(row0 + ((k) >> 1) * HALF + (((k) & 1) * 2 + mm) * 16) * 4096 + col0 + bj * HALF; \
            ga[buf][mm][bj] = *(const u32x4*)gp; gb[buf][mm][bj] = *(const u32x4*)(gp + 2048); } } while (0)
        MRG_LOAD(0, 0);
#pragma unroll
        for (int k = 0; k < 4; ++k) {
            if (k < 3) MRG_LOAD((k + 1) & 1, k + 1);
            const int ai = k >> 1, mp = k & 1;
#pragma unroll
            for (int mm = 0; mm < 2; ++mm)
#pragma unroll
                for (int bj = 0; bj < 2; ++bj) { f32x4 a0, a1, b0, b1; unpack8(ga[k & 1][mm][bj], a0, a1); unpack8(gb[k & 1][mm][bj], b0, b1);
#pragma unroll
                    for (int j = 0; j < 4; ++j) { acc[ai][bj][mp * 2 + mm][0][j] *= a0[j] * __builtin_amdgcn_rcpf(b0[j]); acc[ai][bj][mp * 2 + mm][1][j] *= a1[j] * __builtin_amdgcn_rcpf(b1[j]); } }
            __builtin_amdgcn_sched_barrier(0);
        }
#undef MRG_LOAD
    }
    __device__ __forceinline__ void operator()(AccRef acc, const Unit& u, int wr, int wc, int fr, int fq) const {
        const int row0 = u.pm * BM + wr * 64 + fr; const int col0 = u.pn * BM + wc * 32 + 8 * fq;
#pragma unroll
        for (int ai = 0; ai < 2; ++ai) {
            u32x4 gw[4][2];
#pragma unroll
            for (int m = 0; m < 4; ++m)
#pragma unroll
                for (int bj = 0; bj < 2; ++bj) gw[m][bj] = *(const u32x4*)(G + (size_t)(row0 + ai * HALF + m * 16) * 4096 + 2048 + col0 + bj * HALF);
#pragma unroll
            for (int m = 0; m < 4; ++m)
#pragma unroll
                for (int bj = 0; bj < 2; ++bj) { f32x4 g0, g1; unpack8(gw[m][bj], g0, g1);
                    *(u32x4*)(O + (size_t)(row0 + ai * HALF + m * 16) * 2048 + col0 + bj * HALF) = pack8(acc[ai][bj][m][0] * g0, acc[ai][bj][m][1] * g1); }
            __builtin_amdgcn_sched_barrier(0);
        }
    }
};
struct EpiRes {
    static constexpr bool PERM = false; const float* R; float* O;
    __device__ __forceinline__ void operator()(AccRef acc, const Unit& u, int wr, int wc, int fr, int fq) const {
        const int row0 = u.pm * BM + wr * 64 + fr; const int col0 = u.pn * BM + wc * 32 + 4 * fq;
#pragma unroll
        for (int ai = 0; ai < 2; ++ai) {
            f32x4 r[4][2][2];
#pragma unroll
            for (int m = 0; m < 4; ++m)
#pragma unroll
                for (int bj = 0; bj < 2; ++bj)
#pragma unroll
                    for (int n = 0; n < 2; ++n) r[m][bj][n] = *(const f32x4*)(R + (size_t)(row0 + ai * HALF + m * 16) * 2048 + col0 + bj * HALF + n * 16);
#pragma unroll
            for (int m = 0; m < 4; ++m)
#pragma unroll
                for (int bj = 0; bj < 2; ++bj)
#pragma unroll
                    for (int n = 0; n < 2; ++n) *(f32x4*)(O + (size_t)(row0 + ai * HALF + m * 16) * 2048 + col0 + bj * HALF + n * 16) = r[m][bj][n] + acc[ai][bj][m][n];
            __builtin_amdgcn_sched_barrier(0);
        }
    }
};
struct EpiSwiGLU {
    static constexpr bool PERM = true; bf16_t* O;
    __device__ __forceinline__ void operator()(AccRef acc, const Unit& u, int wr, int wc, int fr, int fq) const {
        const int row0 = u.pm * BM + wr * 64 + fr; const int col0 = u.pn * HALF + wc * 32 + 8 * fq;
#pragma unroll
        for (int ai = 0; ai < 2; ++ai)
#pragma unroll
            for (int m = 0; m < 4; ++m) { f32x4 v0, v1;
#pragma unroll
                for (int j = 0; j < 4; ++j) { const float a0 = acc[ai][0][m][0][j], a1 = acc[ai][0][m][1][j];
                    v0[j] = a0 * sigmoidf_(a0) * acc[ai][1][m][0][j]; v1[j] = a1 * sigmoidf_(a1) * acc[ai][1][m][1][j]; }
                *(u32x4*)(O + (size_t)(row0 + ai * HALF + m * 16) * DFF + col0) = pack8(v0, v1);
                __builtin_amdgcn_sched_barrier(0); }
    }
};

__device__ __forceinline__ int rowmap(int mode, int n) {
    switch (mode) {
        case 1: return n < 1024 ? n : (n < 4096 ? n + 4096 : n - 3072);
        case 2: return ((n >> 7) << 8) + (n & 127);
        case 3: return ((n >> 7) << 8) + 128 + (n & 127);
        default: return n;
    }
}
__device__ __forceinline__ void transpose_cvt(const Ctx cx, LAS float* tile, const float* src, int K, int N, bf16_t* dst, int mode, int ldd, int koff) {
    constexpr int TB = 4;
    const int tid = cx.tid; const int tn = N >> 6, ntile = (K >> 6) * tn;
    for (int t4 = cx.bid * TB; t4 < ntile; t4 += cx.nblk * TB) {
        f32x4 v[TB][2];
#pragma unroll
        for (int u = 0; u < TB; ++u) { const int t = t4 + u, k0 = (t / tn) << 6, n0 = (t % tn) << 6;
#pragma unroll
            for (int i = 0; i < 2; ++i) { const int kk = (tid >> 4) + i * 32, nc = (tid & 15) << 2; v[u][i] = *(const f32x4*)(src + (size_t)(k0 + kk) * N + n0 + nc); } }
#pragma unroll
        for (int u = 0; u < TB; ++u)
#pragma unroll
            for (int i = 0; i < 2; ++i) { const int kk = (tid >> 4) + i * 32, nc = (tid & 15) << 2; LAS float* tp = tile + u * (64 * 65) + kk * 65 + nc;
                tp[0] = v[u][i][0]; tp[1] = v[u][i][1]; tp[2] = v[u][i][2]; tp[3] = v[u][i][3]; }
        __syncthreads();
#pragma unroll
        for (int u = 0; u < TB; ++u) { const int t = t4 + u, k0 = (t / tn) << 6, n0 = (t % tn) << 6;
            const int nn = tid >> 3, kc = (tid & 7) << 3; f32x4 a, b; const LAS float* tp = tile + u * (64 * 65);
#pragma unroll
            for (int j = 0; j < 4; ++j) { a[j] = tp[(kc + j) * 65 + nn]; b[j] = tp[(kc + 4 + j) * 65 + nn]; }
            *(u32x4*)(dst + (size_t)rowmap(mode, n0 + nn) * ldd + koff + k0 + kc) = pack8(a, b); }
        __syncthreads();
    }
}

__device__ __forceinline__ void filter_features(const Ctx cx, LAS float* sm, const float* fw1, const float* fb1, const float* ff1, const float* fw2, const float* fb2, const float* ff2, int L, bf16_t* Hfb) {
    const int tid = cx.tid, tt = tid >> 6, j = tid & 63;
    LAS float* zf = sm; LAS float* h1s = sm + 8 * 36;
    const float b1 = fb1[j], f1 = ff1[j], b2 = fb2[j], f2 = ff2[j];
    for (int t0 = cx.bid * 8; t0 < L; t0 += cx.nblk * 8) {
        const int t = t0 + tt;
        if (j < 33) { float z;
            if (j == 0) z = (float)t / (float)(L - 1);
            else { const int k = (j - 1) & 15; const float band = 1e-4f + (float)k * ((15.0f - 1e-4f) / 15.0f);
                double rv = (double)band * (double)t / (double)L; rv -= floor(rv); const float r = (float)rv;
                z = (j <= 16) ? __builtin_amdgcn_cosf(r) : -__builtin_amdgcn_sinf(r); }
            zf[tt * 36 + j] = z; }
        __syncthreads();
        { float a = b1; for (int i = 0; i < 33; ++i) a += zf[tt * 36 + i] * fw1[i * 64 + j];
          h1s[tt * 64 + j] = __builtin_amdgcn_sinf(f1 * a * 0.15915494309189535f); }
        __syncthreads();
        { float a = b2; for (int i = 0; i < 64; ++i) a += h1s[tt * 64 + i] * fw2[i * 64 + j];
          Hfb[(size_t)t * 64 + j] = (bf16_t)(cvt_pk_bf16(__builtin_amdgcn_sinf(f2 * a * 0.15915494309189535f), 0.f) & 0xffffu); }
        __syncthreads();
    }
}

__device__ __forceinline__ int PX(int i) { const int h = i >> 5; return i + h + (h << 2); }
__device__ __forceinline__ f32x2 cmul(f32x2 a, f32x2 b) { return (f32x2){a.x * b.x - a.y * b.y, a.x * b.y + a.y * b.x}; }
__device__ __forceinline__ f32x2 cis_rev(float rev) { return (f32x2){__builtin_amdgcn_cosf(rev), __builtin_amdgcn_sinf(rev)}; }
__device__ __forceinline__ f32x2 rot8(f32x2 v, int k, bool inv) {
    const float c = 0.70710678118654752f;
    if (!inv) { switch (k) { case 1: return (f32x2){c * (v.x + v.y), c * (v.y - v.x)}; case 2: return (f32x2){v.y, -v.x}; case 3: return (f32x2){c * (v.y - v.x), -c * (v.x + v.y)}; default: return v; } }
    else      { switch (k) { case 1: return (f32x2){c * (v.x - v.y), c * (v.x + v.y)}; case 2: return (f32x2){-v.y, v.x}; case 3: return (f32x2){-c * (v.x + v.y), c * (v.x - v.y)}; default: return v; } }
}
template <int LOGR> __device__ __forceinline__ void dif_bfly(f32x2 (&v)[1 << LOGR], int r, int logm) {
    constexpr int R = 1 << LOGR;
    f32x2 W = cis_rev(-(float)r * __uint_as_float((unsigned)(126 - logm) << 23));
#pragma unroll
    for (int s = 0; s < LOGR; ++s) {
        const int half = R >> (s + 1);
#pragma unroll
        for (int q = 0; q < R; ++q) if ((q & half) == 0) {
            const int qq = q & (half - 1);
            const f32x2 a = v[q], b = v[q + half];
            v[q] = a + b;
            v[q + half] = rot8(cmul(a - b, W), (qq << s) * (8 / R), false);
        }
        W = cmul(W, W);
    }
}
template <int LOGR> __device__ __forceinline__ void dit_bfly(f32x2 (&v)[1 << LOGR], int r, int logm0) {
    constexpr int R = 1 << LOGR;
    f32x2 Wt[LOGR];
    Wt[LOGR - 1] = cis_rev((float)r * __uint_as_float((unsigned)(127 - (logm0 + LOGR)) << 23));
#pragma unroll
    for (int s = LOGR - 2; s >= 0; --s) Wt[s] = cmul(Wt[s + 1], Wt[s + 1]);
#pragma unroll
    for (int s = 0; s < LOGR; ++s) {
        const int half = 1 << s;
        const f32x2 W = Wt[s];
#pragma unroll
        for (int q = 0; q < R; ++q) if ((q & half) == 0) {
            const int qq = q & (half - 1);
            const f32x2 a = v[q], b = rot8(cmul(v[q + half], W), qq * (4 >> s), true);
            v[q] = a + b; v[q + half] = a - b;
        }
    }
}
template <int LOGR> __device__ __forceinline__ void dif_pass(const Ctx cx, LAS f32x2* X, int logN, int logm) {
    constexpr int R = 1 << LOGR;
    const int logsub = logm - LOGR + 1, sub = 1 << logsub, ngroups = 1 << (logN - LOGR), psub = PX(sub);
#pragma unroll 2
    for (int g = cx.tid; g < ngroups; g += 512) {
        const int r = g & (sub - 1), blk = g >> logsub, base = (blk << (logm + 1)) + r, pb = PX(base);
        f32x2 v[R];
#pragma unroll
        for (int q = 0; q < R; ++q) v[q] = X[pb + ((sub >= 32) ? q * psub : (q * sub + 5 * ((q * sub) >> 5)))];
        dif_bfly<LOGR>(v, r, logm);
#pragma unroll
        for (int q = 0; q < R; ++q) X[pb + ((sub >= 32) ? q * psub : (q * sub + 5 * ((q * sub) >> 5)))] = v[q];
    }
}
template <int LOGR> __device__ __forceinline__ void dit_pass(const Ctx cx, LAS f32x2* X, int logN, int logm0) {
    constexpr int R = 1 << LOGR;
    const int sub = 1 << logm0, ngroups = 1 << (logN - LOGR), psub = PX(sub);
#pragma unroll 2
    for (int g = cx.tid; g < ngroups; g += 512) {
        const int r = g & (sub - 1), blk = g >> logm0, base = (blk << (logm0 + LOGR)) + r, pb = PX(base);
        f32x2 v[R];
#pragma unroll
        for (int q = 0; q < R; ++q) v[q] = X[pb + ((sub >= 32) ? q * psub : (q * sub + 5 * ((q * sub) >> 5)))];
        dit_bfly<LOGR>(v, r, logm0);
#pragma unroll
        for (int q = 0; q < R; ++q) X[pb + ((sub >= 32) ? q * psub : (q * sub + 5 * ((q * sub) >> 5)))] = v[q];
    }
}
__device__ __forceinline__ void fft_fwd(const Ctx cx, LAS f32x2* X, int logN) {
    int n8 = 0, n4 = 0; for (int rem = logN; rem > 0;) { if (rem > 4 || rem == 3) { ++n8; rem -= 3; } else { ++n4; rem -= 2; } }
    int logm = logN - 1;
    for (int i = 0; i < n8; ++i) { dif_pass<3>(cx, X, logN, logm); logm -= 3; __syncthreads(); }
    for (int i = 0; i < n4; ++i) { dif_pass<2>(cx, X, logN, logm); logm -= 2; __syncthreads(); }
}
__device__ __forceinline__ void fft_inv(const Ctx cx, LAS f32x2* X, int logN) {
    int n8 = 0, n4 = 0; for (int rem = logN; rem > 0;) { if (rem > 4 || rem == 3) { ++n8; rem -= 3; } else { ++n4; rem -= 2; } }
    int lm = 0;
    for (int i = 0; i < n4; ++i) { dit_pass<2>(cx, X, logN, lm); lm += 2; __syncthreads(); }
    for (int i = 0; i < n8; ++i) { dit_pass<3>(cx, X, logN, lm); lm += 3; __syncthreads(); }
}
__device__ __forceinline__ int fft_partner(int pp) { if (pp == 0) return 0; const int j = 31 - __builtin_clz(pp); return (3 << j) - 1 - pp; }

__device__ __forceinline__ void filter_spectrum(const Ctx cx, LAS unsigned char* lds, const bf16_t* W3T, const float* hbias, int L, int logN2, const bf16_t* Hfb, f32x2* FS) {
    const int tid = cx.tid, N2 = 2 * L, wid = tid >> 6, lane = tid & 63, fr = lane & 15, fq = lane >> 4;
    LAS f32x2* X = (LAS f32x2*)lds; LAS float* red = (LAS float*)(lds + LDS_X_BYTES);
    const float min_decay = -3.0701134573253944f, max_decay = -15.350567286626972f;
    const float tscale = 1.0f / (float)(L - 1);
    for (int c = cx.bid; c < 1024; c += cx.nblk) {
        bf16x8 wf0 = (bf16x8){0, 0, 0, 0, 0, 0, 0, 0}, wf1 = wf0;
        if (fr < 4) { wf0 = *(const bf16x8*)(W3T + (size_t)c * 256 + fr * 64 + fq * 8); wf1 = *(const bf16x8*)(W3T + (size_t)c * 256 + fr * 64 + 32 + fq * 8); }
        if (tid == 0) X[PX(L)] = (f32x2){0.f, 0.f};
        const float delta = fabsf(min_decay + (max_decay - min_decay) * ((float)c / 1023.0f));
        float ss0 = 0.f, ss1 = 0.f;
#pragma unroll 8
        for (int tl = wid; tl < (L >> 4); tl += 8) {
            const int n = (tl << 4) + fr;
            const bf16x8 h0 = *(const bf16x8*)(Hfb + (size_t)n * 64 + fq * 8), h1 = *(const bf16x8*)(Hfb + (size_t)n * 64 + 32 + fq * 8);
            f32x4 acc = (f32x4){0.f, 0.f, 0.f, 0.f};
            acc = __builtin_amdgcn_mfma_f32_16x16x32_bf16(wf0, h0, acc, 0, 0, 0);
            acc = __builtin_amdgcn_mfma_f32_16x16x32_bf16(wf1, h1, acc, 0, 0, 0);
            if (fq == 0) {
                const float dec = __expf(-((float)n * tscale) * delta);
                const float f00 = acc[0] * dec, f01 = acc[1] * dec, f10 = acc[2] * dec, f11 = acc[3] * dec;
                if (n == 0) { const f32x2 v = (f32x2){f00 + f01, f10 + f11}; X[PX(0)] = v; ss0 += v.x * v.x; ss1 += v.y * v.y; }
                else { X[PX(n)] = (f32x2){f00, f10}; X[PX(N2 - n)] = (f32x2){f01, f11}; ss0 += f00 * f00 + f01 * f01; ss1 += f10 * f10 + f11 * f11; }
            }
        }
        ss0 = wave_sum(tid, ss0); ss1 = wave_sum(tid, ss1);
        if (lane == 0) { red[wid * 2] = ss0; red[wid * 2 + 1] = ss1; }
        __syncthreads();
        float t0 = 0.f, t1 = 0.f;
#pragma unroll
        for (int w = 0; w < 8; ++w) { t0 += red[w * 2]; t1 += red[w * 2 + 1]; }
        const float sc = 0.5f / (float)N2; const f32x2 rs = (f32x2){rsqrtf(t0 + 1e-6f) * sc, rsqrtf(t1 + 1e-6f) * sc};
        for (int n = tid; n < N2; n += 512) X[PX(n)] *= rs;
        __syncthreads();
        fft_fwd(cx, X, logN2);
        f32x2* dst = FS + (size_t)c * N2;
        const f32x2 dbias = (f32x2){hbias[c] * sc, hbias[1024 + c] * sc};
        for (int n = tid; n < N2; n += 512) dst[n] = X[PX(n)] + dbias;
        __syncthreads();
    }
}

__device__ __forceinline__ float sconv(const bf16_t* row, int n, int L, float w0, float w1, float w2, float b) {
    const float um = n > 0 ? bf2f(row[n - 1]) : 0.f, u0 = bf2f(row[n]), up = (n + 1 < L) ? bf2f(row[n + 1]) : 0.f;
    return um * w0 + u0 * w1 + up * w2 + b;
}
template <int GW> __device__ __forceinline__ void convN(const bf16_t* row, int n0, int L, float w0, float w1, float w2, float b, float (&o)[GW]) {
    float u[GW + 2];
    u[0] = n0 > 0 ? bf2f(row[n0 - 1]) : 0.f;
    u[GW + 1] = (n0 + GW < L) ? bf2f(row[n0 + GW]) : 0.f;
    if (GW == 4) { const u32x2 w = *(const u32x2*)(row + n0); u[1] = __uint_as_float(w.x << 16); u[2] = __uint_as_float(w.x & 0xffff0000u); u[3] = __uint_as_float(w.y << 16); u[GW] = __uint_as_float(w.y & 0xffff0000u); }
    else { const unsigned w = *(const unsigned*)(row + n0); u[1] = __uint_as_float(w << 16); u[2] = __uint_as_float(w & 0xffff0000u); }
#pragma unroll
    for (int i = 0; i < GW; ++i) o[i] = u[i] * w0 + u[i + 1] * w1 + u[i + 2] * w2 + b;
}
template <int GW> __device__ __forceinline__ void hyena_p1(int tid, LAS f32x2* X, int logN2, int L, int order, const bf16_t* rowA, const bf16_t* rowB, float w0, float w1, float w2, float wb, f32x2* Z1) {
    const int lsub = logN2 - 3, sub = 1 << lsub;
    for (int t = tid; t < (sub / GW); t += 512) {
        const int r0 = t * GW, pb0 = PX(r0), psub = PX(sub);
        f32x2 v[GW][8];
#pragma unroll
        for (int q = 0; q < 4; ++q) { const int n0 = r0 + q * sub;
            if (order == 0) { float a[GW], b[GW]; convN<GW>(rowA, n0, L, w0, w1, w2, wb, a); convN<GW>(rowB, n0, L, w0, w1, w2, wb, b);
#pragma unroll
                for (int i = 0; i < GW; ++i) v[i][q] = (f32x2){a[i], b[i]};
 }
            else {
#pragma unroll
                for (int i = 0; i < GW / 2; ++i) { const f32x4 z = ((const f32x4*)(Z1 + n0))[i]; v[2 * i][q] = (f32x2){z[0], z[1]}; v[2 * i + 1][q] = (f32x2){z[2], z[3]}; } } }
#pragma unroll
        for (int i = 0; i < GW; ++i) {
#pragma unroll
            for (int q = 4; q < 8; ++q) v[i][q] = (f32x2){0.f, 0.f};
            dif_bfly<3>(v[i], r0 + i, logN2 - 1); }
#pragma unroll
        for (int q = 0; q < 8; ++q)
#pragma unroll
            for (int i = 0; i < GW; ++i) X[pb0 + i + q * psub] = v[i][q];
    }
}
template <int GW> __device__ __forceinline__ void hyena_p9(int tid, LAS f32x2* X, int logN2, int L, int order, const bf16_t* rowA, const bf16_t* rowB, float w0, float w1, float w2, float wb, float hb, f32x2* Z1, bf16_t* outA, bf16_t* outB) {
    const int lsub = logN2 - 3, sub = 1 << lsub;
    for (int t = tid; t < (sub / GW); t += 512) {
        const int r0 = t * GW, pb0 = PX(r0), psub = PX(sub);
        f32x2 v[GW][8];
#pragma unroll
        for (int q = 0; q < 8; ++q)
#pragma unroll
            for (int i = 0; i < GW; ++i) v[i][q] = X[pb0 + i + q * psub];
#pragma unroll
        for (int i = 0; i < GW; ++i) dit_bfly<3>(v[i], r0 + i, lsub);
#pragma unroll
        for (int q = 0; q < 4; ++q) { const int n0 = r0 + q * sub;
            float xa[GW], xb[GW]; convN<GW>(rowA, n0, L, w0, w1, w2, wb, xa); convN<GW>(rowB, n0, L, w0, w1, w2, wb, xb);
            f32x2 zo[GW];
#pragma unroll
            for (int i = 0; i < GW; ++i) zo[i] = (f32x2){xa[i] * v[i][q].x, xb[i] * v[i][q].y};
            if (order == 0) {
#pragma unroll
                for (int i = 0; i < GW / 2; ++i) ((f32x4*)(Z1 + n0))[i] = (f32x4){zo[2 * i].x, zo[2 * i].y, zo[2 * i + 1].x, zo[2 * i + 1].y}; }
            else if (GW == 4) { u32x2 wa, wb2; wa.x = cvt_pk_bf16(zo[0].x, zo[1].x); wa.y = cvt_pk_bf16(zo[2].x, zo[GW - 1].x); wb2.x = cvt_pk_bf16(zo[0].y, zo[1].y); wb2.y = cvt_pk_bf16(zo[2].y, zo[GW - 1].y);
                *(u32x2*)(outA + n0) = wa; *(u32x2*)(outB + n0) = wb2; }
            else { *(unsigned*)(outA + n0) = cvt_pk_bf16(zo[0].x, zo[1].x); *(unsigned*)(outB + n0) = cvt_pk_bf16(zo[0].y, zo[1].y); }
        }
    }
}
__device__ __forceinline__ void hyena_phase(const Ctx cx, LAS unsigned char* lds, const float* conv_w, const float* conv_b, const float* hbias, int L, int logN2, int nbatch, const f32x2* FS, const bf16_t* UH, bf16_t* BT, f32x2* Z1) {
    const int tid = cx.tid, N2 = 2 * L;
    LAS f32x2* X = (LAS f32x2*)lds;
    int n8 = 0, n4 = 0; for (int rem = logN2; rem > 0;) { if (rem > 4 || rem == 3) { ++n8; rem -= 3; } else { ++n4; rem -= 2; } }
    const int lsub = logN2 - 3, sub = 1 << lsub;
    for (int c = cx.bid; c < 1024; c += cx.nblk) {
        const f32x2* FSc = FS + (size_t)c * N2;
        const float v0 = conv_w[c], v1 = conv_w[3072 + c], v2 = conv_w[6144 + c], v3 = conv_b[c];
        const float bias0 = hbias[c], bias1 = hbias[1024 + c];
        const bf16_t* uv = UH + (size_t)c * NTG;
        for (int pair = 0; pair < nbatch / 2; ++pair) {
            const int tA = (2 * pair) * L, tB = tA + L;
            for (int order = 0; order < 2; ++order) {
                const int gch = (order + 1) * 1024 + c;
                const bf16_t* ug = UH + (size_t)gch * NTG;
                const float g0 = conv_w[gch], g1 = conv_w[3072 + gch], g2 = conv_w[6144 + gch], g3 = conv_b[gch];
                const float hb = order ? bias1 : bias0;
                if (logN2 == 14) hyena_p1<4>(tid, X, logN2, L, order, uv + tA, uv + tB, v0, v1, v2, v3, Z1);
                else             hyena_p1<2>(tid, X, logN2, L, order, uv + tA, uv + tB, v0, v1, v2, v3, Z1);
                __syncthreads();
                { int logm = logN2 - 4;
                  for (int i = 1; i < n8; ++i) { dif_pass<3>(cx, X, logN2, logm); logm -= 3; __syncthreads(); }
                  for (int i = 0; i < n4 - 1; ++i) { dif_pass<2>(cx, X, logN2, logm); logm -= 2; __syncthreads(); } }
#pragma unroll 2
                for (int g = tid; g < (N2 >> 2); g += 512) {
                    const int base = g << 2, pbase = PX(base);
                    f32x2 v[4];
#pragma unroll
                    for (int q = 0; q < 4; ++q) v[q] = X[pbase + q];
                    const int pb = base ? ((3 << (31 - __builtin_clz(base))) - 4 - base) : 0;
                    const f32x4 a01 = *(const f32x4*)(FSc + base), a23 = *(const f32x4*)(FSc + base + 2);
                    const f32x4 b01 = *(const f32x4*)(FSc + pb), b23 = *(const f32x4*)(FSc + pb + 2);
                    { f32x2 a = v[0], b = v[2]; v[0] = a + b; v[2] = a - b; a = v[1]; b = v[3]; v[1] = a + b; v[3] = rot8(a - b, 2, false);
                      a = v[0]; b = v[1]; v[0] = a + b; v[1] = a - b; a = v[2]; b = v[3]; v[2] = a + b; v[3] = a - b; }
                    f32x2 A[4], Bn[4];
                    A[0] = (f32x2){a01[0], a01[1]}; A[1] = (f32x2){a01[2], a01[3]}; A[2] = (f32x2){a23[0], a23[1]}; A[3] = (f32x2){a23[2], a23[3]};
                    if (base) { Bn[0] = (f32x2){b23[2], b23[3]}; Bn[1] = (f32x2){b23[0], b23[1]}; Bn[2] = (f32x2){b01[2], b01[3]}; Bn[3] = (f32x2){b01[0], b01[1]}; }
                    else      { Bn[0] = (f32x2){b01[0], b01[1]}; Bn[1] = (f32x2){b01[2], b01[3]}; Bn[2] = (f32x2){b23[2], b23[3]}; Bn[3] = (f32x2){b23[0], b23[1]}; }
#pragma unroll
                    for (int q = 0; q < 4; ++q) { const f32x2 Hq = order ? (f32x2){A[q].y + Bn[q].y, Bn[q].x - A[q].x} : (f32x2){A[q].x + Bn[q].x, A[q].y - Bn[q].y};
                        v[q] = cmul(v[q], Hq); }
                    { f32x2 a = v[0], b = v[1]; v[0] = a + b; v[1] = a - b; a = v[2]; b = v[3]; v[2] = a + b; v[3] = a - b;
                      a = v[0]; b = v[2]; v[0] = a + b; v[2] = a - b; a = v[1]; b = rot8(v[3], 2, true); v[1] = a + b; v[3] = a - b; }
#pragma unroll
                    for (int q = 0; q < 4; ++q) X[pbase + q] = v[q];
                }
                __syncthreads();
                { int lm = 2;
                  for (int i = 1; i < n4; ++i) { dit_pass<2>(cx, X, logN2, lm); lm += 2; __syncthreads(); }
                  for (int i = 0; i < n8 - 1; ++i) { dit_pass<3>(cx, X, logN2, lm); lm += 3; __syncthreads(); } }
                if (logN2 == 14) hyena_p9<4>(tid, X, logN2, L, order, ug + tA, ug + tB, g0, g1, g2, g3, hb, Z1, BT + (size_t)c * NTG + tA, BT + (size_t)c * NTG + tB);
                else             hyena_p9<2>(tid, X, logN2, L, order, ug + tA, ug + tB, g0, g1, g2, g3, hb, Z1, BT + (size_t)c * NTG + tA, BT + (size_t)c * NTG + tB);
                __syncthreads();
            }
        }
    }
}

template <int HW> __device__ __forceinline__ void pool_item(const bf16_t* UP, bf16_t* PL, int L, int tok, int ch0) {
    const int t = tok & (L - 1);
    const bf16_t* basep = UP + (size_t)(tok - t) * 1024 + ch0;
    u32x4 w[2 * HW];
#pragma unroll
    for (int i = 0; i < 2 * HW; ++i) { const int s = t - HW + i; const int sc = s < 0 ? 0 : (s >= L ? L - 1 : s); w[i] = *(const u32x4*)(basep + (size_t)sc * 1024); }
    f32x4 s0 = (f32x4){0.f, 0.f, 0.f, 0.f}, s1 = s0;
#pragma unroll
    for (int i = 0; i < 2 * HW; ++i) { const int s = t - HW + i; f32x4 a, b; unpack8(w[i], a, b); const float m = (s >= 0 && s < L) ? 1.0f : 0.0f; s0 += a * m; s1 += b * m; }
    f32x4 a, b; unpack8(w[HW], a, b);
    const int lo = (t - HW) < 0 ? 0 : (t - HW), hi = (t + HW) > L ? L : (t + HW);
    const float inv = 1.0f / (float)(hi - lo);
    *(u32x4*)(PL + (size_t)tok * 2048 + ch0) = pack8(s0 * inv - a, s1 * inv - b);
}
__device__ __forceinline__ void pool_phase(const Ctx cx, const bf16_t* UP, bf16_t* PL, int L) {
    const int total = NTG * 128;
    for (int idx = cx.bid * 512 + cx.tid; idx < total; idx += cx.nblk * 512) {
        const int grp = idx / (NTG * 32), rem = idx - grp * (NTG * 32), tok = rem >> 5, ch0 = grp * 256 + ((rem & 31) << 3);
        switch (grp) {
            case 0: pool_item<1>(UP, PL, L, tok, ch0); break;
            case 1: pool_item<2>(UP, PL, L, tok, ch0); break;
            case 2: pool_item<4>(UP, PL, L, tok, ch0); break;
            default: pool_item<8>(UP, PL, L, tok, ch0); break;
        }
    }
}

__device__ __forceinline__ void bt_transpose(const Ctx cx, LAS unsigned short* tile, const bf16_t* BT, bf16_t* AB) {
    constexpr int TB = 4;
    const int tid = cx.tid;
    constexpr int NTT = NTG / 64;
    for (int t4 = cx.bid * TB; t4 < 16 * NTT; t4 += cx.nblk * TB) {
        u32x4 w[TB];
#pragma unroll
        for (int u = 0; u < TB; ++u) { const int t = t4 + u, c0 = (t / NTT) << 6, k0 = (t % NTT) << 6; const int r = tid >> 3, cc = (tid & 7) << 3;
            w[u] = *(const u32x4*)(BT + (size_t)(c0 + r) * NTG + k0 + cc); }
#pragma unroll
        for (int u = 0; u < TB; ++u) { const int r = tid >> 3, cc = (tid & 7) << 3; LAS unsigned short* d = tile + u * (64 * 72) + r * 72 + cc;
            d[0] = (unsigned short)(w[u].x & 0xffff); d[1] = (unsigned short)(w[u].x >> 16); d[2] = (unsigned short)(w[u].y & 0xffff); d[3] = (unsigned short)(w[u].y >> 16);
            d[4] = (unsigned short)(w[u].z & 0xffff); d[5] = (unsigned short)(w[u].z >> 16); d[6] = (unsigned short)(w[u].w & 0xffff); d[7] = (unsigned short)(w[u].w >> 16); }
        __syncthreads();
#pragma unroll
        for (int u = 0; u < TB; ++u) { const int t = t4 + u, c0 = (t / NTT) << 6, k0 = (t % NTT) << 6; const int tk = tid >> 3, ch = (tid & 7) << 3; const LAS unsigned short* tp = tile + u * (64 * 72); u32x4 o;
            o.x = (unsigned)tp[(ch + 0) * 72 + tk] | ((unsigned)tp[(ch + 1) * 72 + tk] << 16); o.y = (unsigned)tp[(ch + 2) * 72 + tk] | ((unsigned)tp[(ch + 3) * 72 + tk] << 16);
            o.z = (unsigned)tp[(ch + 4) * 72 + tk] | ((unsigned)tp[(ch + 5) * 72 + tk] << 16); o.w = (unsigned)tp[(ch + 6) * 72 + tk] | ((unsigned)tp[(ch + 7) * 72 + tk] << 16);
            *(u32x4*)(AB + (size_t)(k0 + tk) * 2048 + 1024 + c0 + ch) = o; }
        __syncthreads();
    }
}

template <bool OUTF32> __device__ __forceinline__ void rmsnorm_phase(const Ctx cx, const float* x, const float* g, void* outp, int nrows) {
    constexpr int RB = 4;
    const int wave = cx.tid >> 6, lane = cx.tid & 63;
    const int nw = cx.nblk * 8;
    for (int row0 = (cx.bid * 8 + wave) * RB; row0 < nrows; row0 += nw * RB) {
        f32x4 v[RB][8];
#pragma unroll
        for (int rb = 0; rb < RB; ++rb) { const f32x4* xr = (const f32x4*)(x + (size_t)(row0 + rb) * DM);
#pragma unroll
            for (int i = 0; i < 8; ++i) v[rb][i] = __builtin_nontemporal_load(xr + lane + 64 * i); }
        float rs[RB];
#pragma unroll
        for (int rb = 0; rb < RB; ++rb) { float ss = 0.f;
#pragma unroll
            for (int i = 0; i < 8; ++i) ss += v[rb][i][0] * v[rb][i][0] + v[rb][i][1] * v[rb][i][1] + v[rb][i][2] * v[rb][i][2] + v[rb][i][3] * v[rb][i][3];
            ss = wave_sum(cx.tid, ss); rs[rb] = rsqrtf(ss * (1.0f / DM) + 1e-6f); }
#pragma unroll
        for (int i = 0; i < 8; ++i) { const f32x4 gv = ((const f32x4*)g)[lane + 64 * i];
#pragma unroll
            for (int rb = 0; rb < RB; ++rb) { const f32x4 o = v[rb][i] * rs[rb] * gv;
                if (OUTF32) __builtin_nontemporal_store(o, (f32x4*)((float*)outp + (size_t)(row0 + rb) * DM) + lane + 64 * i);
                else { u32x2 w; w.x = cvt_pk_bf16(o[0], o[1]); w.y = cvt_pk_bf16(o[2], o[3]); ((u32x2*)((bf16_t*)outp + (size_t)(row0 + rb) * DM))[lane + 64 * i] = w; } } }
    }
}

#define XB_TMO      128
#define XB_XCNT(j)  (256  + 64 * (j))
#define XB_XSUB(j)  (1280 + 64 * (j))
#define XB_XGEN(j)  (2304 + 64 * (j))
#define XB_TOP      3328
#define XB_TOPGEN   3392
#define XCD_BAR_WORDS 3456
#define XB_SPIN_CAP (1u << 18)
__device__ __forceinline__ unsigned xb_ld(unsigned* p)              { return __hip_atomic_load(p, __ATOMIC_RELAXED, __HIP_MEMORY_SCOPE_AGENT); }
__device__ __forceinline__ unsigned xb_add(unsigned* p, unsigned v) { return __hip_atomic_fetch_add(p, v, __ATOMIC_RELAXED, __HIP_MEMORY_SCOPE_AGENT); }
__device__ __forceinline__ unsigned xb_xcc_id() { return (unsigned)__builtin_amdgcn_s_getreg((3 << 11) | 20) & 0xFu; }
#define XB_SPIN(cond, bar) do { unsigned _sp = 0; while (cond) { __builtin_amdgcn_s_sleep(1); \
    if ((++_sp & 255u) == 0u) { if (xb_ld(&(bar)[XB_TMO])) break; if (_sp > XB_SPIN_CAP) { atomicAdd(&(bar)[XB_TMO], 1u); break; } } } } while (0)
__device__ __forceinline__ void xcd_barrier_complete(unsigned* bar, unsigned x, unsigned G, unsigned& nloc, unsigned& nx) {
    unsigned sum, cnt, mine, sp = 0u;
    for (;;) {
        sum = 0u; cnt = 0u; mine = 0u;
#pragma unroll
        for (unsigned j = 0; j < 16; ++j) { const unsigned c = xb_ld(&bar[XB_XCNT(j)]); sum += c; cnt += (c > 0u) ? 1u : 0u; mine = (j == x) ? c : mine; }
        if (sum == G) break;
        __builtin_amdgcn_s_sleep(1);
        if ((++sp & 255u) == 0u) { if (xb_ld(&bar[XB_TMO])) break; if (sp > XB_SPIN_CAP) { atomicAdd(&bar[XB_TMO], 1u); break; } }
    }
    nloc = mine > 0u ? mine : 1u; nx = cnt > 0u ? cnt : 1u;
}
__device__ __forceinline__ void xcd_barrier(unsigned* bar, volatile LAS unsigned* st, bool leader, unsigned G) {
    asm volatile("s_waitcnt vmcnt(0)" ::: "memory");
    __syncthreads();
    if (leader) {
        __builtin_amdgcn_s_waitcnt(0);
        const unsigned x = xb_xcc_id();
        unsigned nloc = st[0], nx = st[1];
        if (nloc == 0u) { xcd_barrier_complete(bar, x, G, nloc, nx); st[0] = nloc; st[1] = nx; }
        const unsigned old = xb_add(&bar[XB_XSUB(x)], 1u);
        const unsigned gen = old / nloc;
        if (old + 1u == (gen + 1u) * nloc) {
            __builtin_amdgcn_fence(__ATOMIC_RELEASE, "agent");
            asm volatile("s_waitcnt vmcnt(0)" ::: "memory");
            const unsigned og = xb_add(&bar[XB_TOP], 1u);
            const unsigned tg = og / nx;
            if (og + 1u == (tg + 1u) * nx) xb_add(&bar[XB_TOPGEN], 1u);
            else XB_SPIN(xb_ld(&bar[XB_TOPGEN]) == tg, bar);
            __builtin_amdgcn_fence(__ATOMIC_ACQUIRE, "agent");
            xb_add(&bar[XB_XGEN(x)], 1u);
            asm volatile("s_waitcnt vmcnt(0)" ::: "memory");
        } else {
            XB_SPIN(xb_ld(&bar[XB_XGEN(x)]) == gen, bar);
            __builtin_amdgcn_fence(__ATOMIC_ACQUIRE, "agent");
            asm volatile("s_waitcnt vmcnt(0)" ::: "memory");
        }
    }
    __syncthreads();
}

typedef const __attribute__((address_space(4))) Params* PP;
__device__ __forceinline__ const float* grp_x(PP p, int g) { return g == 0 ? p->x_prompt : p->x_sample; }

__device__ __forceinline__ void run_phase(const Ctx cx, PP p, int ph, LAS unsigned char* lds) {
    unsigned char* ws = p->ws;
    bf16_t* WinT = (bf16_t*)(ws + WS_WIN); bf16_t* WpT = (bf16_t*)(ws + WS_WPOOL); bf16_t* WaT = (bf16_t*)(ws + WS_WA); bf16_t* WbT = (bf16_t*)(ws + WS_WB);
    bf16_t* WoT = (bf16_t*)(ws + WS_WO); bf16_t* WguT = (bf16_t*)(ws + WS_WGU); bf16_t* WdT = (bf16_t*)(ws + WS_WD);
    bf16_t* HF8 = (bf16_t*)(ws + WS_HF8); bf16_t* HF4 = (bf16_t*)(ws + WS_HF4); bf16_t* W3T = (bf16_t*)(ws + WS_W3T); f32x2* FS8 = (f32x2*)(ws + WS_FS8); f32x2* FS4 = (f32x2*)(ws + WS_FS4);
    f32x2* Z1 = (f32x2*)(ws + WS_Z1) + (size_t)cx.bid * 8192;
    bf16_t* H = (bf16_t*)(ws + WS_H); bf16_t* UP = (bf16_t*)(ws + WS_UP); bf16_t* G = (bf16_t*)(ws + WS_G); bf16_t* UH = (bf16_t*)(ws + WS_UH);
    bf16_t* PL = (bf16_t*)(ws + WS_PL); bf16_t* BT = (bf16_t*)(ws + WS_BT); bf16_t* AB = (bf16_t*)(ws + WS_AB); bf16_t* ACT = (bf16_t*)(ws + WS_ACT);
    if (EN(100) && ph == 0) {
        LAS float* tile = (LAS float*)lds;
        for (int job = 0; job < 7; ++job) {
            const float* s; int K, N, mode = 0, ldd = 0, koff = 0; bf16_t* d;
            switch (job) {
                case 0: s = p->w_in; K = 2048; N = 8192; d = WinT; mode = 1; break;
                case 1: s = p->w_a; K = 1024; N = 2048; d = UP; break;
                case 2: s = p->w_b; K = 1024; N = 2048; d = WaT; ldd = 2048; koff = 1024; break;
                case 3: s = p->w_out; K = 2048; N = 2048; d = WoT; break;
                case 4: s = p->w_gate; K = 2048; N = DFF; d = WguT; mode = 2; break;
                case 5: s = p->w_up; K = 2048; N = DFF; d = WguT; mode = 3; break;
                case 6: s = p->w_down; K = DFF; N = 2048; d = WdT; break;
                default: s = p->pool_w + (size_t)(job - 7) * 65536; K = 256; N = 256; d = WpT + (size_t)(job - 7) * 65536; break;
            }
            transpose_cvt(cx, tile, s, K, N, d, mode, ldd ? ldd : K, koff);
        }
        for (int idx = cx.bid * 512 + cx.tid; idx < 262144; idx += cx.nblk * 512)
            WpT[idx] = (bf16_t)(cvt_pk_bf16(p->pool_w[idx] * p->pool_scale[((idx >> 16) << 8) + (idx & 255)], 0.f) & 0xffffu);
        for (int idx = cx.bid * 512 + cx.tid; idx < 262144; idx += cx.nblk * 512)
            W3T[idx] = (bf16_t)(cvt_pk_bf16(p->filt_w3[(size_t)(idx & 63) * 4096 + ((idx >> 6) & 3) * 1024 + (idx >> 8)], 0.f) & 0xffffu);
        for (int v = 0; v < 2; ++v)
            filter_features(cx, (LAS float*)lds, p->filt_w1, p->filt_b1, p->filt_f1, p->filt_w2, p->filt_b2, p->filt_f2, v ? 4096 : 8192, v ? HF4 : HF8);
        return;
    }
    if (EN(101) && ph == 1) {
        { Gemm gf{UP, WpT, 2048, 1024, 256, 1024, 256, 256, WGM}; EpiRaw ef{WaT, 2048}; gemm_phase(cx, lds, gf, ef); }
        for (int v = 0; v < 2; ++v) filter_spectrum(cx, lds, W3T, p->hyena_bias, v ? 4096 : 8192, v ? 13 : 14, v ? HF4 : HF8, v ? FS4 : FS8);
        rmsnorm_phase<false>(cx, grp_x(p, 0), p->g_mix, H, NTG);
        return;
    }
    const int g = (ph - 2) / 9, k = (ph - 2) % 9;
    const int L = g == 0 ? 8192 : 4096, logN2 = g == 0 ? 14 : 13, nb = g == 0 ? 4 : 8;
    float* outg = p->out + (size_t)g * NTG * DM;
    switch (k) {
        case 0: if (EN(0)) {
            Gemm ga{H, WinT, NTG, 5120, 2048, 2048, 2048, 0, WGM}; EpiUPG ea{UP, G}; gemm_phase(cx, lds, ga, ea);
            Gemm gb{WinT + (size_t)5120 * 2048, H, 3072, NTG, 2048, 2048, 2048, 0, 6}; EpiRaw eb{UH, NTG}; gemm_phase(cx, lds, gb, eb);
        } break;
        case 1: if (EN(1)) {
            hyena_phase(cx, lds, p->conv_w, p->conv_b, p->hyena_bias, L, logN2, nb, g == 0 ? FS8 : FS4, UH, BT, Z1);
        } break;
        case 2: if (EN(2)) {
            pool_phase(cx, UP, AB, L);
            bt_transpose(cx, (LAS unsigned short*)lds, BT, AB);
        } break;
        case 3: if (EN(3)) {
            Gemm g1{AB, WaT, NTG, 2048, 2048, 2048, 2048, 0, WGM}; EpiMerge e1{G, H}; gemm_phase<EpiMerge, true>(cx, lds, g1, e1);
        } break;
        case 4: if (EN(4)) {
            Gemm go{H, WoT, NTG, 2048, 2048, 2048, 2048, 0, WGM}; EpiRes eo{grp_x(p, g), outg}; gemm_phase(cx, lds, go, eo);
        } break;
        case 5: if (EN(5)) rmsnorm_phase<false>(cx, outg, p->g_ffn, H, NTG); break;
        case 6: if (EN(6)) {
            Gemm gg{H, WguT, NTG, 11264, 2048, 2048, 2048, 0, 8}; EpiSwiGLU eg{ACT}; gemm_phase(cx, lds, gg, eg);
        } break;
        case 7: if (EN(7)) {
            Gemm gd{ACT, WdT, NTG, 2048, DFF, DFF, DFF, 0, WGM}; EpiRes ed{outg, outg}; gemm_phase(cx, lds, gd, ed);
        } break;
        case 8: if (EN(8)) {
            rmsnorm_phase<true>(cx, outg, p->g_final, outg, NTG);
            if (g + 1 < NGRP) rmsnorm_phase<false>(cx, grp_x(p, g + 1), p->g_mix, H, NTG);
        } break;
    }
}

__global__ __launch_bounds__(512, 2) void mega(Params p, int ph_lo, int ph_hi) {
    extern __shared__ __attribute__((aligned(16))) unsigned char smem_raw[];
    LAS unsigned char* lds = (LAS unsigned char*)smem_raw;
    const int wid_s = __builtin_amdgcn_readfirstlane((int)threadIdx.x >> 6);
    volatile LAS unsigned* bst = (volatile LAS unsigned*)(lds + LDS_X_BYTES + 1024);
    { unsigned* bar0 = (unsigned*)(((PP)__builtin_amdgcn_kernarg_segment_ptr())->ws + WS_BAR);
      if (threadIdx.x == 0) { bst[0] = 0u; bst[1] = 0u; (void)xb_add(&bar0[XB_XCNT(xb_xcc_id())], 1u); }
      __syncthreads(); }
    for (int ph = ph_lo; ph < ph_hi; ++ph) {
        int nrep = 1;
#ifdef PROBE_DUP
        if ((PROBE_DUP >= 100 && ph == PROBE_DUP - 100) || (PROBE_DUP < 100 && ph >= 2 && (ph - 2) % 9 == PROBE_DUP)) nrep = 2;
#endif
        for (int r = 0; r < nrep; ++r) {
            if (r) __syncthreads();
            PP pp = (PP)__builtin_amdgcn_kernarg_segment_ptr(); asm volatile("" : "+s"(pp));
            Ctx cx; cx.bid = blockIdx.x; cx.nblk = gridDim.x;
            { int lane_; asm volatile("v_mbcnt_lo_u32_b32 %0, -1, 0\n\tv_mbcnt_hi_u32_b32 %0, -1, %0" : "=&v"(lane_)); cx.tid = (wid_s << 6) | lane_; }
            asm volatile("" : "+v"(cx.tid)); asm volatile("" : "+s"(cx.bid)); asm volatile("" : "+s"(cx.nblk));
            run_phase(cx, pp, ph, lds);
        }
        if (ph + 1 < ph_hi) {
            if (ph_lo < 0) cg::this_grid().sync();
            { int lane_; asm volatile("v_mbcnt_lo_u32_b32 %0, -1, 0\n\tv_mbcnt_hi_u32_b32 %0, -1, %0" : "=&v"(lane_));
                   unsigned* bar = (unsigned*)(((PP)__builtin_amdgcn_kernarg_segment_ptr())->ws + WS_BAR);
                   xcd_barrier(bar, bst, wid_s == 0 && lane_ == 0, gridDim.x); }
        }
    }
}

extern "C" void kernel_launch(void* const* d_in, const int* in_sizes, int n_in, void* d_out, int out_size, void* d_ws, size_t ws_size, hipStream_t stream) {
    static int grid = 0;
    if (grid == 0) {
        if (n_in != 24 || ws_size < WS_END) { fprintf(stderr, "kernel_launch: unexpected n_in %d or ws_size %zu (< %zu)\n", n_in, ws_size, (size_t)WS_END); grid = -1; return; }
        int dev = 0, cus = 0, per_cu = 0;
        hipGetDevice(&dev); hipDeviceGetAttribute(&cus, hipDeviceAttributeMultiprocessorCount, dev);
        if (hipFuncSetAttribute((const void*)mega, hipFuncAttributeMaxDynamicSharedMemorySize, LDS_BYTES) != hipSuccess) { fprintf(stderr, "kernel_launch: hipFuncSetAttribute failed\n"); grid = -1; return; }
        if (hipOccupancyMaxActiveBlocksPerMultiprocessor(&per_cu, (const void*)mega, 512, LDS_BYTES) != hipSuccess || per_cu < 1) { fprintf(stderr, "kernel_launch: occupancy query says %d\n", per_cu); per_cu = 1; }
        (void)hipGetLastError();
        grid = cus; if (grid > 256) grid = 256; if (grid < 1) grid = 256;
    }
    if (grid < 0) return;
    Params p{};
    const float** pp = (const float**)&p;
    for (int i = 0; i < 24; ++i) pp[i] = (const float*)d_in[i];
    p.out = (float*)d_out; p.ws = (unsigned char*)d_ws;
    if (hipMemsetAsync((char*)d_ws + WS_BAR, 0, 16384, stream) != hipSuccess) { fprintf(stderr, "kernel_launch: memset of barrier words failed\n"); return; }
#if MULTI_LAUNCH
    for (int ph = 0; ph < NPH; ++ph) hipLaunchKernelGGL(mega, dim3(grid), dim3(512), LDS_BYTES, stream, p, ph, ph + 1);
#else
    int lo = 0, hi = NPH; void* args[] = {&p, &lo, &hi};
    hipError_t e = hipLaunchCooperativeKernel((const void*)mega, dim3(grid), dim3(512), args, LDS_BYTES, stream);
    if (e != hipSuccess) fprintf(stderr, "kernel_launch: cooperative launch failed: %s (grid %d)\n", hipGetErrorString(e), grid);
#endif
}
```

```cpp
#include <hip/hip_runtime.h>
#include <hip/hip_cooperative_groups.h>
#include <cstdio>
namespace cg = cooperative_groups;

#ifndef MULTI_LAUNCH
#define MULTI_LAUNCH 0
#endif

#ifndef ONLY
#define ONLY -1
#endif
#define EN(x) (ONLY == -1 || ONLY == (x))
#define LAS __attribute__((address_space(3)))
typedef unsigned short bf16_t;
typedef short bf16x8 __attribute__((ext_vector_type(8)));
typedef float f32x4 __attribute__((ext_vector_type(4)));
typedef float f32x2 __attribute__((ext_vector_type(2)));
typedef unsigned u32x4 __attribute__((ext_vector_type(4)));
typedef unsigned u32x2 __attribute__((ext_vector_type(2)));

constexpr int DM = 2048, DFF = 5632, NTG = 32768, NGRP = 2;
constexpr int BM = 256, BK = 64, HALF = 128, HTB = HALF * BK * 2, NXCD = 8, WGM = 4;
constexpr int XPAD_ELEMS = 16384 + 512 * 5;
constexpr int LDS_X_BYTES = XPAD_ELEMS * 8;
constexpr int LDS_BYTES = LDS_X_BYTES + 2048;
constexpr int NPH = 2 + NGRP * 9;

constexpr size_t WS_WIN = 0;
constexpr size_t WS_WPOOL = WS_WIN + (size_t)8192 * 2048 * 2;
constexpr size_t WS_WA = WS_WPOOL + (size_t)1024 * 256 * 2;
constexpr size_t WS_WB = WS_WA + (size_t)2048 * 1024 * 2;
constexpr size_t WS_WO = WS_WB + (size_t)2048 * 1024 * 2;
constexpr size_t WS_WGU = WS_WO + (size_t)2048 * 2048 * 2;
constexpr size_t WS_WD = WS_WGU + (size_t)11264 * 2048 * 2;
constexpr size_t WS_HF8 = WS_WD + (size_t)2048 * 5632 * 2;
constexpr size_t WS_HF4 = WS_HF8 + (size_t)8192 * 64 * 4;
constexpr size_t WS_FS8 = WS_HF4 + (size_t)4096 * 64 * 4;
constexpr size_t WS_FS4 = WS_FS8 + (size_t)1024 * 16384 * 8;
constexpr size_t WS_Z1 = WS_FS4 + (size_t)1024 * 8192 * 8;
constexpr size_t WS_H = WS_Z1 + (size_t)256 * 65536;
constexpr size_t WS_UP = WS_H + (size_t)NTG * 2048 * 2;
constexpr size_t WS_G = WS_UP + (size_t)NTG * 1024 * 2;
constexpr size_t WS_UH = WS_G + (size_t)NTG * 4096 * 2;
constexpr size_t WS_W3T = WS_UH + (size_t)3072 * NTG * 2;
constexpr size_t WS_BAR = WS_W3T + (size_t)1024 * 256 * 2;
constexpr size_t WS_END = WS_BAR + 16384;
constexpr size_t WS_PL = WS_H;
constexpr size_t WS_BT = WS_H + (size_t)NTG * 1024 * 2;
constexpr size_t WS_AB = WS_UH;
constexpr size_t WS_ACT = WS_G;
static_assert((size_t)NTG * DFF * 2 <= (size_t)NTG * 4096 * 2 + (size_t)3072 * NTG * 2, "ACT must fit in G|UH");

struct Params {
    const float* x_prompt; const float* x_sample; const float* g_mix; const float* w_in; const float* pool_w; const float* pool_scale;
    const float* conv_w; const float* conv_b; const float* filt_w1; const float* filt_b1; const float* filt_f1; const float* filt_w2;
    const float* filt_b2; const float* filt_f2; const float* filt_w3; const float* hyena_bias; const float* w_a; const float* w_b;
    const float* w_out; const float* g_ffn; const float* w_gate; const float* w_up; const float* w_down; const float* g_final;
    float* out; unsigned char* ws;
};

struct Ctx { int tid, bid, nblk; };
__device__ __forceinline__ float bf2f(unsigned short b) { return __uint_as_float(((unsigned)b) << 16); }
__device__ __forceinline__ unsigned cvt_pk_bf16(float lo, float hi) { unsigned r; asm volatile("v_cvt_pk_bf16_f32 %0, %1, %2" : "=v"(r) : "v"(lo), "v"(hi)); return r; }
__device__ __forceinline__ float sigmoidf_(float v) { return __builtin_amdgcn_rcpf(1.0f + __builtin_amdgcn_exp2f(-1.4426950408889634f * v)); }
__device__ __forceinline__ float wave_sum(int tid, float v) {
#pragma unroll
    for (int o = 32; o > 0; o >>= 1) v += __int_as_float(__builtin_amdgcn_ds_bpermute(((tid ^ o) & 63) << 2, __float_as_int(v)));
    return v;
}

__device__ __forceinline__ int lds_byte(int r, int c) { const int st = (r >> 4) * 2 + (c >> 5), rr = r & 15, cc = c & 31, ob = rr * 64 + cc * 2; return st * 1024 + (ob ^ (((ob >> 9) & 1) << 5)); }
__device__ __forceinline__ void stage_rc(int b, int& R, int& C) { const int st = b / 1024, sb = b % 1024, swz = sb ^ (((sb >> 9) & 1) << 5); R = (st >> 1) * 16 + swz / 64; C = (st & 1) * 32 + (swz % 64) / 2; }
__device__ __forceinline__ int perm32(int rho) { const int n = rho >> 4, i = rho & 15; return 8 * (i >> 2) + 4 * n + (i & 3); }

struct Unit { int pm, pn; };
struct Gemm { const bf16_t* A; const bf16_t* Bt; int M, N, K, lda, ldb, a_pn_step, wgm; };

struct StaticOrder {
    int nM, nN, nwg, G, c, wgm;
    __device__ __forceinline__ void init(int M, int N, int G_, int c_, int wgm_) { nM = M / BM; nN = N / BM; nwg = nM * nN; G = G_; c = c_; wgm = wgm_; }
    __device__ __forceinline__ bool next(int i, Unit& u) const {
        const long L = (long)i * G + c; if (L >= nwg) return false;
        int wgid = (int)L; { const int q = nwg / NXCD, r = nwg % NXCD, xcd = wgid % NXCD, off = wgid / NXCD; wgid = (xcd < r ? xcd * (q + 1) : r * (q + 1) + (xcd - r) * q) + off; }
        const int nig = wgm * nN, gid = wgid / nig, fm = gid * wgm, gsz = (nM - fm) < wgm ? (nM - fm) : wgm;
        u.pm = fm + ((wgid % nig) % gsz); u.pn = (wgid % nig) / gsz; return true;
    }
};

template <class Epi, bool MID = false>
__device__ __forceinline__ void gemm_phase(const Ctx cx, LAS unsigned char* lds, const Gemm g, const Epi& E) {
    const int tid = cx.tid, wid = __builtin_amdgcn_readfirstlane(tid >> 6), lane = tid & 63, wr = wid >> 2, wc = wid & 3, fr = lane & 15, fq = lane >> 4;
    const int K = g.K, nt = K / BK;
    StaticOrder S; S.init(g.M, g.N, cx.nblk, cx.bid, g.wgm);
    unsigned voffA[2], voffB[2];
#pragma unroll
    for (int i = 0; i < 2; ++i) { int R, C; stage_rc(tid * 16 + i * 8192, R, C); const int Rb = Epi::PERM ? ((R & ~31) + perm32(R & 31)) : R;
        voffA[i] = (unsigned)(R * g.lda + C) * 2u; voffB[i] = (unsigned)(Rb * g.ldb + C) * 2u; }
    const size_t kstep = (size_t)(BK * 2);
    const size_t hstepA = (size_t)HALF * g.lda * 2, hstepB = (size_t)HALF * g.ldb * 2;
    const size_t tstepA = 2 * hstepA, tstepB = 2 * hstepB;
    const unsigned ldsw = (unsigned)wid * 1024u;
    const int aoff = lds_byte(wr * 64 + fr, fq * 8), boff = lds_byte(wc * 32 + fr, fq * 8);
#define PG8_SA(b, h) (((b) * 2 + (h)) * HTB)
#define PG8_SB(b, h) ((4 + (b) * 2 + (h)) * HTB)
#define PG8_STAGE(bufoff, gbase, voff) do { _Pragma("unroll") for (int _i = 0; _i < 2; ++_i) \
        __builtin_amdgcn_global_load_lds((const unsigned*)((const char*)(gbase) + (voff)[_i]), (LAS unsigned*)(lds + (bufoff) + ldsw + _i * 8192), 16, 0, 0); } while (0)
#define PG8_LDA(dst, b, h) do { _Pragma("unroll") for (int m = 0; m < 4; ++m) _Pragma("unroll") for (int k = 0; k < 2; ++k) dst[m][k] = *(const LAS bf16x8*)(lds + PG8_SA(b, h) + aoff + m * 2048 + k * 1024); } while (0)
#define PG8_LDB(dst, b, h) do { _Pragma("unroll") for (int n = 0; n < 2; ++n) _Pragma("unroll") for (int k = 0; k < 2; ++k) dst[n][k] = *(const LAS bf16x8*)(lds + PG8_SB(b, h) + boff + n * 2048 + k * 1024); } while (0)
#define PG8_MMA(ai, bj, At, Bt) do { __builtin_amdgcn_s_setprio(1); _Pragma("unroll") for (int m = 0; m < 4; ++m) _Pragma("unroll") for (int n = 0; n < 2; ++n) _Pragma("unroll") for (int k = 0; k < 2; ++k) \
        acc[ai][bj][m][n] = __builtin_amdgcn_mfma_f32_16x16x32_bf16(Bt[n][k], At[m][k], acc[ai][bj][m][n], 0, 0, 0); __builtin_amdgcn_s_setprio(0); } while (0)
#define PG8_WAIT_V(n) asm volatile("s_waitcnt vmcnt(" #n ")" ::: "memory")
#define PG8_WAIT_L(n) asm volatile("s_waitcnt lgkmcnt(" #n ")" ::: "memory")
#define PG8_BAR __builtin_amdgcn_s_barrier()
#define PG8_SCHED __builtin_amdgcn_sched_barrier(0)
    Unit cur, nxt; int ui = 0;
    if (!S.next(0, cur)) return;
    f32x4 acc[2][2][4][2];
#pragma unroll
    for (int a = 0; a < 2; ++a)
#pragma unroll
        for (int b = 0; b < 2; ++b)
#pragma unroll
            for (int m = 0; m < 4; ++m)
#pragma unroll
                for (int n = 0; n < 2; ++n) acc[a][b][m][n] = (f32x4){0.f, 0.f, 0.f, 0.f};
    bf16x8 At[4][2], B0[2][2], B1[2][2];
    const char* cA = (const char*)g.A + (size_t)cur.pm * tstepA + (size_t)cur.pn * (size_t)g.a_pn_step * 2; const char* cB = (const char*)g.Bt + (size_t)cur.pn * tstepB;
    PG8_STAGE(PG8_SB(0, 0), cB, voffB); PG8_STAGE(PG8_SA(0, 0), cA, voffA); PG8_STAGE(PG8_SB(0, 1), cB + hstepB, voffB); PG8_STAGE(PG8_SA(0, 1), cA + hstepA, voffA);
    if (wr == 1) PG8_BAR;
    PG8_WAIT_V(4); PG8_BAR;
    PG8_STAGE(PG8_SB(1, 0), cB + kstep, voffB); PG8_STAGE(PG8_SA(1, 0), cA + kstep, voffA); PG8_STAGE(PG8_SB(1, 1), cB + hstepB + kstep, voffB);
    PG8_WAIT_V(6); PG8_BAR;
    for (;;) {
        const bool has_next = S.next(ui + 1, nxt);
        const char* nA = has_next ? (const char*)g.A + (size_t)nxt.pm * tstepA + (size_t)nxt.pn * (size_t)g.a_pn_step * 2 : cA; const char* nB = has_next ? (const char*)g.Bt + (size_t)nxt.pn * tstepB : cB;
        for (int t = 0; t < nt; t += 2) {
            const bool last = (t == nt - 2);
            const char* a1 = cA + (size_t)(t + 1) * kstep;
            const char* a2 = last ? nA : cA + (size_t)(t + 2) * kstep; const char* b2 = last ? nB : cB + (size_t)(t + 2) * kstep;
            const char* a3 = a2 + kstep; const char* b3 = b2 + kstep;
            if constexpr (MID) if (t == (nt >> 1)) { int fr_ = fr, fq_ = fq; asm volatile("" : "+v"(fr_), "+v"(fq_)); E.mid(acc, cur, wr, wc, fr_, fq_); }
            PG8_LDB(B0, 0, 0); PG8_SCHED; PG8_LDA(At, 0, 0); PG8_STAGE(PG8_SA(1, 1), a1 + hstepA, voffA);
            PG8_WAIT_L(8); PG8_BAR; PG8_WAIT_L(0); PG8_MMA(0, 0, At, B0); PG8_BAR; PG8_SCHED;
            PG8_LDB(B1, 0, 1); PG8_STAGE(PG8_SB(0, 0), b2, voffB);
            PG8_BAR; PG8_WAIT_L(0); PG8_MMA(0, 1, At, B1); PG8_BAR;
            PG8_LDA(At, 0, 1); PG8_STAGE(PG8_SA(0, 0), a2, voffA);
            PG8_BAR; PG8_WAIT_L(0); PG8_MMA(1, 0, At, B0); PG8_BAR; PG8_SCHED;
            PG8_STAGE(PG8_SB(0, 1), b2 + hstepB, voffB);
            PG8_WAIT_V(6); PG8_BAR; PG8_MMA(1, 1, At, B1); PG8_BAR;
            PG8_LDB(B0, 1, 0); PG8_SCHED; PG8_LDA(At, 1, 0); PG8_STAGE(PG8_SA(0, 1), a2 + hstepA, voffA);
            PG8_WAIT_L(8); PG8_BAR; PG8_WAIT_L(0); PG8_MMA(0, 0, At, B0); PG8_BAR; PG8_SCHED;
            PG8_LDB(B1, 1, 1); PG8_STAGE(PG8_SB(1, 0), b3, voffB);
            PG8_BAR; PG8_WAIT_L(0); PG8_MMA(0, 1, At, B1); PG8_BAR;
            PG8_LDA(At, 1, 1); PG8_STAGE(PG8_SA(1, 0), a3, voffA);
            PG8_BAR; PG8_WAIT_L(0); PG8_MMA(1, 0, At, B0); PG8_BAR; PG8_SCHED;
            PG8_STAGE(PG8_SB(1, 1), b3 + hstepB, voffB);
            PG8_WAIT_V(6); PG8_BAR; PG8_MMA(1, 1, At, B1); PG8_BAR;
        }
        { int fr_ = fr, fq_ = fq; asm volatile("" : "+v"(fr_), "+v"(fq_));
          E(acc, cur, wr, wc, fr_, fq_); }
        if (!has_next) break;
#pragma unroll
        for (int a = 0; a < 2; ++a)
#pragma unroll
            for (int b = 0; b < 2; ++b)
#pragma unroll
                for (int m = 0; m < 4; ++m)
#pragma unroll
                    for (int n = 0; n < 2; ++n) acc[a][b][m][n] = (f32x4){0.f, 0.f, 0.f, 0.f};
        cur = nxt; cA = nA; cB = nB; ++ui;
    }
    PG8_WAIT_V(0);
    if (wr == 0) PG8_BAR;
    PG8_BAR;
#undef PG8_SA
#undef PG8_SB
#undef PG8_STAGE
#undef PG8_LDA
#undef PG8_LDB
#undef PG8_MMA
#undef PG8_WAIT_V
#undef PG8_WAIT_L
#undef PG8_BAR
#undef PG8_SCHED
}

typedef const f32x4 (&AccRef)[2][2][4][2];
__device__ __forceinline__ u32x4 pack8(f32x4 v0, f32x4 v1) { u32x4 w; w.x = cvt_pk_bf16(v0[0], v0[1]); w.y = cvt_pk_bf16(v0[2], v0[3]); w.z = cvt_pk_bf16(v1[0], v1[1]); w.w = cvt_pk_bf16(v1[2], v1[3]); return w; }
__device__ __forceinline__ void unpack8(u32x4 w, f32x4& v0, f32x4& v1) {
    v0[0] = __uint_as_float(w.x << 16); v0[1] = __uint_as_float(w.x & 0xffff0000u); v0[2] = __uint_as_float(w.y << 16); v0[3] = __uint_as_float(w.y & 0xffff0000u);
    v1[0] = __uint_as_float(w.z << 16); v1[1] = __uint_as_float(w.z & 0xffff0000u); v1[2] = __uint_as_float(w.w << 16); v1[3] = __uint_as_float(w.w & 0xffff0000u);
}

struct EpiUPG {
    static constexpr bool PERM = true; bf16_t* UP; bf16_t* G;
    __device__ __forceinline__ void operator()(AccRef acc, const Unit& u, int wr, int wc, int fr, int fq) const {
        const int row0 = u.pm * BM + wr * 64 + fr; const bool sg = u.pn >= 4;
        bf16_t* base = sg ? G : UP; const int ldc = sg ? 4096 : 1024; const int col0 = (sg ? u.pn * BM - 1024 : u.pn * BM) + wc * 32 + 8 * fq;
#pragma unroll
        for (int ai = 0; ai < 2; ++ai)
#pragma unroll
            for (int m = 0; m < 4; ++m) { bf16_t* rowp = base + (size_t)(row0 + ai * HALF + m * 16) * ldc + col0;
#pragma unroll
                for (int bj = 0; bj < 2; ++bj) { f32x4 v0 = acc[ai][bj][m][0], v1 = acc[ai][bj][m][1];
                    if (sg) {
#pragma unroll
                        for (int j = 0; j < 4; ++j) { v0[j] = sigmoidf_(v0[j]); v1[j] = sigmoidf_(v1[j]); } }
                    *(u32x4*)(rowp + bj * HALF) = pack8(v0, v1); }
                __builtin_amdgcn_sched_barrier(0); }
    }
};
struct EpiRaw {
    static constexpr bool PERM = true; bf16_t* O; int ldc;
    __device__ __forceinline__ void operator()(AccRef acc, const Unit& u, int wr, int wc, int fr, int fq) const {
        const int row0 = u.pm * BM + wr * 64 + fr; const int col0 = u.pn * BM + wc * 32 + 8 * fq;
#pragma unroll
        for (int ai = 0; ai < 2; ++ai)
#pragma unroll
            for (int m = 0; m < 4; ++m) { bf16_t* rowp = O + (size_t)(row0 + ai * HALF + m * 16) * ldc + col0;
#pragma unroll
                for (int bj = 0; bj < 2; ++bj) *(u32x4*)(rowp + bj * HALF) = pack8(acc[ai][bj][m][0], acc[ai][bj][m][1]);
                __builtin_amdgcn_sched_barrier(0); }
    }
};
struct EpiPool {
    static constexpr bool PERM = true; bf16_t* O; const float* scale;
    __device__ __forceinline__ void operator()(AccRef acc, const Unit& u, int wr, int wc, int fr, int fq) const {
        const int row0 = u.pm * BM + wr * 64 + fr; const int col0 = u.pn * BM + wc * 32 + 8 * fq;
        f32x4 s[2][2];
#pragma unroll
        for (int bj = 0; bj < 2; ++bj) { s[bj][0] = *(const f32x4*)(scale + col0 + bj * HALF); s[bj][1] = *(const f32x4*)(scale + col0 + bj * HALF + 4); }
#pragma unroll
        for (int ai = 0; ai < 2; ++ai)
#pragma unroll
            for (int m = 0; m < 4; ++m) { bf16_t* rowp = O + (size_t)(row0 + ai * HALF + m * 16) * 2048 + col0;
#pragma unroll
                for (int bj = 0; bj < 2; ++bj) *(u32x4*)(rowp + bj * HALF) = pack8(acc[ai][bj][m][0] * s[bj][0], acc[ai][bj][m][1] * s[bj][1]);
                __builtin_amdgcn_sched_barrier(0); }
    }
};
template <bool ADD> struct EpiGate {
    static constexpr bool PERM = true; const bf16_t* Gt; const bf16_t* T; bf16_t* O;
    __device__ __forceinline__ void operator()(AccRef acc, const Unit& u, int wr, int wc, int fr, int fq) const {
        const int row0 = u.pm * BM + wr * 64 + fr; const int col0 = u.pn * BM + wc * 32 + 8 * fq;
#pragma unroll
        for (int ai = 0; ai < 2; ++ai) {
            u32x4 gw[4][2], tw[4][2];
#pragma unroll
            for (int m = 0; m < 4; ++m)
#pragma unroll
                for (int bj = 0; bj < 2; ++bj) { const size_t row = (size_t)(row0 + ai * HALF + m * 16);
                    gw[m][bj] = *(const u32x4*)(Gt + row * 4096 + col0 + bj * HALF);
                    if (ADD) tw[m][bj] = *(const u32x4*)(T + row * 2048 + col0 + bj * HALF); }
#pragma unroll
            for (int m = 0; m < 4; ++m)
#pragma unroll
                for (int bj = 0; bj < 2; ++bj) { const size_t row = (size_t)(row0 + ai * HALF + m * 16);
                    f32x4 g0, g1; unpack8(gw[m][bj], g0, g1);
                    f32x4 v0 = acc[ai][bj][m][0] * g0, v1 = acc[ai][bj][m][1] * g1;
                    if (ADD) { f32x4 t0, t1; unpack8(tw[m][bj], t0, t1); v0 += t0; v1 += t1; }
                    *(u32x4*)(O + row * 2048 + col0 + bj * HALF) = pack8(v0, v1); }
            __builtin_amdgcn_sched_barrier(0);
        }
    }
};
struct EpiMerge {
    static constexpr bool PERM = true; const bf16_t* G; bf16_t* O;
    __device__ __forceinline__ void mid(f32x4 (&acc)[2][2][4][2], const Unit& u, int wr, int wc, int fr, int fq) const {
        const int row0 = u.pm * BM + wr * 64 + fr; const int col0 = u.pn * BM + wc * 32 + 8 * fq;
        u32x4 ga[2][2][2], gb[2][2][2];
#define MRG_LOAD(buf, k) do { _Pragma("unroll") for (int mm = 0; mm < 2; ++mm) _Pragma("unroll") for (int bj = 0; bj < 2; ++bj) { \
            const bf16_t* gp = G + (size_t)(row0 + ((k) >> 1) * HALF + (((k) & 1) * 2 + mm) * 16) * 4096 + col0 + bj * HALF; \
            ga[buf][mm][bj] = *(const u32x4*)gp; gb[buf][mm][bj] = *(const u32x4*)(gp + 2048); } } while (0)
        MRG_LOAD(0, 0);
#pragma unroll
        for (int k = 0; k < 4; ++k) {
            if (k < 3) MRG_LOAD((k + 1) & 1, k + 1);
            const int ai = k >> 1, mp = k & 1;
#pragma unroll
            for (int mm = 0; mm < 2; ++mm)
#pragma unroll
                for (int bj = 0; bj < 2; ++bj) { f32x4 a0, a1, b0, b1; unpack8(ga[k & 1][mm][bj], a0, a1); unpack8(gb[k & 1][mm][bj], b0, b1);
#pragma unroll
                    for (int j = 0; j < 4; ++j) { acc[ai][bj][mp * 2 + mm][0][j] *= a0[j] * __builtin_amdgcn_rcpf(b0[j]); acc[ai][bj][mp * 2 + mm][1][j] *= a1[j] * __builtin_amdgcn_rcpf(b1[j]); } }
            __builtin_amdgcn_sched_barrier(0);
        }
#undef MRG_LOAD
    }
    __device__ __forceinline__ void operator()(AccRef acc, const Unit& u, int wr, int wc, int fr, int fq) const {
        const int row0 = u.pm * BM + wr * 64 + fr; const int col0 = u.pn * BM + wc * 32 + 8 * fq;
#pragma unroll
        for (int ai = 0; ai < 2; ++ai) {
            u32x4 gw[4][2];
#pragma unroll
            for (int m = 0; m < 4; ++m)
#pragma unroll
                for (int bj = 0; bj < 2; ++bj) gw[m][bj] = *(const u32x4*)(G + (size_t)(row0 + ai * HALF + m * 16) * 4096 + 2048 + col0 + bj * HALF);
#pragma unroll
            for (int m = 0; m < 4; ++m)
#pragma unroll
                for (int bj = 0; bj < 2; ++bj) { f32x4 g0, g1; unpack8(gw[m][bj], g0, g1);
                    *(u32x4*)(O + (size_t)(row0 + ai * HALF + m * 16) * 2048 + col0 + bj * HALF) = pack8(acc[ai][bj][m][0] * g0, acc[ai][bj][m][1] * g1); }
            __builtin_amdgcn_sched_barrier(0);
        }
    }
};
struct EpiRes {
    static constexpr bool PERM = false; const float* R; float* O;
    __device__ __forceinline__ void operator()(AccRef acc, const Unit& u, int wr, int wc, int fr, int fq) const {
        const int row0 = u.pm * BM + wr * 64 + fr; const int col0 = u.pn * BM + wc * 32 + 4 * fq;
#pragma unroll
        for (int ai = 0; ai < 2; ++ai) {
            f32x4 r[4][2][2];
#pragma unroll
            for (int m = 0; m < 4; ++m)
#pragma unroll
                for (int bj = 0; bj < 2; ++bj)
#pragma unroll
                    for (int n = 0; n < 2; ++n) r[m][bj][n] = *(const f32x4*)(R + (size_t)(row0 + ai * HALF + m * 16) * 2048 + col0 + bj * HALF + n * 16);
#pragma unroll
            for (int m = 0; m < 4; ++m)
#pragma unroll
                for (int bj = 0; bj < 2; ++bj)
#pragma unroll
                    for (int n = 0; n < 2; ++n) *(f32x4*)(O + (size_t)(row0 + ai * HALF + m * 16) * 2048 + col0 + bj * HALF + n * 16) = r[m][bj][n] + acc[ai][bj][m][n];
            __builtin_amdgcn_sched_barrier(0);
        }
    }
};
struct EpiSwiGLU {
    static constexpr bool PERM = true; bf16_t* O;
    __device__ __forceinline__ void operator()(AccRef acc, const Unit& u, int wr, int wc, int fr, int fq) const {
        const int row0 = u.pm * BM + wr * 64 + fr; const int col0 = u.pn * HALF + wc * 32 + 8 * fq;
#pragma unroll
        for (int ai = 0; ai < 2; ++ai)
#pragma unroll
            for (int m = 0; m < 4; ++m) { f32x4 v0, v1;
#pragma unroll
                for (int j = 0; j < 4; ++j) { const float a0 = acc[ai][0][m][0][j], a1 = acc[ai][0][m][1][j];
                    v0[j] = a0 * sigmoidf_(a0) * acc[ai][1][m][0][j]; v1[j] = a1 * sigmoidf_(a1) * acc[ai][1][m][1][j]; }
                *(u32x4*)(O + (size_t)(row0 + ai * HALF + m * 16) * DFF + col0) = pack8(v0, v1);
                __builtin_amdgcn_sched_barrier(0); }
    }
};

__device__ __forceinline__ int rowmap(int mode, int n) {
    switch (mode) {
        case 1: return n < 1024 ? n : (n < 4096 ? n + 4096 : n - 3072);
        case 2: return ((n >> 7) << 8) + (n & 127);
        case 3: return ((n >> 7) << 8) + 128 + (n & 127);
        default: return n;
    }
}
__device__ __forceinline__ void transpose_cvt(const Ctx cx, LAS float* tile, const float* src, int K, int N, bf16_t* dst, int mode, int ldd, int koff) {
    constexpr int TB = 4;
    const int tid = cx.tid; const int tn = N >> 6, ntile = (K >> 6) * tn;
    for (int t4 = cx.bid * TB; t4 < ntile; t4 += cx.nblk * TB) {
        f32x4 v[TB][2];
#pragma unroll
        for (int u = 0; u < TB; ++u) { const int t = t4 + u, k0 = (t / tn) << 6, n0 = (t % tn) << 6;
#pragma unroll
            for (int i = 0; i < 2; ++i) { const int kk = (tid >> 4) + i * 32, nc = (tid & 15) << 2; v[u][i] = *(const f32x4*)(src + (size_t)(k0 + kk) * N + n0 + nc); } }
#pragma unroll
        for (int u = 0; u < TB; ++u)
#pragma unroll
            for (int i = 0; i < 2; ++i) { const int kk = (tid >> 4) + i * 32, nc = (tid & 15) << 2; LAS float* tp = tile + u * (64 * 65) + kk * 65 + nc;
                tp[0] = v[u][i][0]; tp[1] = v[u][i][1]; tp[2] = v[u][i][2]; tp[3] = v[u][i][3]; }
        __syncthreads();
#pragma unroll
        for (int u = 0; u < TB; ++u) { const int t = t4 + u, k0 = (t / tn) << 6, n0 = (t % tn) << 6;
            const int nn = tid >> 3, kc = (tid & 7) << 3; f32x4 a, b; const LAS float* tp = tile + u * (64 * 65);
#pragma unroll
            for (int j = 0; j < 4; ++j) { a[j] = tp[(kc + j) * 65 + nn]; b[j] = tp[(kc + 4 + j) * 65 + nn]; }
            *(u32x4*)(dst + (size_t)rowmap(mode, n0 + nn) * ldd + koff + k0 + kc) = pack8(a, b); }
        __syncthreads();
    }
}

__device__ __forceinline__ void filter_features(const Ctx cx, LAS float* sm, const float* fw1, const float* fb1, const float* ff1, const float* fw2, const float* fb2, const float* ff2, int L, bf16_t* Hfb) {
    const int tid = cx.tid, tt = tid >> 6, j = tid & 63;
    LAS float* zf = sm; LAS float* h1s = sm + 8 * 36;
    const float b1 = fb1[j], f1 = ff1[j], b2 = fb2[j], f2 = ff2[j];
    for (int t0 = cx.bid * 8; t0 < L; t0 += cx.nblk * 8) {
        const int t = t0 + tt;
        if (j < 33) { float z;
            if (j == 0) z = (float)t / (float)(L - 1);
            else { const int k = (j - 1) & 15; const float band = 1e-4f + (float)k * ((15.0f - 1e-4f) / 15.0f);
                double rv = (double)band * (double)t / (double)L; rv -= floor(rv); const float r = (float)rv;
                z = (j <= 16) ? __builtin_amdgcn_cosf(r) : -__builtin_amdgcn_sinf(r); }
            zf[tt * 36 + j] = z; }
        __syncthreads();
        { float a = b1; for (int i = 0; i < 33; ++i) a += zf[tt * 36 + i] * fw1[i * 64 + j];
          h1s[tt * 64 + j] = __builtin_amdgcn_sinf(f1 * a * 0.15915494309189535f); }
        __syncthreads();
        { float a = b2; for (int i = 0; i < 64; ++i) a += h1s[tt * 64 + i] * fw2[i * 64 + j];
          Hfb[(size_t)t * 64 + j] = (bf16_t)(cvt_pk_bf16(__builtin_amdgcn_sinf(f2 * a * 0.15915494309189535f), 0.f) & 0xffffu); }
        __syncthreads();
    }
}

__device__ __forceinline__ int PX(int i) { const int h = i >> 5; return i + h + (h << 2); }
__device__ __forceinline__ f32x2 cmul(f32x2 a, f32x2 b) { return (f32x2){a.x * b.x - a.y * b.y, a.x * b.y + a.y * b.x}; }
__device__ __forceinline__ f32x2 cis_rev(float rev) { return (f32x2){__builtin_amdgcn_cosf(rev), __builtin_amdgcn_sinf(rev)}; }
__device__ __forceinline__ f32x2 rot8(f32x2 v, int k, bool inv) {
    const float c = 0.70710678118654752f;
    if (!inv) { switch (k) { case 1: return (f32x2){c * (v.x + v.y), c * (v.y - v.x)}; case 2: return (f32x2){v.y, -v.x}; case 3: return (f32x2){c * (v.y - v.x), -c * (v.x + v.y)}; default: return v; } }
    else      { switch (k) { case 1: return (f32x2){c * (v.x - v.y), c * (v.x + v.y)}; case 2: return (f32x2){-v.y, v.x}; case 3: return (f32x2){-c * (v.x + v.y), c * (v.x - v.y)}; default: return v; } }
}
template <int LOGR> __device__ __forceinline__ void dif_bfly(f32x2 (&v)[1 << LOGR], int r, int logm) {
    constexpr int R = 1 << LOGR;
    f32x2 W = cis_rev(-(float)r * __uint_as_float((unsigned)(126 - logm) << 23));
#pragma unroll
    for (int s = 0; s < LOGR; ++s) {
        const int half = R >> (s + 1);
#pragma unroll
        for (int q = 0; q < R; ++q) if ((q & half) == 0) {
            const int qq = q & (half - 1);
            const f32x2 a = v[q], b = v[q + half];
            v[q] = a + b;
            v[q + half] = rot8(cmul(a - b, W), (qq << s) * (8 / R), false);
        }
        W = cmul(W, W);
    }
}
template <int LOGR> __device__ __forceinline__ void dit_bfly(f32x2 (&v)[1 << LOGR], int r, int logm0) {
    constexpr int R = 1 << LOGR;
    f32x2 Wt[LOGR];
    Wt[LOGR - 1] = cis_rev((float)r * __uint_as_float((unsigned)(127 - (logm0 + LOGR)) << 23));
#pragma unroll
    for (int s = LOGR - 2; s >= 0; --s) Wt[s] = cmul(Wt[s + 1], Wt[s + 1]);
#pragma unroll
    for (int s = 0; s < LOGR; ++s) {
        const int half = 1 << s;
        const f32x2 W = Wt[s];
#pragma unroll
        for (int q = 0; q < R; ++q) if ((q & half) == 0) {
            const int qq = q & (half - 1);
            const f32x2 a = v[q], b = rot8(cmul(v[q + half], W), qq * (4 >> s), true);
            v[q] = a + b; v[q + half] = a - b;
        }
    }
}
template <int LOGR> __device__ __forceinline__ void dif_pass(const Ctx cx, LAS f32x2* X, int logN, int logm) {
    constexpr int R = 1 << LOGR;
    const int logsub = logm - LOGR + 1, sub = 1 << logsub, ngroups = 1 << (logN - LOGR), psub = PX(sub);
#pragma unroll 2
    for (int g = cx.tid; g < ngroups; g += 512) {
        const int r = g & (sub - 1), blk = g >> logsub, base = (blk << (logm + 1)) + r, pb = PX(base);
        f32x2 v[R];
#pragma unroll
        for (int q = 0; q < R; ++q) v[q] = X[pb + ((sub >= 32) ? q * psub : (q * sub + 5 * ((q * sub) >> 5)))];
        dif_bfly<LOGR>(v, r, logm);
#pragma unroll
        for (int q = 0; q < R; ++q) X[pb + ((sub >= 32) ? q * psub : (q * sub + 5 * ((q * sub) >> 5)))] = v[q];
    }
}
template <int LOGR> __device__ __forceinline__ void dit_pass(const Ctx cx, LAS f32x2* X, int logN, int logm0) {
    constexpr int R = 1 << LOGR;
    const int sub = 1 << logm0, ngroups = 1 << (logN - LOGR), psub = PX(sub);
#pragma unroll 2
    for (int g = cx.tid; g < ngroups; g += 512) {
        const int r = g & (sub - 1), blk = g >> logm0, base = (blk << (logm0 + LOGR)) + r, pb = PX(base);
        f32x2 v[R];
#pragma unroll
        for (int q = 0; q < R; ++q) v[q] = X[pb + ((sub >= 32) ? q * psub : (q * sub + 5 * ((q * sub) >> 5)))];
        dit_bfly<LOGR>(v, r, logm0);
#pragma unroll
        for (int q = 0; q < R; ++q) X[pb + ((sub >= 32) ? q * psub : (q * sub + 5 * ((q * sub) >> 5)))] = v[q];
    }
}
__device__ __forceinline__ void fft_fwd(const Ctx cx, LAS f32x2* X, int logN) {
    int n8 = 0, n4 = 0; for (int rem = logN; rem > 0;) { if (rem > 4 || rem == 3) { ++n8; rem -= 3; } else { ++n4; rem -= 2; } }
    int logm = logN - 1;
    for (int i = 0; i < n8; ++i) { dif_pass<3>(cx, X, logN, logm); logm -= 3; __syncthreads(); }
    for (int i = 0; i < n4; ++i) { dif_pass<2>(cx, X, logN, logm); logm -= 2; __syncthreads(); }
}
__device__ __forceinline__ void fft_inv(const Ctx cx, LAS f32x2* X, int logN) {
    int n8 = 0, n4 = 0; for (int rem = logN; rem > 0;) { if (rem > 4 || rem == 3) { ++n8; rem -= 3; } else { ++n4; rem -= 2; } }
    int lm = 0;
    for (int i = 0; i < n4; ++i) { dit_pass<2>(cx, X, logN, lm); lm += 2; __syncthreads(); }
    for (int i = 0; i < n8; ++i) { dit_pass<3>(cx, X, logN, lm); lm += 3; __syncthreads(); }
}
__device__ __forceinline__ int fft_partner(int pp) { if (pp == 0) return 0; const int j = 31 - __builtin_clz(pp); return (3 << j) - 1 - pp; }

__device__ __forceinline__ void filter_spectrum(const Ctx cx, LAS unsigned char* lds, const bf16_t* W3T, const float* hbias, int L, int logN2, const bf16_t* Hfb, f32x2* FS) {
    const int tid = cx.tid, N2 = 2 * L, wid = tid >> 6, lane = tid & 63, fr = lane & 15, fq = lane >> 4;
    LAS f32x2* X = (LAS f32x2*)lds; LAS float* red = (LAS float*)(lds + LDS_X_BYTES);
    const float min_decay = -3.0701134573253944f, max_decay = -15.350567286626972f;
    const float tscale = 1.0f / (float)(L - 1);
    for (int c = cx.bid; c < 1024; c += cx.nblk) {
        bf16x8 wf0 = (bf16x8){0, 0, 0, 0, 0, 0, 0, 0}, wf1 = wf0;
        if (fr < 4) { wf0 = *(const bf16x8*)(W3T + (size_t)c * 256 + fr * 64 + fq * 8); wf1 = *(const bf16x8*)(W3T + (size_t)c * 256 + fr * 64 + 32 + fq * 8); }
        if (tid == 0) X[PX(L)] = (f32x2){0.f, 0.f};
        const float delta = fabsf(min_decay + (max_decay - min_decay) * ((float)c / 1023.0f));
        float ss0 = 0.f, ss1 = 0.f;
#pragma unroll 8
        for (int tl = wid; tl < (L >> 4); tl += 8) {
            const int n = (tl << 4) + fr;
            const bf16x8 h0 = *(const bf16x8*)(Hfb + (size_t)n * 64 + fq * 8), h1 = *(const bf16x8*)(Hfb + (size_t)n * 64 + 32 + fq * 8);
            f32x4 acc = (f32x4){0.f, 0.f, 0.f, 0.f};
            acc = __builtin_amdgcn_mfma_f32_16x16x32_bf16(wf0, h0, acc, 0, 0, 0);
            acc = __builtin_amdgcn_mfma_f32_16x16x32_bf16(wf1, h1, acc, 0, 0, 0);
            if (fq == 0) {
                const float dec = __expf(-((float)n * tscale) * delta);
                const float f00 = acc[0] * dec, f01 = acc[1] * dec, f10 = acc[2] * dec, f11 = acc[3] * dec;
                if (n == 0) { const f32x2 v = (f32x2){f00 + f01, f10 + f11}; X[PX(0)] = v; ss0 += v.x * v.x; ss1 += v.y * v.y; }
                else { X[PX(n)] = (f32x2){f00, f10}; X[PX(N2 - n)] = (f32x2){f01, f11}; ss0 += f00 * f00 + f01 * f01; ss1 += f10 * f10 + f11 * f11; }
            }
        }
        ss0 = wave_sum(tid, ss0); ss1 = wave_sum(tid, ss1);
        if (lane == 0) { red[wid * 2] = ss0; red[wid * 2 + 1] = ss1; }
        __syncthreads();
        float t0 = 0.f, t1 = 0.f;
#pragma unroll
        for (int w = 0; w < 8; ++w) { t0 += red[w * 2]; t1 += red[w * 2 + 1]; }
        const float sc = 0.5f / (float)N2; const f32x2 rs = (f32x2){rsqrtf(t0 + 1e-6f) * sc, rsqrtf(t1 + 1e-6f) * sc};
        for (int n = tid; n < N2; n += 512) X[PX(n)] *= rs;
        __syncthreads();
        fft_fwd(cx, X, logN2);
        f32x2* dst = FS + (size_t)c * N2;
        const f32x2 dbias = (f32x2){hbias[c] * sc, hbias[1024 + c] * sc};
        for (int n = tid; n < N2; n += 512) dst[n] = X[PX(n)] + dbias;
        __syncthreads();
    }
}

__device__ __forceinline__ float sconv(const bf16_t* row, int n, int L, float w0, float w1, float w2, float b) {
    const float um = n > 0 ? bf2f(row[n - 1]) : 0.f, u0 = bf2f(row[n]), up = (n + 1 < L) ? bf2f(row[n + 1]) : 0.f;
    return um * w0 + u0 * w1 + up * w2 + b;
}
template <int GW> __device__ __forceinline__ void convN(const bf16_t* row, int n0, int L, float w0, float w1, float w2, float b, float (&o)[GW]) {
    float u[GW + 2];
    u[0] = n0 > 0 ? bf2f(row[n0 - 1]) : 0.f;
    u[GW + 1] = (n0 + GW < L) ? bf2f(row[n0 + GW]) : 0.f;
    if (GW == 4) { const u32x2 w = *(const u32x2*)(row + n0); u[1] = __uint_as_float(w.x << 16); u[2] = __uint_as_float(w.x & 0xffff0000u); u[3] = __uint_as_float(w.y << 16); u[GW] = __uint_as_float(w.y & 0xffff0000u); }
    else { const unsigned w = *(const unsigned*)(row + n0); u[1] = __uint_as_float(w << 16); u[2] = __uint_as_float(w & 0xffff0000u); }
#pragma unroll
    for (int i = 0; i < GW; ++i) o[i] = u[i] * w0 + u[i + 1] * w1 + u[i + 2] * w2 + b;
}
template <int GW> __device__ __forceinline__ void hyena_p1(int tid, LAS f32x2* X, int logN2, int L, int order, const bf16_t* rowA, const bf16_t* rowB, float w0, float w1, float w2, float wb, f32x2* Z1) {
    const int lsub = logN2 - 3, sub = 1 << lsub;
    for (int t = tid; t < (sub / GW); t += 512) {
        const int r0 = t * GW, pb0 = PX(r0), psub = PX(sub);
        f32x2 v[GW][8];
#pragma unroll
        for (int q = 0; q < 4; ++q) { const int n0 = r0 + q * sub;
            if (order == 0) { float a[GW], b[GW]; convN<GW>(rowA, n0, L, w0, w1, w2, wb, a); convN<GW>(rowB, n0, L, w0, w1, w2, wb, b);
#pragma unroll
                for (int i = 0; i < GW; ++i) v[i][q] = (f32x2){a[i], b[i]};
 }
            else {
#pragma unroll
                for (int i = 0; i < GW / 2; ++i) { const f32x4 z = ((const f32x4*)(Z1 + n0))[i]; v[2 * i][q] = (f32x2){z[0], z[1]}; v[2 * i + 1][q] = (f32x2){z[2], z[3]}; } } }
#pragma unroll
        for (int i = 0; i < GW; ++i) {
#pragma unroll
            for (int q = 4; q < 8; ++q) v[i][q] = (f32x2){0.f, 0.f};
            dif_bfly<3>(v[i], r0 + i, logN2 - 1); }
#pragma unroll
        for (int q = 0; q < 8; ++q)
#pragma unroll
            for (int i = 0; i < GW; ++i) X[pb0 + i + q * psub] = v[i][q];
    }
}
template <int GW> __device__ __forceinline__ void hyena_p9(int tid, LAS f32x2* X, int logN2, int L, int order, const bf16_t* rowA, const bf16_t* rowB, float w0, float w1, float w2, float wb, float hb, f32x2* Z1, bf16_t* outA, bf16_t* outB) {
    const int lsub = logN2 - 3, sub = 1 << lsub;
    for (int t = tid; t < (sub / GW); t += 512) {
        const int r0 = t * GW, pb0 = PX(r0), psub = PX(sub);
        f32x2 v[GW][8];
#pragma unroll
        for (int q = 0; q < 8; ++q)
#pragma unroll
            for (int i = 0; i < GW; ++i) v[i][q] = X[pb0 + i + q * psub];
#pragma unroll
        for (int i = 0; i < GW; ++i) dit_bfly<3>(v[i], r0 + i, lsub);
#pragma unroll
        for (int q = 0; q < 4; ++q) { const int n0 = r0 + q * sub;
            float xa[GW], xb[GW]; convN<GW>(rowA, n0, L, w0, w1, w2, wb, xa); convN<GW>(rowB, n0, L, w0, w1, w2, wb, xb);
            f32x2 zo[GW];
#pragma unroll
            for (int i = 0; i < GW; ++i) zo[i] = (f32x2){xa[i] * v[i][q].x, xb[i] * v[i][q].y};
            if (order == 0) {
#pragma unroll
                for (int i = 0; i < GW; ++i) v[i][q] = zo[i]; }
            else if (GW == 4) { u32x2 wa, wb2; wa.x = cvt_pk_bf16(zo[0].x, zo[1].x); wa.y = cvt_pk_bf16(zo[2].x, zo[GW - 1].x); wb2.x = cvt_pk_bf16(zo[0].y, zo[1].y); wb2.y = cvt_pk_bf16(zo[2].y, zo[GW - 1].y);
                *(u32x2*)(outA + n0) = wa; *(u32x2*)(outB + n0) = wb2; }
            else { *(unsigned*)(outA + n0) = cvt_pk_bf16(zo[0].x, zo[1].x); *(unsigned*)(outB + n0) = cvt_pk_bf16(zo[0].y, zo[1].y); }
        }
        if (order == 0) {
#pragma unroll
            for (int i = 0; i < GW; ++i) {
#pragma unroll
                for (int q = 4; q < 8; ++q) v[i][q] = (f32x2){0.f, 0.f};
                dif_bfly<3>(v[i], r0 + i, logN2 - 1); }
#pragma unroll
            for (int q = 0; q < 8; ++q)
#pragma unroll
                for (int i = 0; i < GW; ++i) X[pb0 + i + q * psub] = v[i][q];
        }
    }
}
__device__ __forceinline__ void hyena_phase(const Ctx cx, LAS unsigned char* lds, const float* conv_w, const float* conv_b, const float* hbias, int L, int logN2, int nbatch, const f32x2* FS, const bf16_t* UH, bf16_t* BT, f32x2* Z1) {
    const int tid = cx.tid, N2 = 2 * L;
    LAS f32x2* X = (LAS f32x2*)lds;
    int n8 = 0, n4 = 0; for (int rem = logN2; rem > 0;) { if (rem > 4 || rem == 3) { ++n8; rem -= 3; } else { ++n4; rem -= 2; } }
    const int lsub = logN2 - 3, sub = 1 << lsub;
    for (int c = cx.bid; c < 1024; c += cx.nblk) {
        const f32x2* FSc = FS + (size_t)c * N2;
        const float v0 = conv_w[c], v1 = conv_w[3072 + c], v2 = conv_w[6144 + c], v3 = conv_b[c];
        const float bias0 = hbias[c], bias1 = hbias[1024 + c];
        const bf16_t* uv = UH + (size_t)c * NTG;
        for (int pair = 0; pair < nbatch / 2; ++pair) {
            const int tA = (2 * pair) * L, tB = tA + L;
            for (int order = 0; order < 2; ++order) {
                const int gch = (order + 1) * 1024 + c;
                const bf16_t* ug = UH + (size_t)gch * NTG;
                const float g0 = conv_w[gch], g1 = conv_w[3072 + gch], g2 = conv_w[6144 + gch], g3 = conv_b[gch];
                const float hb = order ? bias1 : bias0;
                if (order == 0) {
                    if (logN2 == 14) hyena_p1<4>(tid, X, logN2, L, 0, uv + tA, uv + tB, v0, v1, v2, v3, Z1);
                    else             hyena_p1<2>(tid, X, logN2, L, 0, uv + tA, uv + tB, v0, v1, v2, v3, Z1);
                    __syncthreads(); }
                { int logm = logN2 - 4;
                  for (int i = 1; i < n8; ++i) { dif_pass<3>(cx, X, logN2, logm); logm -= 3; __syncthreads(); }
                  for (int i = 0; i < n4 - 1; ++i) { dif_pass<2>(cx, X, logN2, logm); logm -= 2; __syncthreads(); } }
#pragma unroll 2
                for (int g = tid; g < (N2 >> 2); g += 512) {
                    const int base = g << 2, pbase = PX(base);
                    f32x2 v[4];
#pragma unroll
                    for (int q = 0; q < 4; ++q) v[q] = X[pbase + q];
                    const int pb = base ? ((3 << (31 - __builtin_clz(base))) - 4 - base) : 0;
                    const f32x4 a01 = *(const f32x4*)(FSc + base), a23 = *(const f32x4*)(FSc + base + 2);
                    const f32x4 b01 = *(const f32x4*)(FSc + pb), b23 = *(const f32x4*)(FSc + pb + 2);
                    { f32x2 a = v[0], b = v[2]; v[0] = a + b; v[2] = a - b; a = v[1]; b = v[3]; v[1] = a + b; v[3] = rot8(a - b, 2, false);
                      a = v[0]; b = v[1]; v[0] = a + b; v[1] = a - b; a = v[2]; b = v[3]; v[2] = a + b; v[3] = a - b; }
                    f32x2 A[4], Bn[4];
                    A[0] = (f32x2){a01[0], a01[1]}; A[1] = (f32x2){a01[2], a01[3]}; A[2] = (f32x2){a23[0], a23[1]}; A[3] = (f32x2){a23[2], a23[3]};
                    if (base) { Bn[0] = (f32x2){b23[2], b23[3]}; Bn[1] = (f32x2){b23[0], b23[1]}; Bn[2] = (f32x2){b01[2], b01[3]}; Bn[3] = (f32x2){b01[0], b01[1]}; }
                    else      { Bn[0] = (f32x2){b01[0], b01[1]}; Bn[1] = (f32x2){b01[2], b01[3]}; Bn[2] = (f32x2){b23[2], b23[3]}; Bn[3] = (f32x2){b23[0], b23[1]}; }
#pragma unroll
                    for (int q = 0; q < 4; ++q) { const f32x2 Hq = order ? (f32x2){A[q].y + Bn[q].y, Bn[q].x - A[q].x} : (f32x2){A[q].x + Bn[q].x, A[q].y - Bn[q].y};
                        v[q] = cmul(v[q], Hq); }
                    { f32x2 a = v[0], b = v[1]; v[0] = a + b; v[1] = a - b; a = v[2]; b = v[3]; v[2] = a + b; v[3] = a - b;
                      a = v[0]; b = v[2]; v[0] = a + b; v[2] = a - b; a = v[1]; b = rot8(v[3], 2, true); v[1] = a + b; v[3] = a - b; }
#pragma unroll
                    for (int q = 0; q < 4; ++q) X[pbase + q] = v[q];
                }
                __syncthreads();
                { int lm = 2;
                  for (int i = 1; i < n4; ++i) { dit_pass<2>(cx, X, logN2, lm); lm += 2; __syncthreads(); }
                  for (int i = 0; i < n8 - 1; ++i) { dit_pass<3>(cx, X, logN2, lm); lm += 3; __syncthreads(); } }
                if (logN2 == 14) hyena_p9<4>(tid, X, logN2, L, order, ug + tA, ug + tB, g0, g1, g2, g3, hb, Z1, BT + (size_t)c * NTG + tA, BT + (size_t)c * NTG + tB);
                else             hyena_p9<2>(tid, X, logN2, L, order, ug + tA, ug + tB, g0, g1, g2, g3, hb, Z1, BT + (size_t)c * NTG + tA, BT + (size_t)c * NTG + tB);
                __syncthreads();
            }
        }
    }
}

template <int HW> __device__ __forceinline__ void pool_item(const bf16_t* UP, bf16_t* PL, int L, int tok, int ch0) {
    const int t = tok & (L - 1);
    const bf16_t* basep = UP + (size_t)(tok - t) * 1024 + ch0;
    u32x4 w[2 * HW];
#pragma unroll
    for (int i = 0; i < 2 * HW; ++i) { const int s = t - HW + i; const int sc = s < 0 ? 0 : (s >= L ? L - 1 : s); w[i] = *(const u32x4*)(basep + (size_t)sc * 1024); }
    f32x4 s0 = (f32x4){0.f, 0.f, 0.f, 0.f}, s1 = s0;
#pragma unroll
    for (int i = 0; i < 2 * HW; ++i) { const int s = t - HW + i; f32x4 a, b; unpack8(w[i], a, b); const float m = (s >= 0 && s < L) ? 1.0f : 0.0f; s0 += a * m; s1 += b * m; }
    f32x4 a, b; unpack8(w[HW], a, b);
    const int lo = (t - HW) < 0 ? 0 : (t - HW), hi = (t + HW) > L ? L : (t + HW);
    const float inv = 1.0f / (float)(hi - lo);
    *(u32x4*)(PL + (size_t)tok * 2048 + ch0) = pack8(s0 * inv - a, s1 * inv - b);
}
__device__ __forceinline__ void pool_phase(const Ctx cx, const bf16_t* UP, bf16_t* PL, int L) {
    const int total = NTG * 128;
    for (int idx = cx.bid * 512 + cx.tid; idx < total; idx += cx.nblk * 512) {
        const int grp = idx / (NTG * 32), rem = idx - grp * (NTG * 32), tok = rem >> 5, ch0 = grp * 256 + ((rem & 31) << 3);
        switch (grp) {
            case 0: pool_item<1>(UP, PL, L, tok, ch0); break;
            case 1: pool_item<2>(UP, PL, L, tok, ch0); break;
            case 2: pool_item<4>(UP, PL, L, tok, ch0); break;
            default: pool_item<8>(UP, PL, L, tok, ch0); break;
        }
    }
}

__device__ __forceinline__ void bt_transpose(const Ctx cx, LAS unsigned short* tile, const bf16_t* BT, bf16_t* AB) {
    constexpr int TB = 4;
    const int tid = cx.tid;
    constexpr int NTT = NTG / 64;
    for (int t4 = cx.bid * TB; t4 < 16 * NTT; t4 += cx.nblk * TB) {
        u32x4 w[TB];
#pragma unroll
        for (int u = 0; u < TB; ++u) { const int t = t4 + u, c0 = (t / NTT) << 6, k0 = (t % NTT) << 6; const int r = tid >> 3, cc = (tid & 7) << 3;
            w[u] = *(const u32x4*)(BT + (size_t)(c0 + r) * NTG + k0 + cc); }
#pragma unroll
        for (int u = 0; u < TB; ++u) { const int r = tid >> 3, cc = (tid & 7) << 3; LAS unsigned short* d = tile + u * (64 * 72) + r * 72 + cc;
            d[0] = (unsigned short)(w[u].x & 0xffff); d[1] = (unsigned short)(w[u].x >> 16); d[2] = (unsigned short)(w[u].y & 0xffff); d[3] = (unsigned short)(w[u].y >> 16);
            d[4] = (unsigned short)(w[u].z & 0xffff); d[5] = (unsigned short)(w[u].z >> 16); d[6] = (unsigned short)(w[u].w & 0xffff); d[7] = (unsigned short)(w[u].w >> 16); }
        __syncthreads();
#pragma unroll
        for (int u = 0; u < TB; ++u) { const int t = t4 + u, c0 = (t / NTT) << 6, k0 = (t % NTT) << 6; const int tk = tid >> 3, ch = (tid & 7) << 3; const LAS unsigned short* tp = tile + u * (64 * 72); u32x4 o;
            o.x = (unsigned)tp[(ch + 0) * 72 + tk] | ((unsigned)tp[(ch + 1) * 72 + tk] << 16); o.y = (unsigned)tp[(ch + 2) * 72 + tk] | ((unsigned)tp[(ch + 3) * 72 + tk] << 16);
            o.z = (unsigned)tp[(ch + 4) * 72 + tk] | ((unsigned)tp[(ch + 5) * 72 + tk] << 16); o.w = (unsigned)tp[(ch + 6) * 72 + tk] | ((unsigned)tp[(ch + 7) * 72 + tk] << 16);
            *(u32x4*)(AB + (size_t)(k0 + tk) * 2048 + 1024 + c0 + ch) = o; }
        __syncthreads();
    }
}

template <bool OUTF32> __device__ __forceinline__ void rmsnorm_phase(const Ctx cx, const float* x, const float* g, void* outp, int nrows) {
    constexpr int RB = 4;
    const int wave = cx.tid >> 6, lane = cx.tid & 63;
    const int nw = cx.nblk * 8;
    for (int row0 = (cx.bid * 8 + wave) * RB; row0 < nrows; row0 += nw * RB) {
        f32x4 v[RB][8];
#pragma unroll
        for (int rb = 0; rb < RB; ++rb) { const f32x4* xr = (const f32x4*)(x + (size_t)(row0 + rb) * DM);
#pragma unroll
            for (int i = 0; i < 8; ++i) v[rb][i] = __builtin_nontemporal_load(xr + lane + 64 * i); }
        float rs[RB];
#pragma unroll
        for (int rb = 0; rb < RB; ++rb) { float ss = 0.f;
#pragma unroll
            for (int i = 0; i < 8; ++i) ss += v[rb][i][0] * v[rb][i][0] + v[rb][i][1] * v[rb][i][1] + v[rb][i][2] * v[rb][i][2] + v[rb][i][3] * v[rb][i][3];
            ss = wave_sum(cx.tid, ss); rs[rb] = rsqrtf(ss * (1.0f / DM) + 1e-6f); }
#pragma unroll
        for (int i = 0; i < 8; ++i) { const f32x4 gv = ((const f32x4*)g)[lane + 64 * i];
#pragma unroll
            for (int rb = 0; rb < RB; ++rb) { const f32x4 o = v[rb][i] * rs[rb] * gv;
                if (OUTF32) __builtin_nontemporal_store(o, (f32x4*)((float*)outp + (size_t)(row0 + rb) * DM) + lane + 64 * i);
                else { u32x2 w; w.x = cvt_pk_bf16(o[0], o[1]); w.y = cvt_pk_bf16(o[2], o[3]); ((u32x2*)((bf16_t*)outp + (size_t)(row0 + rb) * DM))[lane + 64 * i] = w; } } }
    }
}

#define XB_TMO      128
#define XB_XCNT(j)  (256  + 64 * (j))
#define XB_XSUB(j)  (1280 + 64 * (j))
#define XB_XGEN(j)  (2304 + 64 * (j))
#define XB_TOP      3328
#define XB_TOPGEN   3392
#define XCD_BAR_WORDS 3456
#define XB_SPIN_CAP (1u << 18)
__device__ __forceinline__ unsigned xb_ld(unsigned* p)              { return __hip_atomic_load(p, __ATOMIC_RELAXED, __HIP_MEMORY_SCOPE_AGENT); }
__device__ __forceinline__ unsigned xb_add(unsigned* p, unsigned v) { return __hip_atomic_fetch_add(p, v, __ATOMIC_RELAXED, __HIP_MEMORY_SCOPE_AGENT); }
__device__ __forceinline__ unsigned xb_xcc_id() { return (unsigned)__builtin_amdgcn_s_getreg((3 << 11) | 20) & 0xFu; }
#define XB_SPIN(cond, bar) do { unsigned _sp = 0; while (cond) { __builtin_amdgcn_s_sleep(1); \
    if ((++_sp & 255u) == 0u) { if (xb_ld(&(bar)[XB_TMO])) break; if (_sp > XB_SPIN_CAP) { atomicAdd(&(bar)[XB_TMO], 1u); break; } } } } while (0)
__device__ __forceinline__ void xcd_barrier_complete(unsigned* bar, unsigned x, unsigned G, unsigned& nloc, unsigned& nx) {
    unsigned sum, cnt, mine, sp = 0u;
    for (;;) {
        sum = 0u; cnt = 0u; mine = 0u;
#pragma unroll
        for (unsigned j = 0; j < 16; ++j) { const unsigned c = xb_ld(&bar[XB_XCNT(j)]); sum += c; cnt += (c > 0u) ? 1u : 0u; mine = (j == x) ? c : mine; }
        if (sum == G) break;
        __builtin_amdgcn_s_sleep(1);
        if ((++sp & 255u) == 0u) { if (xb_ld(&bar[XB_TMO])) break; if (sp > XB_SPIN_CAP) { atomicAdd(&bar[XB_TMO], 1u); break; } }
    }
    nloc = mine > 0u ? mine : 1u; nx = cnt > 0u ? cnt : 1u;
}
__device__ __forceinline__ void xcd_barrier(unsigned* bar, volatile LAS unsigned* st, bool leader, unsigned G) {
    asm volatile("s_waitcnt vmcnt(0)" ::: "memory");
    __syncthreads();
    if (leader) {
        __builtin_amdgcn_s_waitcnt(0);
        const unsigned x = xb_xcc_id();
        unsigned nloc = st[0], nx = st[1];
        if (nloc == 0u) { xcd_barrier_complete(bar, x, G, nloc, nx); st[0] = nloc; st[1] = nx; }
        const unsigned old = xb_add(&bar[XB_XSUB(x)], 1u);
        const unsigned gen = old / nloc;
        if (old + 1u == (gen + 1u) * nloc) {
            __builtin_amdgcn_fence(__ATOMIC_RELEASE, "agent");
            asm volatile("s_waitcnt vmcnt(0)" ::: "memory");
            const unsigned og = xb_add(&bar[XB_TOP], 1u);
            const unsigned tg = og / nx;
            if (og + 1u == (tg + 1u) * nx) xb_add(&bar[XB_TOPGEN], 1u);
            else XB_SPIN(xb_ld(&bar[XB_TOPGEN]) == tg, bar);
            __builtin_amdgcn_fence(__ATOMIC_ACQUIRE, "agent");
            xb_add(&bar[XB_XGEN(x)], 1u);
            asm volatile("s_waitcnt vmcnt(0)" ::: "memory");
        } else {
            XB_SPIN(xb_ld(&bar[XB_XGEN(x)]) == gen, bar);
            __builtin_amdgcn_fence(__ATOMIC_ACQUIRE, "agent");
            asm volatile("s_waitcnt vmcnt(0)" ::: "memory");
        }
    }
    __syncthreads();
}

typedef const __attribute__((address_space(4))) Params* PP;
__device__ __forceinline__ const float* grp_x(PP p, int g) { return g == 0 ? p->x_prompt : p->x_sample; }

__device__ __forceinline__ void run_phase(const Ctx cx, PP p, int ph, LAS unsigned char* lds) {
    unsigned char* ws = p->ws;
    bf16_t* WinT = (bf16_t*)(ws + WS_WIN); bf16_t* WpT = (bf16_t*)(ws + WS_WPOOL); bf16_t* WaT = (bf16_t*)(ws + WS_WA); bf16_t* WbT = (bf16_t*)(ws + WS_WB);
    bf16_t* WoT = (bf16_t*)(ws + WS_WO); bf16_t* WguT = (bf16_t*)(ws + WS_WGU); bf16_t* WdT = (bf16_t*)(ws + WS_WD);
    bf16_t* HF8 = (bf16_t*)(ws + WS_HF8); bf16_t* HF4 = (bf16_t*)(ws + WS_HF4); bf16_t* W3T = (bf16_t*)(ws + WS_W3T); f32x2* FS8 = (f32x2*)(ws + WS_FS8); f32x2* FS4 = (f32x2*)(ws + WS_FS4);
    f32x2* Z1 = (f32x2*)(ws + WS_Z1) + (size_t)cx.bid * 8192;
    bf16_t* H = (bf16_t*)(ws + WS_H); bf16_t* UP = (bf16_t*)(ws + WS_UP); bf16_t* G = (bf16_t*)(ws + WS_G); bf16_t* UH = (bf16_t*)(ws + WS_UH);
    bf16_t* PL = (bf16_t*)(ws + WS_PL); bf16_t* BT = (bf16_t*)(ws + WS_BT); bf16_t* AB = (bf16_t*)(ws + WS_AB); bf16_t* ACT = (bf16_t*)(ws + WS_ACT);
    if (EN(100) && ph == 0) {
        LAS float* tile = (LAS float*)lds;
        for (int job = 0; job < 7; ++job) {
            const float* s; int K, N, mode = 0, ldd = 0, koff = 0; bf16_t* d;
            switch (job) {
                case 0: s = p->w_in; K = 2048; N = 8192; d = WinT; mode = 1; break;
                case 1: s = p->w_a; K = 1024; N = 2048; d = UP; break;
                case 2: s = p->w_b; K = 1024; N = 2048; d = WaT; ldd = 2048; koff = 1024; break;
                case 3: s = p->w_out; K = 2048; N = 2048; d = WoT; break;
                case 4: s = p->w_gate; K = 2048; N = DFF; d = WguT; mode = 2; break;
                case 5: s = p->w_up; K = 2048; N = DFF; d = WguT; mode = 3; break;
                case 6: s = p->w_down; K = DFF; N = 2048; d = WdT; break;
                default: s = p->pool_w + (size_t)(job - 7) * 65536; K = 256; N = 256; d = WpT + (size_t)(job - 7) * 65536; break;
            }
            transpose_cvt(cx, tile, s, K, N, d, mode, ldd ? ldd : K, koff);
        }
        for (int idx = cx.bid * 512 + cx.tid; idx < 262144; idx += cx.nblk * 512)
            WpT[idx] = (bf16_t)(cvt_pk_bf16(p->pool_w[idx] * p->pool_scale[((idx >> 16) << 8) + (idx & 255)], 0.f) & 0xffffu);
        for (int idx = cx.bid * 512 + cx.tid; idx < 262144; idx += cx.nblk * 512)
            W3T[idx] = (bf16_t)(cvt_pk_bf16(p->filt_w3[(size_t)(idx & 63) * 4096 + ((idx >> 6) & 3) * 1024 + (idx >> 8)], 0.f) & 0xffffu);
        for (int v = 0; v < 2; ++v)
            filter_features(cx, (LAS float*)lds, p->filt_w1, p->filt_b1, p->filt_f1, p->filt_w2, p->filt_b2, p->filt_f2, v ? 4096 : 8192, v ? HF4 : HF8);
        return;
    }
    if (EN(101) && ph == 1) {
        { Gemm gf{UP, WpT, 2048, 1024, 256, 1024, 256, 256, WGM}; EpiRaw ef{WaT, 2048}; gemm_phase(cx, lds, gf, ef); }
        for (int v = 0; v < 2; ++v) filter_spectrum(cx, lds, W3T, p->hyena_bias, v ? 4096 : 8192, v ? 13 : 14, v ? HF4 : HF8, v ? FS4 : FS8);
        rmsnorm_phase<false>(cx, grp_x(p, 0), p->g_mix, H, NTG);
        return;
    }
    const int g = (ph - 2) / 9, k = (ph - 2) % 9;
    const int L = g == 0 ? 8192 : 4096, logN2 = g == 0 ? 14 : 13, nb = g == 0 ? 4 : 8;
    float* outg = p->out + (size_t)g * NTG * DM;
    switch (k) {
        case 0: if (EN(0)) {
            Gemm ga{H, WinT, NTG, 5120, 2048, 2048, 2048, 0, WGM}; EpiUPG ea{UP, G}; gemm_phase(cx, lds, ga, ea);
            Gemm gb{WinT + (size_t)5120 * 2048, H, 3072, NTG, 2048, 2048, 2048, 0, 6}; EpiRaw eb{UH, NTG}; gemm_phase(cx, lds, gb, eb);
        } break;
        case 1: if (EN(1)) {
            hyena_phase(cx, lds, p->conv_w, p->conv_b, p->hyena_bias, L, logN2, nb, g == 0 ? FS8 : FS4, UH, BT, Z1);
        } break;
        case 2: if (EN(2)) {
            pool_phase(cx, UP, AB, L);
            bt_transpose(cx, (LAS unsigned short*)lds, BT, AB);
        } break;
        case 3: if (EN(3)) {
            Gemm g1{AB, WaT, NTG, 2048, 2048, 2048, 2048, 0, WGM}; EpiMerge e1{G, H}; gemm_phase<EpiMerge, true>(cx, lds, g1, e1);
        } break;
        case 4: if (EN(4)) {
            Gemm go{H, WoT, NTG, 2048, 2048, 2048, 2048, 0, WGM}; EpiRes eo{grp_x(p, g), outg}; gemm_phase(cx, lds, go, eo);
        } break;
        case 5: if (EN(5)) rmsnorm_phase<false>(cx, outg, p->g_ffn, H, NTG); break;
        case 6: if (EN(6)) {
            Gemm gg{H, WguT, NTG, 11264, 2048, 2048, 2048, 0, 8}; EpiSwiGLU eg{ACT}; gemm_phase(cx, lds, gg, eg);
        } break;
        case 7: if (EN(7)) {
            Gemm gd{ACT, WdT, NTG, 2048, DFF, DFF, DFF, 0, WGM}; EpiRes ed{outg, outg}; gemm_phase(cx, lds, gd, ed);
        } break;
        case 8: if (EN(8)) {
            rmsnorm_phase<true>(cx, outg, p->g_final, outg, NTG);
            if (g + 1 < NGRP) rmsnorm_phase<false>(cx, grp_x(p, g + 1), p->g_mix, H, NTG);
        } break;
    }
}

__global__ __launch_bounds__(512, 2) void mega(Params p, int ph_lo, int ph_hi) {
    extern __shared__ __attribute__((aligned(16))) unsigned char smem_raw[];
    LAS unsigned char* lds = (LAS unsigned char*)smem_raw;
    const int wid_s = __builtin_amdgcn_readfirstlane((int)threadIdx.x >> 6);
    volatile LAS unsigned* bst = (volatile LAS unsigned*)(lds + LDS_X_BYTES + 1024);
    { unsigned* bar0 = (unsigned*)(((PP)__builtin_amdgcn_kernarg_segment_ptr())->ws + WS_BAR);
      if (threadIdx.x == 0) { bst[0] = 0u; bst[1] = 0u; (void)xb_add(&bar0[XB_XCNT(xb_xcc_id())], 1u); }
      __syncthreads(); }
    for (int ph = ph_lo; ph < ph_hi; ++ph) {
        int nrep = 1;
#ifdef PROBE_DUP
        if ((PROBE_DUP >= 100 && ph == PROBE_DUP - 100) || (PROBE_DUP < 100 && ph >= 2 && (ph - 2) % 9 == PROBE_DUP)) nrep = 2;
#endif
        for (int r = 0; r < nrep; ++r) {
            if (r) __syncthreads();
            PP pp = (PP)__builtin_amdgcn_kernarg_segment_ptr(); asm volatile("" : "+s"(pp));
            Ctx cx; cx.bid = blockIdx.x; cx.nblk = gridDim.x;
            { int lane_; asm volatile("v_mbcnt_lo_u32_b32 %0, -1, 0\n\tv_mbcnt_hi_u32_b32 %0, -1, %0" : "=&v"(lane_)); cx.tid = (wid_s << 6) | lane_; }
            asm volatile("" : "+v"(cx.tid)); asm volatile("" : "+s"(cx.bid)); asm volatile("" : "+s"(cx.nblk));
            run_phase(cx, pp, ph, lds);
        }
        if (ph + 1 < ph_hi) {
            if (ph_lo < 0) cg::this_grid().sync();
            { int lane_; asm volatile("v_mbcnt_lo_u32_b32 %0, -1, 0\n\tv_mbcnt_hi_u32_b32 %0, -1, %0" : "=&v"(lane_));
                   unsigned* bar = (unsigned*)(((PP)__builtin_amdgcn_kernarg_segment_ptr())->ws + WS_BAR);
                   xcd_barrier(bar, bst, wid_s == 0 && lane_ == 0, gridDim.x); }
        }
    }
}

extern "C" void kernel_launch(void* const* d_in, const int* in_sizes, int n_in, void* d_out, int out_size, void* d_ws, size_t ws_size, hipStream_t stream) {
    static int grid = 0;
    if (grid == 0) {
        if (n_in != 24 || ws_size < WS_END) { fprintf(stderr, "kernel_launch: unexpected n_in %d or ws_size %zu (< %zu)\n", n_in, ws_size, (size_t)WS_END); grid = -1; return; }
        int dev = 0, cus = 0, per_cu = 0;
        hipGetDevice(&dev); hipDeviceGetAttribute(&cus, hipDeviceAttributeMultiprocessorCount, dev);
        if (hipFuncSetAttribute((const void*)mega, hipFuncAttributeMaxDynamicSharedMemorySize, LDS_BYTES) != hipSuccess) { fprintf(stderr, "kernel_launch: hipFuncSetAttribute failed\n"); grid = -1; return; }
        if (hipOccupancyMaxActiveBlocksPerMultiprocessor(&per_cu, (const void*)mega, 512, LDS_BYTES) != hipSuccess || per_cu < 1) { fprintf(stderr, "kernel_launch: occupancy query says %d\n", per_cu); per_cu = 1; }
        (void)hipGetLastError();
        grid = cus; if (grid > 256) grid = 256; if (grid < 1) grid = 256;
    }
    if (grid < 0) return;
    Params p{};
    const float** pp = (const float**)&p;
    for (int i = 0; i < 24; ++i) pp[i] = (const float*)d_in[i];
    p.out = (float*)d_out; p.ws = (unsigned char*)d_ws;
    if (hipMemsetAsync((char*)d_ws + WS_BAR, 0, 16384, stream) != hipSuccess) { fprintf(stderr, "kernel_launch: memset of barrier words failed\n"); return; }
#if MULTI_LAUNCH
    for (int ph = 0; ph < NPH; ++ph) hipLaunchKernelGGL(mega, dim3(grid), dim3(512), LDS_BYTES, stream, p, ph, ph + 1);
#else
    int lo = 0, hi = NPH; void* args[] = {&p, &lo, &hi};
    hipError_t e = hipLaunchCooperativeKernel((const void*)mega, dim3(grid), dim3(512), args, LDS_BYTES, stream);
    if (e != hipSuccess) fprintf(stderr, "kernel_launch: cooperative launch failed: %s (grid %d)\n", hipGetErrorString(e), grid);
#endif
}
```

```cpp
#include <hip/hip_runtime.h>
#include <hip/hip_cooperative_groups.h>
#include <cstdio>
namespace cg = cooperative_groups;

#ifndef MULTI_LAUNCH
#define MULTI_LAUNCH 0
#endif

#ifndef ONLY
#define ONLY -1
#endif
#define EN(x) (ONLY == -1 || ONLY == (x))
#define LAS __attribute__((address_space(3)))
typedef unsigned short bf16_t;
typedef short bf16x8 __attribute__((ext_vector_type(8)));
typedef float f32x4 __attribute__((ext_vector_type(4)));
typedef float f32x2 __attribute__((ext_vector_type(2)));
typedef unsigned u32x4 __attribute__((ext_vector_type(4)));
typedef unsigned u32x2 __attribute__((ext_vector_type(2)));

constexpr int DM = 2048, DFF = 5632, NTG = 32768, NGRP = 2;
constexpr int BM = 256, BK = 64, HALF = 128, HTB = HALF * BK * 2, NXCD = 8, WGM = 4;
constexpr int XPAD_ELEMS = 16384 + 512 * 5;
constexpr int LDS_X_BYTES = XPAD_ELEMS * 8;
constexpr int LDS_BYTES = LDS_X_BYTES + 2048;
constexpr int NPH = 2 + NGRP * 9;

constexpr size_t WS_WIN = 0;
constexpr size_t WS_WPOOL = WS_WIN + (size_t)8192 * 2048 * 2;
constexpr size_t WS_WA = WS_WPOOL + (size_t)1024 * 256 * 2;
constexpr size_t WS_WB = WS_WA + (size_t)2048 * 1024 * 2;
constexpr size_t WS_WO = WS_WB + (size_t)2048 * 1024 * 2;
constexpr size_t WS_WGU = WS_WO + (size_t)2048 * 2048 * 2;
constexpr size_t WS_WD = WS_WGU + (size_t)11264 * 2048 * 2;
constexpr size_t WS_HF8 = WS_WD + (size_t)2048 * 5632 * 2;
constexpr size_t WS_HF4 = WS_HF8 + (size_t)8192 * 64 * 4;
constexpr size_t WS_FS8 = WS_HF4 + (size_t)4096 * 64 * 4;
constexpr size_t WS_FS4 = WS_FS8 + (size_t)1024 * 16384 * 8;
constexpr size_t WS_Z1 = WS_FS4 + (size_t)1024 * 8192 * 8;
constexpr size_t WS_H = WS_Z1 + (size_t)256 * 65536;
constexpr size_t WS_UP = WS_H + (size_t)NTG * 2048 * 2;
constexpr size_t WS_G = WS_UP + (size_t)NTG * 1024 * 2;
constexpr size_t WS_UH = WS_G + (size_t)NTG * 4096 * 2;
constexpr size_t WS_W3T = WS_UH + (size_t)3072 * NTG * 2;
constexpr size_t WS_BAR = WS_W3T + (size_t)1024 * 256 * 2;
constexpr size_t WS_END = WS_BAR + 16384;
constexpr size_t WS_PL = WS_H;
constexpr size_t WS_BT = WS_H + (size_t)NTG * 1024 * 2;
constexpr size_t WS_AB = WS_UH;
constexpr size_t WS_ACT = WS_G;
static_assert((size_t)NTG * DFF * 2 <= (size_t)NTG * 4096 * 2 + (size_t)3072 * NTG * 2, "ACT must fit in G|UH");

struct Params {
    const float* x_prompt; const float* x_sample; const float* g_mix; const float* w_in; const float* pool_w; const float* pool_scale;
    const float* conv_w; const float* conv_b; const float* filt_w1; const float* filt_b1; const float* filt_f1; const float* filt_w2;
    const float* filt_b2; const float* filt_f2; const float* filt_w3; const float* hyena_bias; const float* w_a; const float* w_b;
    const float* w_out; const float* g_ffn; const float* w_gate; const float* w_up; const float* w_down; const float* g_final;
    float* out; unsigned char* ws;
};

struct Ctx { int tid, bid, nblk; };
__device__ __forceinline__ float bf2f(unsigned short b) { return __uint_as_float(((unsigned)b) << 16); }
__device__ __forceinline__ unsigned cvt_pk_bf16(float lo, float hi) { unsigned r; asm volatile("v_cvt_pk_bf16_f32 %0, %1, %2" : "=v"(r) : "v"(lo), "v"(hi)); return r; }
__device__ __forceinline__ float sigmoidf_(float v) { return __builtin_amdgcn_rcpf(1.0f + __builtin_amdgcn_exp2f(-1.4426950408889634f * v)); }
__device__ __forceinline__ float wave_sum(int tid, float v) {
#pragma unroll
    for (int o = 32; o > 0; o >>= 1) v += __int_as_float(__builtin_amdgcn_ds_bpermute(((tid ^ o) & 63) << 2, __float_as_int(v)));
    return v;
}

__device__ __forceinline__ int lds_byte(int r, int c) { const int st = (r >> 4) * 2 + (c >> 5), rr = r & 15, cc = c & 31, ob = rr * 64 + cc * 2; return st * 1024 + (ob ^ (((ob >> 9) & 1) << 5)); }
__device__ __forceinline__ void stage_rc(int b, int& R, int& C) { const int st = b / 1024, sb = b % 1024, swz = sb ^ (((sb >> 9) & 1) << 5); R = (st >> 1) * 16 + swz / 64; C = (st & 1) * 32 + (swz % 64) / 2; }
__device__ __forceinline__ int perm32(int rho) { const int n = rho >> 4, i = rho & 15; return 8 * (i >> 2) + 4 * n + (i & 3); }

struct Unit { int pm, pn; };
struct Gemm { const bf16_t* A; const bf16_t* Bt; int M, N, K, lda, ldb, a_pn_step, wgm; };

struct StaticOrder {
    int nM, nN, nwg, G, c, wgm;
    __device__ __forceinline__ void init(int M, int N, int G_, int c_, int wgm_) { nM = M / BM; nN = N / BM; nwg = nM * nN; G = G_; c = c_; wgm = wgm_; }
    __device__ __forceinline__ bool next(int i, Unit& u) const {
        const long L = (long)i * G + c; if (L >= nwg) return false;
        int wgid = (int)L; { const int q = nwg / NXCD, r = nwg % NXCD, xcd = wgid % NXCD, off = wgid / NXCD; wgid = (xcd < r ? xcd * (q + 1) : r * (q + 1) + (xcd - r) * q) + off; }
        const int nig = wgm * nN, gid = wgid / nig, fm = gid * wgm, gsz = (nM - fm) < wgm ? (nM - fm) : wgm;
        u.pm = fm + ((wgid % nig) % gsz); u.pn = (wgid % nig) / gsz; return true;
    }
};

template <class Epi, bool MID = false>
__device__ __forceinline__ void gemm_phase(const Ctx cx, LAS unsigned char* lds, const Gemm g, const Epi& E) {
    const int tid = cx.tid, wid = __builtin_amdgcn_readfirstlane(tid >> 6), lane = tid & 63, wr = wid >> 2, wc = wid & 3, fr = lane & 15, fq = lane >> 4;
    const int K = g.K, nt = K / BK;
    StaticOrder S; S.init(g.M, g.N, cx.nblk, cx.bid, g.wgm);
    unsigned voffA[2], voffB[2];
#pragma unroll
    for (int i = 0; i < 2; ++i) { int R, C; stage_rc(tid * 16 + i * 8192, R, C); const int Rb = Epi::PERM ? ((R & ~31) + perm32(R & 31)) : R;
        voffA[i] = (unsigned)(R * g.lda + C) * 2u; voffB[i] = (unsigned)(Rb * g.ldb + C) * 2u; }
    const size_t kstep = (size_t)(BK * 2);
    const size_t hstepA = (size_t)HALF * g.lda * 2, hstepB = (size_t)HALF * g.ldb * 2;
    const size_t tstepA = 2 * hstepA, tstepB = 2 * hstepB;
    const unsigned ldsw = (unsigned)wid * 1024u;
    const int aoff = lds_byte(wr * 64 + fr, fq * 8), boff = lds_byte(wc * 32 + fr, fq * 8);
#define PG8_SA(b, h) (((b) * 2 + (h)) * HTB)
#define PG8_SB(b, h) ((4 + (b) * 2 + (h)) * HTB)
#define PG8_STAGE(bufoff, gbase, voff) do { _Pragma("unroll") for (int _i = 0; _i < 2; ++_i) \
        __builtin_amdgcn_global_load_lds((const unsigned*)((const char*)(gbase) + (voff)[_i]), (LAS unsigned*)(lds + (bufoff) + ldsw + _i * 8192), 16, 0, 0); } while (0)
#define PG8_LDA(dst, b, h) do { _Pragma("unroll") for (int m = 0; m < 4; ++m) _Pragma("unroll") for (int k = 0; k < 2; ++k) dst[m][k] = *(const LAS bf16x8*)(lds + PG8_SA(b, h) + aoff + m * 2048 + k * 1024); } while (0)
#define PG8_LDB(dst, b, h) do { _Pragma("unroll") for (int n = 0; n < 2; ++n) _Pragma("unroll") for (int k = 0; k < 2; ++k) dst[n][k] = *(const LAS bf16x8*)(lds + PG8_SB(b, h) + boff + n * 2048 + k * 1024); } while (0)
#define PG8_MMA(ai, bj, At, Bt) do { __builtin_amdgcn_s_setprio(1); _Pragma("unroll") for (int m = 0; m < 4; ++m) _Pragma("unroll") for (int n = 0; n < 2; ++n) _Pragma("unroll") for (int k = 0; k < 2; ++k) \
        acc[ai][bj][m][n] = __builtin_amdgcn_mfma_f32_16x16x32_bf16(Bt[n][k], At[m][k], acc[ai][bj][m][n], 0, 0, 0); __builtin_amdgcn_s_setprio(0); } while (0)
#define PG8_WAIT_V(n) asm volatile("s_waitcnt vmcnt(" #n ")" ::: "memory")
#define PG8_WAIT_L(n) asm volatile("s_waitcnt lgkmcnt(" #n ")" ::: "memory")
#define PG8_BAR __builtin_amdgcn_s_barrier()
#define PG8_SCHED __builtin_amdgcn_sched_barrier(0)
    Unit cur, nxt; int ui = 0;
    if (!S.next(0, cur)) return;
    f32x4 acc[2][2][4][2];
#pragma unroll
    for (int a = 0; a < 2; ++a)
#pragma unroll
        for (int b = 0; b < 2; ++b)
#pragma unroll
            for (int m = 0; m < 4; ++m)
#pragma unroll
                for (int n = 0; n < 2; ++n) acc[a][b][m][n] = (f32x4){0.f, 0.f, 0.f, 0.f};
    bf16x8 At[4][2], B0[2][2], B1[2][2];
    const char* cA = (const char*)g.A + (size_t)cur.pm * tstepA + (size_t)cur.pn * (size_t)g.a_pn_step * 2; const char* cB = (const char*)g.Bt + (size_t)cur.pn * tstepB;
    PG8_STAGE(PG8_SB(0, 0), cB, voffB); PG8_STAGE(PG8_SA(0, 0), cA, voffA); PG8_STAGE(PG8_SB(0, 1), cB + hstepB, voffB); PG8_STAGE(PG8_SA(0, 1), cA + hstepA, voffA);
    if (wr == 1) PG8_BAR;
    PG8_WAIT_V(4); PG8_BAR;
    PG8_STAGE(PG8_SB(1, 0), cB + kstep, voffB); PG8_STAGE(PG8_SA(1, 0), cA + kstep, voffA); PG8_STAGE(PG8_SB(1, 1), cB + hstepB + kstep, voffB);
    PG8_WAIT_V(6); PG8_BAR;
    for (;;) {
        const bool has_next = S.next(ui + 1, nxt);
        const char* nA = has_next ? (const char*)g.A + (size_t)nxt.pm * tstepA + (size_t)nxt.pn * (size_t)g.a_pn_step * 2 : cA; const char* nB = has_next ? (const char*)g.Bt + (size_t)nxt.pn * tstepB : cB;
        for (int t = 0; t < nt; t += 2) {
            const bool last = (t == nt - 2);
            const char* a1 = cA + (size_t)(t + 1) * kstep;
            const char* a2 = last ? nA : cA + (size_t)(t + 2) * kstep; const char* b2 = last ? nB : cB + (size_t)(t + 2) * kstep;
            const char* a3 = a2 + kstep; const char* b3 = b2 + kstep;
            if constexpr (MID) if (t == (nt >> 1)) { int fr_ = fr, fq_ = fq; asm volatile("" : "+v"(fr_), "+v"(fq_)); E.mid(acc, cur, wr, wc, fr_, fq_); }
            PG8_LDB(B0, 0, 0); PG8_SCHED; PG8_LDA(At, 0, 0); PG8_STAGE(PG8_SA(1, 1), a1 + hstepA, voffA);
            PG8_WAIT_L(8); PG8_BAR; PG8_WAIT_L(0); PG8_MMA(0, 0, At, B0); PG8_BAR; PG8_SCHED;
            PG8_LDB(B1, 0, 1); PG8_STAGE(PG8_SB(0, 0), b2, voffB);
            PG8_BAR; PG8_WAIT_L(0); PG8_MMA(0, 1, At, B1); PG8_BAR;
            PG8_LDA(At, 0, 1); PG8_STAGE(PG8_SA(0, 0), a2, voffA);
            PG8_BAR; PG8_WAIT_L(0); PG8_MMA(1, 0, At, B0); PG8_BAR; PG8_SCHED;
            PG8_STAGE(PG8_SB(0, 1), b2 + hstepB, voffB);
            PG8_WAIT_V(6); PG8_BAR; PG8_MMA(1, 1, At, B1); PG8_BAR;
            PG8_LDB(B0, 1, 0); PG8_SCHED; PG8_LDA(At, 1, 0); PG8_STAGE(PG8_SA(0, 1), a2 + hstepA, voffA);
            PG8_WAIT_L(8); PG8_BAR; PG8_WAIT_L(0); PG8_MMA(0, 0, At, B0); PG8_BAR; PG8_SCHED;
            PG8_LDB(B1, 1, 1); PG8_STAGE(PG8_SB(1, 0), b3, voffB);
            PG8_BAR; PG8_WAIT_L(0); PG8_MMA(0, 1, At, B1); PG8_BAR;
            PG8_LDA(At, 1, 1); PG8_STAGE(PG8_SA(1, 0), a3, voffA);
            PG8_BAR; PG8_WAIT_L(0); PG8_MMA(1, 0, At, B0); PG8_BAR; PG8_SCHED;
            PG8_STAGE(PG8_SB(1, 1), b3 + hstepB, voffB);
            PG8_WAIT_V(6); PG8_BAR; PG8_MMA(1, 1, At, B1); PG8_BAR;
        }
        { int fr_ = fr, fq_ = fq; asm volatile("" : "+v"(fr_), "+v"(fq_));
          E(acc, cur, wr, wc, fr_, fq_); }
        if (!has_next) break;
#pragma unroll
        for (int a = 0; a < 2; ++a)
#pragma unroll
            for (int b = 0; b < 2; ++b)
#pragma unroll
                for (int m = 0; m < 4; ++m)
#pragma unroll
                    for (int n = 0; n < 2; ++n) acc[a][b][m][n] = (f32x4){0.f, 0.f, 0.f, 0.f};
        cur = nxt; cA = nA; cB = nB; ++ui;
    }
    PG8_WAIT_V(0);
    if (wr == 0) PG8_BAR;
    PG8_BAR;
#undef PG8_SA
#undef PG8_SB
#undef PG8_STAGE
#undef PG8_LDA
#undef PG8_LDB
#undef PG8_MMA
#undef PG8_WAIT_V
#undef PG8_WAIT_L
#undef PG8_BAR
#undef PG8_SCHED
}

typedef const f32x4 (&AccRef)[2][2][4][2];
__device__ __forceinline__ u32x4 pack8(f32x4 v0, f32x4 v1) { u32x4 w; w.x = cvt_pk_bf16(v0[0], v0[1]); w.y = cvt_pk_bf16(v0[2], v0[3]); w.z = cvt_pk_bf16(v1[0], v1[1]); w.w = cvt_pk_bf16(v1[2], v1[3]); return w; }
__device__ __forceinline__ void unpack8(u32x4 w, f32x4& v0, f32x4& v1) {
    v0[0] = __uint_as_float(w.x << 16); v0[1] = __uint_as_float(w.x & 0xffff0000u); v0[2] = __uint_as_float(w.y << 16); v0[3] = __uint_as_float(w.y & 0xffff0000u);
    v1[0] = __uint_as_float(w.z << 16); v1[1] = __uint_as_float(w.z & 0xffff0000u); v1[2] = __uint_as_float(w.w << 16); v1[3] = __uint_as_float(w.w & 0xffff0000u);
}

struct EpiUPG {
    static constexpr bool PERM = true; bf16_t* UP; bf16_t* G;
    __device__ __forceinline__ void operator()(AccRef acc, const Unit& u, int wr, int wc, int fr, int fq) const {
        const int row0 = u.pm * BM + wr * 64 + fr; const bool sg = u.pn >= 4;
        bf16_t* base = sg ? G : UP; const int ldc = sg ? 4096 : 1024; const int col0 = (sg ? u.pn * BM - 1024 : u.pn * BM) + wc * 32 + 8 * fq;
#pragma unroll
        for (int ai = 0; ai < 2; ++ai)
#pragma unroll
            for (int m = 0; m < 4; ++m) { bf16_t* rowp = base + (size_t)(row0 + ai * HALF + m * 16) * ldc + col0;
#pragma unroll
                for (int bj = 0; bj < 2; ++bj) { f32x4 v0 = acc[ai][bj][m][0], v1 = acc[ai][bj][m][1];
                    if (sg) {
#pragma unroll
                        for (int j = 0; j < 4; ++j) { v0[j] = sigmoidf_(v0[j]); v1[j] = sigmoidf_(v1[j]); } }
                    *(u32x4*)(rowp + bj * HALF) = pack8(v0, v1); }
                __builtin_amdgcn_sched_barrier(0); }
    }
};
struct EpiRaw {
    static constexpr bool PERM = true; bf16_t* O; int ldc;
    __device__ __forceinline__ void operator()(AccRef acc, const Unit& u, int wr, int wc, int fr, int fq) const {
        const int row0 = u.pm * BM + wr * 64 + fr; const int col0 = u.pn * BM + wc * 32 + 8 * fq;
#pragma unroll
        for (int ai = 0; ai < 2; ++ai)
#pragma unroll
            for (int m = 0; m < 4; ++m) { bf16_t* rowp = O + (size_t)(row0 + ai * HALF + m * 16) * ldc + col0;
#pragma unroll
                for (int bj = 0; bj < 2; ++bj) *(u32x4*)(rowp + bj * HALF) = pack8(acc[ai][bj][m][0], acc[ai][bj][m][1]);
                __builtin_amdgcn_sched_barrier(0); }
    }
};
struct EpiPool {
    static constexpr bool PERM = true; bf16_t* O; const float* scale;
    __device__ __forceinline__ void operator()(AccRef acc, const Unit& u, int wr, int wc, int fr, int fq) const {
        const int row0 = u.pm * BM + wr * 64 + fr; const int col0 = u.pn * BM + wc * 32 + 8 * fq;
        f32x4 s[2][2];
#pragma unroll
        for (int bj = 0; bj < 2; ++bj) { s[bj][0] = *(const f32x4*)(scale + col0 + bj * HALF); s[bj][1] = *(const f32x4*)(scale + col0 + bj * HALF + 4); }
#pragma unroll
        for (int ai = 0; ai < 2; ++ai)
#pragma unroll
            for (int m = 0; m < 4; ++m) { bf16_t* rowp = O + (size_t)(row0 + ai * HALF + m * 16) * 2048 + col0;
#pragma unroll
                for (int bj = 0; bj < 2; ++bj) *(u32x4*)(rowp + bj * HALF) = pack8(acc[ai][bj][m][0] * s[bj][0], acc[ai][bj][m][1] * s[bj][1]);
                __builtin_amdgcn_sched_barrier(0); }
    }
};
template <bool ADD> struct EpiGate {
    static constexpr bool PERM = true; const bf16_t* Gt; const bf16_t* T; bf16_t* O;
    __device__ __forceinline__ void operator()(AccRef acc, const Unit& u, int wr, int wc, int fr, int fq) const {
        const int row0 = u.pm * BM + wr * 64 + fr; const int col0 = u.pn * BM + wc * 32 + 8 * fq;
#pragma unroll
        for (int ai = 0; ai < 2; ++ai) {
            u32x4 gw[4][2], tw[4][2];
#pragma unroll
            for (int m = 0; m < 4; ++m)
#pragma unroll
                for (int bj = 0; bj < 2; ++bj) { const size_t row = (size_t)(row0 + ai * HALF + m * 16);
                    gw[m][bj] = *(const u32x4*)(Gt + row * 4096 + col0 + bj * HALF);
                    if (ADD) tw[m][bj] = *(const u32x4*)(T + row * 2048 + col0 + bj * HALF); }
#pragma unroll
            for (int m = 0; m < 4; ++m)
#pragma unroll
                for (int bj = 0; bj < 2; ++bj) { const size_t row = (size_t)(row0 + ai * HALF + m * 16);
                    f32x4 g0, g1; unpack8(gw[m][bj], g0, g1);
                    f32x4 v0 = acc[ai][bj][m][0] * g0, v1 = acc[ai][bj][m][1] * g1;
                    if (ADD) { f32x4 t0, t1; unpack8(tw[m][bj], t0, t1); v0 += t0; v1 += t1; }
                    *(u32x4*)(O + row * 2048 + col0 + bj * HALF) = pack8(v0, v1); }
            __builtin_amdgcn_sched_barrier(0);
        }
    }
};
struct EpiMerge {
    static constexpr bool PERM = true; const bf16_t* G; bf16_t* O;
    __device__ __forceinline__ void mid(f32x4 (&acc)[2][2][4][2], const Unit& u, int wr, int wc, int fr, int fq) const {
        const int row0 = u.pm * BM + wr * 64 + fr; const int col0 = u.pn * BM + wc * 32 + 8 * fq;
        u32x4 ga[2][2][2], gb[2][2][2];
#define MRG_LOAD(buf, k) do { _Pragma("unroll") for (int mm = 0; mm < 2; ++mm) _Pragma("unroll") for (int bj = 0; bj < 2; ++bj) { \
            const bf16_t* gp = G + (size_t)(row0 + ((k) >> 1) * HALF + (((k) & 1) * 2 + mm) * 16) * 4096 + col0 + bj * HALF; \
            ga[buf][mm][bj] = *(const u32x4*)gp; gb[buf][mm][bj] = *(const u32x4*)(gp + 2048); } } while (0)
        MRG_LOAD(0, 0);
#pragma unroll
        for (int k = 0; k < 4; ++k) {
            if (k < 3) MRG_LOAD((k + 1) & 1, k + 1);
            const int ai = k >> 1, mp = k & 1;
#pragma unroll
            for (int mm = 0; mm < 2; ++mm)
#pragma unroll
                for (int bj = 0; bj < 2; ++bj) { f32x4 a0, a1, b0, b1; unpack8(ga[k & 1][mm][bj], a0, a1); unpack8(gb[k & 1][mm][bj], b0, b1);
#pragma unroll
                    for (int j = 0; j < 4; ++j) { acc[ai][bj][mp * 2 + mm][0][j] *= a0[j] * __builtin_amdgcn_rcpf(b0[j]); acc[ai][bj][mp * 2 + mm][1][j] *= a1[j] * __builtin_amdgcn_rcpf(b1[j]); } }
            __builtin_amdgcn_sched_barrier(0);
        }
#undef MRG_LOAD
    }
    __device__ __forceinline__ void operator()(AccRef acc, const Unit& u, int wr, int wc, int fr, int fq) const {
        const int row0 = u.pm * BM + wr * 64 + fr; const int col0 = u.pn * BM + wc * 32 + 8 * fq;
#pragma unroll
        for (int ai = 0; ai < 2; ++ai) {
            u32x4 gw[4][2];
#pragma unroll
            for (int m = 0; m < 4; ++m)
#pragma unroll
                for (int bj = 0; bj < 2; ++bj) gw[m][bj] = *(const u32x4*)(G + (size_t)(row0 + ai * HALF + m * 16) * 4096 + 2048 + col0 + bj * HALF);
#pragma unroll
            for (int m = 0; m < 4; ++m)
#pragma unroll
                for (int bj = 0; bj < 2; ++bj) { f32x4 g0, g1; unpack8(gw[m][bj], g0, g1);
                    *(u32x4*)(O + (size_t)(row0 + ai * HALF + m * 16) * 2048 + col0 + bj * HALF) = pack8(acc[ai][bj][m][0] * g0, acc[ai][bj][m][1] * g1); }
            __builtin_amdgcn_sched_barrier(0);
        }
    }
};
struct EpiRes {
    static constexpr bool PERM = false; const float* R; float* O;
    __device__ __forceinline__ void operator()(AccRef acc, const Unit& u, int wr, int wc, int fr, int fq) const {
        const int row0 = u.pm * BM + wr * 64 + fr; const int col0 = u.pn * BM + wc * 32 + 4 * fq;
#pragma unroll
        for (int ai = 0; ai < 2; ++ai) {
            f32x4 r[4][2][2];
#pragma unroll
            for (int m = 0; m < 4; ++m)
#pragma unroll
                for (int bj = 0; bj < 2; ++bj)
#pragma unroll
                    for (int n = 0; n < 2; ++n) r[m][bj][n] = *(const f32x4*)(R + (size_t)(row0 + ai * HALF + m * 16) * 2048 + col0 + bj * HALF + n * 16);
#pragma unroll
            for (int m = 0; m < 4; ++m)
#pragma unroll
                for (int bj = 0; bj < 2; ++bj)
#pragma unroll
                    for (int n = 0; n < 2; ++n) *(f32x4*)(O + (size_t)(row0 + ai * HALF + m * 16) * 2048 + col0 + bj * HALF + n * 16) = r[m][bj][n] + acc[ai][bj][m][n];
            __builtin_amdgcn_sched_barrier(0);
        }
    }
};
struct EpiSwiGLU {
    static constexpr bool PERM = true; bf16_t* O;
    __device__ __forceinline__ void operator()(AccRef acc, const Unit& u, int wr, int wc, int fr, int fq) const {
        const int row0 = u.pm * BM + wr * 64 + fr; const int col0 = u.pn * HALF + wc * 32 + 8 * fq;
#pragma unroll
        for (int ai = 0; ai < 2; ++ai)
#pragma unroll
            for (int m = 0; m < 4; ++m) { f32x4 v0, v1;
#pragma unroll
                for (int j = 0; j < 4; ++j) { const float a0 = acc[ai][0][m][0][j], a1 = acc[ai][0][m][1][j];
                    v0[j] = a0 * sigmoidf_(a0) * acc[ai][1][m][0][j]; v1[j] = a1 * sigmoidf_(a1) * acc[ai][1][m][1][j]; }
                *(u32x4*)(O + (size_t)(row0 + ai * HALF + m * 16) * DFF + col0) = pack8(v0, v1);
                __builtin_amdgcn_sched_barrier(0); }
    }
};

__device__ __forceinline__ int rowmap(int mode, int n) {
    switch (mode) {
        case 1: return n < 1024 ? n : (n < 4096 ? n + 4096 : n - 3072);
        case 2: return ((n >> 7) << 8) + (n & 127);
        case 3: return ((n >> 7) << 8) + 128 + (n & 127);
        default: return n;
    }
}
__device__ __forceinline__ void transpose_cvt(const Ctx cx, LAS float* tile, const float* src, int K, int N, bf16_t* dst, int mode, int ldd, int koff) {
    constexpr int TB = 4;
    const int tid = cx.tid; const int tn = N >> 6, ntile = (K >> 6) * tn;
    for (int t4 = cx.bid * TB; t4 < ntile; t4 += cx.nblk * TB) {
        f32x4 v[TB][2];
#pragma unroll
        for (int u = 0; u < TB; ++u) { const int t = t4 + u, k0 = (t / tn) << 6, n0 = (t % tn) << 6;
#pragma unroll
            for (int i = 0; i < 2; ++i) { const int kk = (tid >> 4) + i * 32, nc = (tid & 15) << 2; v[u][i] = *(const f32x4*)(src + (size_t)(k0 + kk) * N + n0 + nc); } }
#pragma unroll
        for (int u = 0; u < TB; ++u)
#pragma unroll
            for (int i = 0; i < 2; ++i) { const int kk = (tid >> 4) + i * 32, nc = (tid & 15) << 2; LAS float* tp = tile + u * (64 * 65) + kk * 65 + nc;
                tp[0] = v[u][i][0]; tp[1] = v[u][i][1]; tp[2] = v[u][i][2]; tp[3] = v[u][i][3]; }
        __syncthreads();
#pragma unroll
        for (int u = 0; u < TB; ++u) { const int t = t4 + u, k0 = (t / tn) << 6, n0 = (t % tn) << 6;
            const int nn = tid >> 3, kc = (tid & 7) << 3; f32x4 a, b; const LAS float* tp = tile + u * (64 * 65);
#pragma unroll
            for (int j = 0; j < 4; ++j) { a[j] = tp[(kc + j) * 65 + nn]; b[j] = tp[(kc + 4 + j) * 65 + nn]; }
            *(u32x4*)(dst + (size_t)rowmap(mode, n0 + nn) * ldd + koff + k0 + kc) = pack8(a, b); }
        __syncthreads();
    }
}

__device__ __forceinline__ void filter_features(const Ctx cx, LAS float* sm, const float* fw1, const float* fb1, const float* ff1, const float* fw2, const float* fb2, const float* ff2, int L, bf16_t* Hfb) {
    const int tid = cx.tid, tt = tid >> 6, j = tid & 63;
    LAS float* zf = sm; LAS float* h1s = sm + 8 * 36;
    const float b1 = fb1[j], f1 = ff1[j], b2 = fb2[j], f2 = ff2[j];
    for (int t0 = cx.bid * 8; t0 < L; t0 += cx.nblk * 8) {
        const int t = t0 + tt;
        if (j < 33) { float z;
            if (j == 0) z = (float)t / (float)(L - 1);
            else { const int k = (j - 1) & 15; const float band = 1e-4f + (float)k * ((15.0f - 1e-4f) / 15.0f);
                double rv = (double)band * (double)t / (double)L; rv -= floor(rv); const float r = (float)rv;
                z = (j <= 16) ? __builtin_amdgcn_cosf(r) : -__builtin_amdgcn_sinf(r); }
            zf[tt * 36 + j] = z; }
        __syncthreads();
        { float a = b1; for (int i = 0; i < 33; ++i) a += zf[tt * 36 + i] * fw1[i * 64 + j];
          h1s[tt * 64 + j] = __builtin_amdgcn_sinf(f1 * a * 0.15915494309189535f); }
        __syncthreads();
        { float a = b2; for (int i = 0; i < 64; ++i) a += h1s[tt * 64 + i] * fw2[i * 64 + j];
          Hfb[(size_t)t * 64 + j] = (bf16_t)(cvt_pk_bf16(__builtin_amdgcn_sinf(f2 * a * 0.15915494309189535f), 0.f) & 0xffffu); }
        __syncthreads();
    }
}

__device__ __forceinline__ int PX(int i) { const int h = i >> 5; return i + h + (h << 2); }
__device__ __forceinline__ f32x2 cmul(f32x2 a, f32x2 b) { return (f32x2){a.x * b.x - a.y * b.y, a.x * b.y + a.y * b.x}; }
__device__ __forceinline__ f32x2 cis_rev(float rev) { return (f32x2){__builtin_amdgcn_cosf(rev), __builtin_amdgcn_sinf(rev)}; }
__device__ __forceinline__ f32x2 rot8(f32x2 v, int k, bool inv) {
    const float c = 0.70710678118654752f;
    if (!inv) { switch (k) { case 1: return (f32x2){c * (v.x + v.y), c * (v.y - v.x)}; case 2: return (f32x2){v.y, -v.x}; case 3: return (f32x2){c * (v.y - v.x), -c * (v.x + v.y)}; default: return v; } }
    else      { switch (k) { case 1: return (f32x2){c * (v.x - v.y), c * (v.x + v.y)}; case 2: return (f32x2){-v.y, v.x}; case 3: return (f32x2){-c * (v.x + v.y), c * (v.x - v.y)}; default: return v; } }
}
template <int LOGR> __device__ __forceinline__ void dif_bfly(f32x2 (&v)[1 << LOGR], int r, int logm) {
    constexpr int R = 1 << LOGR;
    f32x2 W = cis_rev(-(float)r * __uint_as_float((unsigned)(126 - logm) << 23));
#pragma unroll
    for (int s = 0; s < LOGR; ++s) {
        const int half = R >> (s + 1);
#pragma unroll
        for (int q = 0; q < R; ++q) if ((q & half) == 0) {
            const int qq = q & (half - 1);
            const f32x2 a = v[q], b = v[q + half];
            v[q] = a + b;
            v[q + half] = rot8(cmul(a - b, W), (qq << s) * (8 / R), false);
        }
        W = cmul(W, W);
    }
}
template <int LOGR> __device__ __forceinline__ void dit_bfly(f32x2 (&v)[1 << LOGR], int r, int logm0) {
    constexpr int R = 1 << LOGR;
    f32x2 Wt[LOGR];
    Wt[LOGR - 1] = cis_rev((float)r * __uint_as_float((unsigned)(127 - (logm0 + LOGR)) << 23));
#pragma unroll
    for (int s = LOGR - 2; s >= 0; --s) Wt[s] = cmul(Wt[s + 1], Wt[s + 1]);
#pragma unroll
    for (int s = 0; s < LOGR; ++s) {
        const int half = 1 << s;
        const f32x2 W = Wt[s];
#pragma unroll
        for (int q = 0; q < R; ++q) if ((q & half) == 0) {
            const int qq = q & (half - 1);
            const f32x2 a = v[q], b = rot8(cmul(v[q + half], W), qq * (4 >> s), true);
            v[q] = a + b; v[q + half] = a - b;
        }
    }
}
template <int LOGR> __device__ __forceinline__ void dif_pass(const Ctx cx, LAS f32x2* X, int logN, int logm) {
    constexpr int R = 1 << LOGR;
    const int logsub = logm - LOGR + 1, sub = 1 << logsub, ngroups = 1 << (logN - LOGR), psub = PX(sub);
#pragma unroll 2
    for (int g = cx.tid; g < ngroups; g += 512) {
        const int r = g & (sub - 1), blk = g >> logsub, base = (blk << (logm + 1)) + r, pb = PX(base);
        f32x2 v[R];
#pragma unroll
        for (int q = 0; q < R; ++q) v[q] = X[pb + ((sub >= 32) ? q * psub : (q * sub + 5 * ((q * sub) >> 5)))];
        dif_bfly<LOGR>(v, r, logm);
#pragma unroll
        for (int q = 0; q < R; ++q) X[pb + ((sub >= 32) ? q * psub : (q * sub + 5 * ((q * sub) >> 5)))] = v[q];
    }
}
template <int LOGR> __device__ __forceinline__ void dit_pass(const Ctx cx, LAS f32x2* X, int logN, int logm0) {
    constexpr int R = 1 << LOGR;
    const int sub = 1 << logm0, ngroups = 1 << (logN - LOGR), psub = PX(sub);
#pragma unroll 2
    for (int g = cx.tid; g < ngroups; g += 512) {
        const int r = g & (sub - 1), blk = g >> logm0, base = (blk << (logm0 + LOGR)) + r, pb = PX(base);
        f32x2 v[R];
#pragma unroll
        for (int q = 0; q < R; ++q) v[q] = X[pb + ((sub >= 32) ? q * psub : (q * sub + 5 * ((q * sub) >> 5)))];
        dit_bfly<LOGR>(v, r, logm0);
#pragma unroll
        for (int q = 0; q < R; ++q) X[pb + ((sub >= 32) ? q * psub : (q * sub + 5 * ((q * sub) >> 5)))] = v[q];
    }
}
__device__ __forceinline__ void fft_fwd(const Ctx cx, LAS f32x2* X, int logN) {
    int n8 = 0, n4 = 0; for (int rem = logN; rem > 0;) { if (rem > 4 || rem == 3) { ++n8; rem -= 3; } else { ++n4; rem -= 2; } }
    int logm = logN - 1;
    for (int i = 0; i < n8; ++i) { dif_pass<3>(cx, X, logN, logm); logm -= 3; __syncthreads(); }
    for (int i = 0; i < n4; ++i) { dif_pass<2>(cx, X, logN, logm); logm -= 2; __syncthreads(); }
}
__device__ __forceinline__ void fft_inv(const Ctx cx, LAS f32x2* X, int logN) {
    int n8 = 0, n4 = 0; for (int rem = logN; rem > 0;) { if (rem > 4 || rem == 3) { ++n8; rem -= 3; } else { ++n4; rem -= 2; } }
    int lm = 0;
    for (int i = 0; i < n4; ++i) { dit_pass<2>(cx, X, logN, lm); lm += 2; __syncthreads(); }
    for (int i = 0; i < n8; ++i) { dit_pass<3>(cx, X, logN, lm); lm += 3; __syncthreads(); }
}
__device__ __forceinline__ int fft_partner(int pp) { if (pp == 0) return 0; const int j = 31 - __builtin_clz(pp); return (3 << j) - 1 - pp; }

__device__ __forceinline__ void filter_spectrum(const Ctx cx, LAS unsigned char* lds, const bf16_t* W3T, const float* hbias, int L, int logN2, const bf16_t* Hfb, f32x2* FS) {
    const int tid = cx.tid, N2 = 2 * L, wid = tid >> 6, lane = tid & 63, fr = lane & 15, fq = lane >> 4;
    LAS f32x2* X = (LAS f32x2*)lds; LAS float* red = (LAS float*)(lds + LDS_X_BYTES);
    const float min_decay = -3.0701134573253944f, max_decay = -15.350567286626972f;
    const float tscale = 1.0f / (float)(L - 1);
    for (int c = cx.bid; c < 1024; c += cx.nblk) {
        bf16x8 wf0 = (bf16x8){0, 0, 0, 0, 0, 0, 0, 0}, wf1 = wf0;
        if (fr < 4) { wf0 = *(const bf16x8*)(W3T + (size_t)c * 256 + fr * 64 + fq * 8); wf1 = *(const bf16x8*)(W3T + (size_t)c * 256 + fr * 64 + 32 + fq * 8); }
        if (tid == 0) X[PX(L)] = (f32x2){0.f, 0.f};
        const float delta = fabsf(min_decay + (max_decay - min_decay) * ((float)c / 1023.0f));
        float ss0 = 0.f, ss1 = 0.f;
#pragma unroll 8
        for (int tl = wid; tl < (L >> 4); tl += 8) {
            const int n = (tl << 4) + fr;
            const bf16x8 h0 = *(const bf16x8*)(Hfb + (size_t)n * 64 + fq * 8), h1 = *(const bf16x8*)(Hfb + (size_t)n * 64 + 32 + fq * 8);
            f32x4 acc = (f32x4){0.f, 0.f, 0.f, 0.f};
            acc = __builtin_amdgcn_mfma_f32_16x16x32_bf16(wf0, h0, acc, 0, 0, 0);
            acc = __builtin_amdgcn_mfma_f32_16x16x32_bf16(wf1, h1, acc, 0, 0, 0);
            if (fq == 0) {
                const float dec = __expf(-((float)n * tscale) * delta);
                const float f00 = acc[0] * dec, f01 = acc[1] * dec, f10 = acc[2] * dec, f11 = acc[3] * dec;
                if (n == 0) { const f32x2 v = (f32x2){f00 + f01, f10 + f11}; X[PX(0)] = v; ss0 += v.x * v.x; ss1 += v.y * v.y; }
                else { X[PX(n)] = (f32x2){f00, f10}; X[PX(N2 - n)] = (f32x2){f01, f11}; ss0 += f00 * f00 + f01 * f01; ss1 += f10 * f10 + f11 * f11; }
            }
        }
        ss0 = wave_sum(tid, ss0); ss1 = wave_sum(tid, ss1);
        if (lane == 0) { red[wid * 2] = ss0; red[wid * 2 + 1] = ss1; }
        __syncthreads();
        float t0 = 0.f, t1 = 0.f;
#pragma unroll
        for (int w = 0; w < 8; ++w) { t0 += red[w * 2]; t1 += red[w * 2 + 1]; }
        const float sc = 0.5f / (float)N2; const f32x2 rs = (f32x2){rsqrtf(t0 + 1e-6f) * sc, rsqrtf(t1 + 1e-6f) * sc};
        for (int n = tid; n < N2; n += 512) X[PX(n)] *= rs;
        __syncthreads();
        fft_fwd(cx, X, logN2);
        f32x2* dst = FS + (size_t)c * N2;
        const f32x2 dbias = (f32x2){hbias[c] * sc, hbias[1024 + c] * sc};
        for (int n = tid; n < N2; n += 512) dst[n] = X[PX(n)] + dbias;
        __syncthreads();
    }
}

__device__ __forceinline__ float sconv(const bf16_t* row, int n, int L, float w0, float w1, float w2, float b) {
    const float um = n > 0 ? bf2f(row[n - 1]) : 0.f, u0 = bf2f(row[n]), up = (n + 1 < L) ? bf2f(row[n + 1]) : 0.f;
    return um * w0 + u0 * w1 + up * w2 + b;
}
template <int GW> __device__ __forceinline__ void convN(const bf16_t* row, int n0, int L, float w0, float w1, float w2, float b, float (&o)[GW]) {
    float u[GW + 2];
    { const int il = n0 > 0 ? n0 - 1 : 0, ir = (n0 + GW < L) ? n0 + GW : n0;
      const float ul = bf2f(row[il]), ur = bf2f(row[ir]); u[0] = n0 > 0 ? ul : 0.f; u[GW + 1] = (n0 + GW < L) ? ur : 0.f; }
    if (GW == 4) { const u32x2 w = *(const u32x2*)(row + n0); u[1] = __uint_as_float(w.x << 16); u[2] = __uint_as_float(w.x & 0xffff0000u); u[3] = __uint_as_float(w.y << 16); u[GW] = __uint_as_float(w.y & 0xffff0000u); }
    else { const unsigned w = *(const unsigned*)(row + n0); u[1] = __uint_as_float(w << 16); u[2] = __uint_as_float(w & 0xffff0000u); }
#pragma unroll
    for (int i = 0; i < GW; ++i) o[i] = u[i] * w0 + u[i + 1] * w1 + u[i + 2] * w2 + b;
}
template <int GW> __device__ __forceinline__ void hyena_p1(int tid, LAS f32x2* X, int logN2, int L, int order, const bf16_t* rowA, const bf16_t* rowB, float w0, float w1, float w2, float wb, f32x2* Z1) {
    const int lsub = logN2 - 3, sub = 1 << lsub;
    for (int t = tid; t < (sub / GW); t += 512) {
        const int r0 = t * GW, pb0 = PX(r0), psub = PX(sub);
        f32x2 v[GW][8];
#pragma unroll
        for (int q = 0; q < 4; ++q) { const int n0 = r0 + q * sub;
            if (order == 0) { float a[GW], b[GW]; convN<GW>(rowA, n0, L, w0, w1, w2, wb, a); convN<GW>(rowB, n0, L, w0, w1, w2, wb, b);
#pragma unroll
                for (int i = 0; i < GW; ++i) v[i][q] = (f32x2){a[i], b[i]};
 }
            else {
#pragma unroll
                for (int i = 0; i < GW / 2; ++i) { const f32x4 z = ((const f32x4*)(Z1 + n0))[i]; v[2 * i][q] = (f32x2){z[0], z[1]}; v[2 * i + 1][q] = (f32x2){z[2], z[3]}; } } }
#pragma unroll
        for (int i = 0; i < GW; ++i) {
#pragma unroll
            for (int q = 4; q < 8; ++q) v[i][q] = (f32x2){0.f, 0.f};
            dif_bfly<3>(v[i], r0 + i, logN2 - 1); }
#pragma unroll
        for (int q = 0; q < 8; ++q)
#pragma unroll
            for (int i = 0; i < GW; ++i) X[pb0 + i + q * psub] = v[i][q];
    }
}
template <int GW> __device__ __forceinline__ void hyena_p9(int tid, LAS f32x2* X, int logN2, int L, int order, const bf16_t* rowA, const bf16_t* rowB, float w0, float w1, float w2, float wb, float hb, f32x2* Z1, bf16_t* outA, bf16_t* outB) {
    const int lsub = logN2 - 3, sub = 1 << lsub;
    for (int t = tid; t < (sub / GW); t += 512) {
        const int r0 = t * GW, pb0 = PX(r0), psub = PX(sub);
        f32x2 v[GW][8];
#pragma unroll
        for (int q = 0; q < 8; ++q)
#pragma unroll
            for (int i = 0; i < GW; ++i) v[i][q] = X[pb0 + i + q * psub];
#pragma unroll
        for (int i = 0; i < GW; ++i) dit_bfly<3>(v[i], r0 + i, lsub);
#pragma unroll
        for (int q = 0; q < 4; ++q) { const int n0 = r0 + q * sub;
            float xa[GW], xb[GW]; convN<GW>(rowA, n0, L, w0, w1, w2, wb, xa); convN<GW>(rowB, n0, L, w0, w1, w2, wb, xb);
            f32x2 zo[GW];
#pragma unroll
            for (int i = 0; i < GW; ++i) zo[i] = (f32x2){xa[i] * v[i][q].x, xb[i] * v[i][q].y};
            if (order == 0) {
#pragma unroll
                for (int i = 0; i < GW; ++i) v[i][q] = zo[i]; }
            else if (GW == 4) { u32x2 wa, wb2; wa.x = cvt_pk_bf16(zo[0].x, zo[1].x); wa.y = cvt_pk_bf16(zo[2].x, zo[GW - 1].x); wb2.x = cvt_pk_bf16(zo[0].y, zo[1].y); wb2.y = cvt_pk_bf16(zo[2].y, zo[GW - 1].y);
                *(u32x2*)(outA + n0) = wa; *(u32x2*)(outB + n0) = wb2; }
            else { *(unsigned*)(outA + n0) = cvt_pk_bf16(zo[0].x, zo[1].x); *(unsigned*)(outB + n0) = cvt_pk_bf16(zo[0].y, zo[1].y); }
        }
        if (order == 0) {
#pragma unroll
            for (int i = 0; i < GW; ++i) {
#pragma unroll
                for (int q = 4; q < 8; ++q) v[i][q] = (f32x2){0.f, 0.f};
                dif_bfly<3>(v[i], r0 + i, logN2 - 1); }
#pragma unroll
            for (int q = 0; q < 8; ++q)
#pragma unroll
                for (int i = 0; i < GW; ++i) X[pb0 + i + q * psub] = v[i][q];
        }
    }
}
__device__ __forceinline__ void hyena_phase(const Ctx cx, LAS unsigned char* lds, const float* conv_w, const float* conv_b, const float* hbias, int L, int logN2, int nbatch, const f32x2* FS, const bf16_t* UH, bf16_t* BT, f32x2* Z1) {
    const int tid = cx.tid, N2 = 2 * L;
    LAS f32x2* X = (LAS f32x2*)lds;
    int n8 = 0, n4 = 0; for (int rem = logN2; rem > 0;) { if (rem > 4 || rem == 3) { ++n8; rem -= 3; } else { ++n4; rem -= 2; } }
    const int lsub = logN2 - 3, sub = 1 << lsub;
    for (int c = cx.bid; c < 1024; c += cx.nblk) {
        const f32x2* FSc = FS + (size_t)c * N2;
        const float v0 = conv_w[c], v1 = conv_w[3072 + c], v2 = conv_w[6144 + c], v3 = conv_b[c];
        const float bias0 = hbias[c], bias1 = hbias[1024 + c];
        const bf16_t* uv = UH + (size_t)c * NTG;
        for (int pair = 0; pair < nbatch / 2; ++pair) {
            const int tA = (2 * pair) * L, tB = tA + L;
            for (int order = 0; order < 2; ++order) {
                const int gch = (order + 1) * 1024 + c;
                const bf16_t* ug = UH + (size_t)gch * NTG;
                const float g0 = conv_w[gch], g1 = conv_w[3072 + gch], g2 = conv_w[6144 + gch], g3 = conv_b[gch];
                const float hb = order ? bias1 : bias0;
                if (order == 0) {
                    if (logN2 == 14) hyena_p1<4>(tid, X, logN2, L, 0, uv + tA, uv + tB, v0, v1, v2, v3, Z1);
                    else             hyena_p1<2>(tid, X, logN2, L, 0, uv + tA, uv + tB, v0, v1, v2, v3, Z1);
                    __syncthreads(); }
                { int logm = logN2 - 4;
                  for (int i = 1; i < n8; ++i) { dif_pass<3>(cx, X, logN2, logm); logm -= 3; __syncthreads(); }
                  for (int i = 0; i < n4 - 1; ++i) { dif_pass<2>(cx, X, logN2, logm); logm -= 2; __syncthreads(); } }
#pragma unroll 2
                for (int g = tid; g < (N2 >> 2); g += 512) {
                    const int base = g << 2, pbase = PX(base);
                    f32x2 v[4];
#pragma unroll
                    for (int q = 0; q < 4; ++q) v[q] = X[pbase + q];
                    const int pb = base ? ((3 << (31 - __builtin_clz(base))) - 4 - base) : 0;
                    const f32x4 a01 = *(const f32x4*)(FSc + base), a23 = *(const f32x4*)(FSc + base + 2);
                    const f32x4 b01 = *(const f32x4*)(FSc + pb), b23 = *(const f32x4*)(FSc + pb + 2);
                    { f32x2 a = v[0], b = v[2]; v[0] = a + b; v[2] = a - b; a = v[1]; b = v[3]; v[1] = a + b; v[3] = rot8(a - b, 2, false);
                      a = v[0]; b = v[1]; v[0] = a + b; v[1] = a - b; a = v[2]; b = v[3]; v[2] = a + b; v[3] = a - b; }
                    f32x2 A[4], Bn[4];
                    A[0] = (f32x2){a01[0], a01[1]}; A[1] = (f32x2){a01[2], a01[3]}; A[2] = (f32x2){a23[0], a23[1]}; A[3] = (f32x2){a23[2], a23[3]};
                    if (base) { Bn[0] = (f32x2){b23[2], b23[3]}; Bn[1] = (f32x2){b23[0], b23[1]}; Bn[2] = (f32x2){b01[2], b01[3]}; Bn[3] = (f32x2){b01[0], b01[1]}; }
                    else      { Bn[0] = (f32x2){b01[0], b01[1]}; Bn[1] = (f32x2){b01[2], b01[3]}; Bn[2] = (f32x2){b23[2], b23[3]}; Bn[3] = (f32x2){b23[0], b23[1]}; }
#pragma unroll
                    for (int q = 0; q < 4; ++q) { const f32x2 Hq = order ? (f32x2){A[q].y + Bn[q].y, Bn[q].x - A[q].x} : (f32x2){A[q].x + Bn[q].x, A[q].y - Bn[q].y};
                        v[q] = cmul(v[q], Hq); }
                    { f32x2 a = v[0], b = v[1]; v[0] = a + b; v[1] = a - b; a = v[2]; b = v[3]; v[2] = a + b; v[3] = a - b;
                      a = v[0]; b = v[2]; v[0] = a + b; v[2] = a - b; a = v[1]; b = rot8(v[3], 2, true); v[1] = a + b; v[3] = a - b; }
#pragma unroll
                    for (int q = 0; q < 4; ++q) X[pbase + q] = v[q];
                }
                __syncthreads();
                { int lm = 2;
                  for (int i = 1; i < n4; ++i) { dit_pass<2>(cx, X, logN2, lm); lm += 2; __syncthreads(); }
                  for (int i = 0; i < n8 - 1; ++i) { dit_pass<3>(cx, X, logN2, lm); lm += 3; __syncthreads(); } }
                if (logN2 == 14) hyena_p9<4>(tid, X, logN2, L, order, ug + tA, ug + tB, g0, g1, g2, g3, hb, Z1, BT + (size_t)c * NTG + tA, BT + (size_t)c * NTG + tB);
                else             hyena_p9<2>(tid, X, logN2, L, order, ug + tA, ug + tB, g0, g1, g2, g3, hb, Z1, BT + (size_t)c * NTG + tA, BT + (size_t)c * NTG + tB);
                __syncthreads();
            }
        }
    }
}

template <int HW> __device__ __forceinline__ void pool_item(const bf16_t* UP, bf16_t* PL, int L, int tok, int ch0) {
    const int t = tok & (L - 1);
    const bf16_t* basep = UP + (size_t)(tok - t) * 1024 + ch0;
    u32x4 w[2 * HW];
#pragma unroll
    for (int i = 0; i < 2 * HW; ++i) { const int s = t - HW + i; const int sc = s < 0 ? 0 : (s >= L ? L - 1 : s); w[i] = *(const u32x4*)(basep + (size_t)sc * 1024); }
    f32x4 s0 = (f32x4){0.f, 0.f, 0.f, 0.f}, s1 = s0;
#pragma unroll
    for (int i = 0; i < 2 * HW; ++i) { const int s = t - HW + i; f32x4 a, b; unpack8(w[i], a, b); const float m = (s >= 0 && s < L) ? 1.0f : 0.0f; s0 += a * m; s1 += b * m; }
    f32x4 a, b; unpack8(w[HW], a, b);
    const int lo = (t - HW) < 0 ? 0 : (t - HW), hi = (t + HW) > L ? L : (t + HW);
    const float inv = 1.0f / (float)(hi - lo);
    *(u32x4*)(PL + (size_t)tok * 2048 + ch0) = pack8(s0 * inv - a, s1 * inv - b);
}
__device__ __forceinline__ void pool_phase(const Ctx cx, const bf16_t* UP, bf16_t* PL, int L) {
    const int total = NTG * 128;
    for (int idx = cx.bid * 512 + cx.tid; idx < total; idx += cx.nblk * 512) {
        const int grp = idx / (NTG * 32), rem = idx - grp * (NTG * 32), tok = rem >> 5, ch0 = grp * 256 + ((rem & 31) << 3);
        switch (grp) {
            case 0: pool_item<1>(UP, PL, L, tok, ch0); break;
            case 1: pool_item<2>(UP, PL, L, tok, ch0); break;
            case 2: pool_item<4>(UP, PL, L, tok, ch0); break;
            default: pool_item<8>(UP, PL, L, tok, ch0); break;
        }
    }
}

__device__ __forceinline__ void bt_transpose(const Ctx cx, LAS unsigned short* tile, const bf16_t* BT, bf16_t* AB) {
    constexpr int TB = 4;
    const int tid = cx.tid;
    constexpr int NTT = NTG / 64;
    for (int t4 = cx.bid * TB; t4 < 16 * NTT; t4 += cx.nblk * TB) {
        u32x4 w[TB];
#pragma unroll
        for (int u = 0; u < TB; ++u) { const int t = t4 + u, c0 = (t / NTT) << 6, k0 = (t % NTT) << 6; const int r = tid >> 3, cc = (tid & 7) << 3;
            w[u] = *(const u32x4*)(BT + (size_t)(c0 + r) * NTG + k0 + cc); }
#pragma unroll
        for (int u = 0; u < TB; ++u) { const int r = tid >> 3, cc = (tid & 7) << 3; LAS unsigned short* d = tile + u * (64 * 72) + r * 72 + cc;
            d[0] = (unsigned short)(w[u].x & 0xffff); d[1] = (unsigned short)(w[u].x >> 16); d[2] = (unsigned short)(w[u].y & 0xffff); d[3] = (unsigned short)(w[u].y >> 16);
            d[4] = (unsigned short)(w[u].z & 0xffff); d[5] = (unsigned short)(w[u].z >> 16); d[6] = (unsigned short)(w[u].w & 0xffff); d[7] = (unsigned short)(w[u].w >> 16); }
        __syncthreads();
#pragma unroll
        for (int u = 0; u < TB; ++u) { const int t = t4 + u, c0 = (t / NTT) << 6, k0 = (t % NTT) << 6; const int tk = tid >> 3, ch = (tid & 7) << 3; const LAS unsigned short* tp = tile + u * (64 * 72); u32x4 o;
            o.x = (unsigned)tp[(ch + 0) * 72 + tk] | ((unsigned)tp[(ch + 1) * 72 + tk] << 16); o.y = (unsigned)tp[(ch + 2) * 72 + tk] | ((unsigned)tp[(ch + 3) * 72 + tk] << 16);
            o.z = (unsigned)tp[(ch + 4) * 72 + tk] | ((unsigned)tp[(ch + 5) * 72 + tk] << 16); o.w = (unsigned)tp[(ch + 6) * 72 + tk] | ((unsigned)tp[(ch + 7) * 72 + tk] << 16);
            *(u32x4*)(AB + (size_t)(k0 + tk) * 2048 + 1024 + c0 + ch) = o; }
        __syncthreads();
    }
}

template <bool OUTF32> __device__ __forceinline__ void rmsnorm_phase(const Ctx cx, const float* x, const float* g, void* outp, int nrows) {
    constexpr int RB = 4;
    const int wave = cx.tid >> 6, lane = cx.tid & 63;
    const int nw = cx.nblk * 8;
    for (int row0 = (cx.bid * 8 + wave) * RB; row0 < nrows; row0 += nw * RB) {
        f32x4 v[RB][8];
#pragma unroll
        for (int rb = 0; rb < RB; ++rb) { const f32x4* xr = (const f32x4*)(x + (size_t)(row0 + rb) * DM);
#pragma unroll
            for (int i = 0; i < 8; ++i) v[rb][i] = __builtin_nontemporal_load(xr + lane + 64 * i); }
        float rs[RB];
#pragma unroll
        for (int rb = 0; rb < RB; ++rb) { float ss = 0.f;
#pragma unroll
            for (int i = 0; i < 8; ++i) ss += v[rb][i][0] * v[rb][i][0] + v[rb][i][1] * v[rb][i][1] + v[rb][i][2] * v[rb][i][2] + v[rb][i][3] * v[rb][i][3];
            ss = wave_sum(cx.tid, ss); rs[rb] = rsqrtf(ss * (1.0f / DM) + 1e-6f); }
#pragma unroll
        for (int i = 0; i < 8; ++i) { const f32x4 gv = ((const f32x4*)g)[lane + 64 * i];
#pragma unroll
            for (int rb = 0; rb < RB; ++rb) { const f32x4 o = v[rb][i] * rs[rb] * gv;
                if (OUTF32) __builtin_nontemporal_store(o, (f32x4*)((float*)outp + (size_t)(row0 + rb) * DM) + lane + 64 * i);
                else { u32x2 w; w.x = cvt_pk_bf16(o[0], o[1]); w.y = cvt_pk_bf16(o[2], o[3]); ((u32x2*)((bf16_t*)outp + (size_t)(row0 + rb) * DM))[lane + 64 * i] = w; } } }
    }
}

#define XB_TMO      128
#define XB_XCNT(j)  (256  + 64 * (j))
#define XB_XSUB(j)  (1280 + 64 * (j))
#define XB_XGEN(j)  (2304 + 64 * (j))
#define XB_TOP      3328
#define XB_TOPGEN   3392
#define XCD_BAR_WORDS 3456
#define XB_SPIN_CAP (1u << 18)
__device__ __forceinline__ unsigned xb_ld(unsigned* p)              { return __hip_atomic_load(p, __ATOMIC_RELAXED, __HIP_MEMORY_SCOPE_AGENT); }
__device__ __forceinline__ unsigned xb_add(unsigned* p, unsigned v) { return __hip_atomic_fetch_add(p, v, __ATOMIC_RELAXED, __HIP_MEMORY_SCOPE_AGENT); }
__device__ __forceinline__ unsigned xb_xcc_id() { return (unsigned)__builtin_amdgcn_s_getreg((3 << 11) | 20) & 0xFu; }
#define XB_SPIN(cond, bar) do { unsigned _sp = 0; while (cond) { __builtin_amdgcn_s_sleep(1); \
    if ((++_sp & 255u) == 0u) { if (xb_ld(&(bar)[XB_TMO])) break; if (_sp > XB_SPIN_CAP) { atomicAdd(&(bar)[XB_TMO], 1u); break; } } } } while (0)
__device__ __forceinline__ void xcd_barrier_complete(unsigned* bar, unsigned x, unsigned G, unsigned& nloc, unsigned& nx) {
    unsigned sum, cnt, mine, sp = 0u;
    for (;;) {
        sum = 0u; cnt = 0u; mine = 0u;
#pragma unroll
        for (unsigned j = 0; j < 16; ++j) { const unsigned c = xb_ld(&bar[XB_XCNT(j)]); sum += c; cnt += (c > 0u) ? 1u : 0u; mine = (j == x) ? c : mine; }
        if (sum == G) break;
        __builtin_amdgcn_s_sleep(1);
        if ((++sp & 255u) == 0u) { if (xb_ld(&bar[XB_TMO])) break; if (sp > XB_SPIN_CAP) { atomicAdd(&bar[XB_TMO], 1u); break; } }
    }
    nloc = mine > 0u ? mine : 1u; nx = cnt > 0u ? cnt : 1u;
}
__device__ __forceinline__ void xcd_barrier(unsigned* bar, volatile LAS unsigned* st, bool leader, unsigned G) {
    asm volatile("s_waitcnt vmcnt(0)" ::: "memory");
    __syncthreads();
    if (leader) {
        __builtin_amdgcn_s_waitcnt(0);
        const unsigned x = xb_xcc_id();
        unsigned nloc = st[0], nx = st[1];
        if (nloc == 0u) { xcd_barrier_complete(bar, x, G, nloc, nx); st[0] = nloc; st[1] = nx; }
        const unsigned old = xb_add(&bar[XB_XSUB(x)], 1u);
        const unsigned gen = old / nloc;
        if (old + 1u == (gen + 1u) * nloc) {
            __builtin_amdgcn_fence(__ATOMIC_RELEASE, "agent");
            asm volatile("s_waitcnt vmcnt(0)" ::: "memory");
            const unsigned og = xb_add(&bar[XB_TOP], 1u);
            const unsigned tg = og / nx;
            if (og + 1u == (tg + 1u) * nx) xb_add(&bar[XB_TOPGEN], 1u);
            else XB_SPIN(xb_ld(&bar[XB_TOPGEN]) == tg, bar);
            __builtin_amdgcn_fence(__ATOMIC_ACQUIRE, "agent");
            xb_add(&bar[XB_XGEN(x)], 1u);
            asm volatile("s_waitcnt vmcnt(0)" ::: "memory");
        } else {
            XB_SPIN(xb_ld(&bar[XB_XGEN(x)]) == gen, bar);
            __builtin_amdgcn_fence(__ATOMIC_ACQUIRE, "agent");
            asm volatile("s_waitcnt vmcnt(0)" ::: "memory");
        }
    }
    __syncthreads();
}

typedef const __attribute__((address_space(4))) Params* PP;
__device__ __forceinline__ const float* grp_x(PP p, int g) { return g == 0 ? p->x_prompt : p->x_sample; }

__device__ __forceinline__ void run_phase(const Ctx cx, PP p, int ph, LAS unsigned char* lds) {
    unsigned char* ws = p->ws;
    bf16_t* WinT = (bf16_t*)(ws + WS_WIN); bf16_t* WpT = (bf16_t*)(ws + WS_WPOOL); bf16_t* WaT = (bf16_t*)(ws + WS_WA); bf16_t* WbT = (bf16_t*)(ws + WS_WB);
    bf16_t* WoT = (bf16_t*)(ws + WS_WO); bf16_t* WguT = (bf16_t*)(ws + WS_WGU); bf16_t* WdT = (bf16_t*)(ws + WS_WD);
    bf16_t* HF8 = (bf16_t*)(ws + WS_HF8); bf16_t* HF4 = (bf16_t*)(ws + WS_HF4); bf16_t* W3T = (bf16_t*)(ws + WS_W3T); f32x2* FS8 = (f32x2*)(ws + WS_FS8); f32x2* FS4 = (f32x2*)(ws + WS_FS4);
    f32x2* Z1 = (f32x2*)(ws + WS_Z1) + (size_t)cx.bid * 8192;
    bf16_t* H = (bf16_t*)(ws + WS_H); bf16_t* UP = (bf16_t*)(ws + WS_UP); bf16_t* G = (bf16_t*)(ws + WS_G); bf16_t* UH = (bf16_t*)(ws + WS_UH);
    bf16_t* PL = (bf16_t*)(ws + WS_PL); bf16_t* BT = (bf16_t*)(ws + WS_BT); bf16_t* AB = (bf16_t*)(ws + WS_AB); bf16_t* ACT = (bf16_t*)(ws + WS_ACT);
    if (EN(100) && ph == 0) {
        LAS float* tile = (LAS float*)lds;
        for (int job = 0; job < 7; ++job) {
            const float* s; int K, N, mode = 0, ldd = 0, koff = 0; bf16_t* d;
            switch (job) {
                case 0: s = p->w_in; K = 2048; N = 8192; d = WinT; mode = 1; break;
                case 1: s = p->w_a; K = 1024; N = 2048; d = UP; break;
                case 2: s = p->w_b; K = 1024; N = 2048; d = WaT; ldd = 2048; koff = 1024; break;
                case 3: s = p->w_out; K = 2048; N = 2048; d = WoT; break;
                case 4: s = p->w_gate; K = 2048; N = DFF; d = WguT; mode = 2; break;
                case 5: s = p->w_up; K = 2048; N = DFF; d = WguT; mode = 3; break;
                case 6: s = p->w_down; K = DFF; N = 2048; d = WdT; break;
                default: s = p->pool_w + (size_t)(job - 7) * 65536; K = 256; N = 256; d = WpT + (size_t)(job - 7) * 65536; break;
            }
            transpose_cvt(cx, tile, s, K, N, d, mode, ldd ? ldd : K, koff);
        }
        for (int idx = cx.bid * 512 + cx.tid; idx < 262144; idx += cx.nblk * 512)
            WpT[idx] = (bf16_t)(cvt_pk_bf16(p->pool_w[idx] * p->pool_scale[((idx >> 16) << 8) + (idx & 255)], 0.f) & 0xffffu);
        for (int idx = cx.bid * 512 + cx.tid; idx < 262144; idx += cx.nblk * 512)
            W3T[idx] = (bf16_t)(cvt_pk_bf16(p->filt_w3[(size_t)(idx & 63) * 4096 + ((idx >> 6) & 3) * 1024 + (idx >> 8)], 0.f) & 0xffffu);
        for (int v = 0; v < 2; ++v)
            filter_features(cx, (LAS float*)lds, p->filt_w1, p->filt_b1, p->filt_f1, p->filt_w2, p->filt_b2, p->filt_f2, v ? 4096 : 8192, v ? HF4 : HF8);
        return;
    }
    if (EN(101) && ph == 1) {
        { Gemm gf{UP, WpT, 2048, 1024, 256, 1024, 256, 256, WGM}; EpiRaw ef{WaT, 2048}; gemm_phase(cx, lds, gf, ef); }
        for (int v = 0; v < 2; ++v) filter_spectrum(cx, lds, W3T, p->hyena_bias, v ? 4096 : 8192, v ? 13 : 14, v ? HF4 : HF8, v ? FS4 : FS8);
        rmsnorm_phase<false>(cx, grp_x(p, 0), p->g_mix, H, NTG);
        return;
    }
    const int g = (ph - 2) / 9, k = (ph - 2) % 9;
    const int L = g == 0 ? 8192 : 4096, logN2 = g == 0 ? 14 : 13, nb = g == 0 ? 4 : 8;
    float* outg = p->out + (size_t)g * NTG * DM;
    switch (k) {
        case 0: if (EN(0)) {
            Gemm ga{H, WinT, NTG, 5120, 2048, 2048, 2048, 0, WGM}; EpiUPG ea{UP, G}; gemm_phase(cx, lds, ga, ea);
            Gemm gb{WinT + (size_t)5120 * 2048, H, 3072, NTG, 2048, 2048, 2048, 0, 6}; EpiRaw eb{UH, NTG}; gemm_phase(cx, lds, gb, eb);
        } break;
        case 1: if (EN(1)) {
            hyena_phase(cx, lds, p->conv_w, p->conv_b, p->hyena_bias, L, logN2, nb, g == 0 ? FS8 : FS4, UH, BT, Z1);
        } break;
        case 2: if (EN(2)) {
            pool_phase(cx, UP, AB, L);
            bt_transpose(cx, (LAS unsigned short*)lds, BT, AB);
        } break;
        case 3: if (EN(3)) {
            Gemm g1{AB, WaT, NTG, 2048, 2048, 2048, 2048, 0, WGM}; EpiMerge e1{G, H}; gemm_phase<EpiMerge, true>(cx, lds, g1, e1);
        } break;
        case 4: if (EN(4)) {
            Gemm go{H, WoT, NTG, 2048, 2048, 2048, 2048, 0, WGM}; EpiRes eo{grp_x(p, g), outg}; gemm_phase(cx, lds, go, eo);
        } break;
        case 5: if (EN(5)) rmsnorm_phase<false>(cx, outg, p->g_ffn, H, NTG); break;
        case 6: if (EN(6)) {
            Gemm gg{H, WguT, NTG, 11264, 2048, 2048, 2048, 0, 8}; EpiSwiGLU eg{ACT}; gemm_phase(cx, lds, gg, eg);
        } break;
        case 7: if (EN(7)) {
            Gemm gd{ACT, WdT, NTG, 2048, DFF, DFF, DFF, 0, WGM}; EpiRes ed{outg, outg}; gemm_phase(cx, lds, gd, ed);
        } break;
        case 8: if (EN(8)) {
            rmsnorm_phase<true>(cx, outg, p->g_final, outg, NTG);
            if (g + 1 < NGRP) rmsnorm_phase<false>(cx, grp_x(p, g + 1), p->g_mix, H, NTG);
        } break;
    }
}

__global__ __launch_bounds__(512, 2) void mega(Params p, int ph_lo, int ph_hi) {
    extern __shared__ __attribute__((aligned(16))) unsigned char smem_raw[];
    LAS unsigned char* lds = (LAS unsigned char*)smem_raw;
    const int wid_s = __builtin_amdgcn_readfirstlane((int)threadIdx.x >> 6);
    volatile LAS unsigned* bst = (volatile LAS unsigned*)(lds + LDS_X_BYTES + 1024);
    { unsigned* bar0 = (unsigned*)(((PP)__builtin_amdgcn_kernarg_segment_ptr())->ws + WS_BAR);
      if (threadIdx.x == 0) { bst[0] = 0u; bst[1] = 0u; (void)xb_add(&bar0[XB_XCNT(xb_xcc_id())], 1u); }
      __syncthreads(); }
    for (int ph = ph_lo; ph < ph_hi; ++ph) {
        int nrep = 1;
#ifdef PROBE_DUP
        if ((PROBE_DUP >= 100 && ph == PROBE_DUP - 100) || (PROBE_DUP < 100 && ph >= 2 && (ph - 2) % 9 == PROBE_DUP)) nrep = 2;
#endif
        for (int r = 0; r < nrep; ++r) {
            if (r) __syncthreads();
            PP pp = (PP)__builtin_amdgcn_kernarg_segment_ptr(); asm volatile("" : "+s"(pp));
            Ctx cx; cx.bid = blockIdx.x; cx.nblk = gridDim.x;
            { int lane_; asm volatile("v_mbcnt_lo_u32_b32 %0, -1, 0\n\tv_mbcnt_hi_u32_b32 %0, -1, %0" : "=&v"(lane_)); cx.tid = (wid_s << 6) | lane_; }
            asm volatile("" : "+v"(cx.tid)); asm volatile("" : "+s"(cx.bid)); asm volatile("" : "+s"(cx.nblk));
            run_phase(cx, pp, ph, lds);
        }
        if (ph + 1 < ph_hi) {
            if (ph_lo < 0) cg::this_grid().sync();
            { int lane_; asm volatile("v_mbcnt_lo_u32_b32 %0, -1, 0\n\tv_mbcnt_hi_u32_b32 %0, -1, %0" : "=&v"(lane_));
                   unsigned* bar = (unsigned*)(((PP)__builtin_amdgcn_kernarg_segment_ptr())->ws + WS_BAR);
                   xcd_barrier(bar, bst, wid_s == 0 && lane_ == 0, gridDim.x); }
        }
    }
}

extern "C" void kernel_launch(void* const* d_in, const int* in_sizes, int n_in, void* d_out, int out_size, void* d_ws, size_t ws_size, hipStream_t stream) {
    static int grid = 0;
    if (grid == 0) {
        if (n_in != 24 || ws_size < WS_END) { fprintf(stderr, "kernel_launch: unexpected n_in %d or ws_size %zu (< %zu)\n", n_in, ws_size, (size_t)WS_END); grid = -1; return; }
        int dev = 0, cus = 0, per_cu = 0;
        hipGetDevice(&dev); hipDeviceGetAttribute(&cus, hipDeviceAttributeMultiprocessorCount, dev);
        if (hipFuncSetAttribute((const void*)mega, hipFuncAttributeMaxDynamicSharedMemorySize, LDS_BYTES) != hipSuccess) { fprintf(stderr, "kernel_launch: hipFuncSetAttribute failed\n"); grid = -1; return; }
        if (hipOccupancyMaxActiveBlocksPerMultiprocessor(&per_cu, (const void*)mega, 512, LDS_BYTES) != hipSuccess || per_cu < 1) { fprintf(stderr, "kernel_launch: occupancy query says %d\n", per_cu); per_cu = 1; }
        (void)hipGetLastError();
        grid = cus; if (grid > 256) grid = 256; if (grid < 1) grid = 256;
    }
    if (grid < 0) return;
    Params p{};
    const float** pp = (const float**)&p;
    for (int i = 0; i < 24; ++i) pp[i] = (const float*)d_in[i];
    p.out = (float*)d_out; p.ws = (unsigned char*)d_ws;
    if (hipMemsetAsync((char*)d_ws + WS_BAR, 0, 16384, stream) != hipSuccess) { fprintf(stderr, "kernel_launch: memset of barrier words failed\n"); return; }
#if MULTI_LAUNCH
    for (int ph = 0; ph < NPH; ++ph) hipLaunchKernelGGL(mega, dim3(grid), dim3(512), LDS_BYTES, stream, p, ph, ph + 1);
#else
    int lo = 0, hi = NPH; void* args[] = {&p, &lo, &hi};
    hipError_t e = hipLaunchCooperativeKernel((const void*)mega, dim3(grid), dim3(512), args, LDS_BYTES, stream);
    if (e != hipSuccess) fprintf(stderr, "kernel_launch: cooperative launch failed: %s (grid %d)\n", hipGetErrorString(e), grid);
#endif
}
```

```cpp
#include <hip/hip_runtime.h>
#include <hip/hip_cooperative_groups.h>
#include <cstdio>
namespace cg = cooperative_groups;

#ifndef MULTI_LAUNCH
#define MULTI_LAUNCH 0
#endif

#ifndef ONLY
#define ONLY -1
#endif
#define EN(x) (ONLY == -1 || ONLY == (x))
#define LAS __attribute__((address_space(3)))
typedef unsigned short bf16_t;
typedef short bf16x8 __attribute__((ext_vector_type(8)));
typedef float f32x4 __attribute__((ext_vector_type(4)));
typedef float f32x2 __attribute__((ext_vector_type(2)));
typedef unsigned u32x4 __attribute__((ext_vector_type(4)));
typedef unsigned u32x2 __attribute__((ext_vector_type(2)));

constexpr int DM = 2048, DFF = 5632, NTG = 32768, NGRP = 2;
constexpr int BM = 256, BK = 64, HALF = 128, HTB = HALF * BK * 2, NXCD = 8, WGM = 4;
constexpr int XPAD_ELEMS = 16384 + 512 * 5;
constexpr int LDS_X_BYTES = XPAD_ELEMS * 8;
constexpr int LDS_BYTES = LDS_X_BYTES + 2048;
constexpr int NPH = 2 + NGRP * 9;

constexpr size_t WS_WIN = 0;
constexpr size_t WS_WPOOL = WS_WIN + (size_t)8192 * 2048 * 2;
constexpr size_t WS_WA = WS_WPOOL + (size_t)1024 * 256 * 2;
constexpr size_t WS_WB = WS_WA + (size_t)2048 * 1024 * 2;
constexpr size_t WS_WO = WS_WB + (size_t)2048 * 1024 * 2;
constexpr size_t WS_WGU = WS_WO + (size_t)2048 * 2048 * 2;
constexpr size_t WS_WD = WS_WGU + (size_t)11264 * 2048 * 2;
constexpr size_t WS_HF8 = WS_WD + (size_t)2048 * 5632 * 2;
constexpr size_t WS_HF4 = WS_HF8 + (size_t)8192 * 64 * 4;
constexpr size_t WS_FS8 = WS_HF4 + (size_t)4096 * 64 * 4;
constexpr size_t WS_FS4 = WS_FS8 + (size_t)1024 * 16384 * 8;
constexpr size_t WS_Z1 = WS_FS4 + (size_t)1024 * 8192 * 8;
constexpr size_t WS_H = WS_Z1 + (size_t)256 * 65536;
constexpr size_t WS_UP = WS_H + (size_t)NTG * 2048 * 2;
constexpr size_t WS_G = WS_UP + (size_t)NTG * 1024 * 2;
constexpr size_t WS_UH = WS_G + (size_t)NTG * 4096 * 2;
constexpr size_t WS_W3T = WS_UH + (size_t)3072 * NTG * 2;
constexpr size_t WS_BAR = WS_W3T + (size_t)1024 * 256 * 2;
constexpr size_t WS_END = WS_BAR + 16384;
constexpr size_t WS_PL = WS_H;
constexpr size_t WS_BT = WS_H + (size_t)NTG * 1024 * 2;
constexpr size_t WS_AB = WS_UH;
constexpr size_t WS_ACT = WS_G;
static_assert((size_t)NTG * DFF * 2 <= (size_t)NTG * 4096 * 2 + (size_t)3072 * NTG * 2, "ACT must fit in G|UH");

struct Params {
    const float* x_prompt; const float* x_sample; const float* g_mix; const float* w_in; const float* pool_w; const float* pool_scale;
    const float* conv_w; const float* conv_b; const float* filt_w1; const float* filt_b1; const float* filt_f1; const float* filt_w2;
    const float* filt_b2; const float* filt_f2; const float* filt_w3; const float* hyena_bias; const float* w_a; const float* w_b;
    const float* w_out; const float* g_ffn; const float* w_gate; const float* w_up; const float* w_down; const float* g_final;
    float* out; unsigned char* ws;
};

struct Ctx { int tid, bid, nblk; };
__device__ __forceinline__ float bf2f(unsigned short b) { return __uint_as_float(((unsigned)b) << 16); }
__device__ __forceinline__ unsigned cvt_pk_bf16(float lo, float hi) { unsigned r; asm volatile("v_cvt_pk_bf16_f32 %0, %1, %2" : "=v"(r) : "v"(lo), "v"(hi)); return r; }
__device__ __forceinline__ float sigmoidf_(float v) { return __builtin_amdgcn_rcpf(1.0f + __builtin_amdgcn_exp2f(-1.4426950408889634f * v)); }
__device__ __forceinline__ float wave_sum(int tid, float v) {
#pragma unroll
    for (int o = 32; o > 0; o >>= 1) v += __int_as_float(__builtin_amdgcn_ds_bpermute(((tid ^ o) & 63) << 2, __float_as_int(v)));
    return v;
}

__device__ __forceinline__ int lds_byte(int r, int c) { const int st = (r >> 4) * 2 + (c >> 5), rr = r & 15, cc = c & 31, ob = rr * 64 + cc * 2; return st * 1024 + (ob ^ (((ob >> 9) & 1) << 5)); }
__device__ __forceinline__ void stage_rc(int b, int& R, int& C) { const int st = b / 1024, sb = b % 1024, swz = sb ^ (((sb >> 9) & 1) << 5); R = (st >> 1) * 16 + swz / 64; C = (st & 1) * 32 + (swz % 64) / 2; }
__device__ __forceinline__ int perm32(int rho) { const int n = rho >> 4, i = rho & 15; return 8 * (i >> 2) + 4 * n + (i & 3); }

struct Unit { int pm, pn; };
struct Gemm { const bf16_t* A; const bf16_t* Bt; int M, N, K, lda, ldb, a_pn_step, wgm; };

struct StaticOrder {
    int nM, nN, nwg, G, c, wgm;
    __device__ __forceinline__ void init(int M, int N, int G_, int c_, int wgm_) { nM = M / BM; nN = N / BM; nwg = nM * nN; G = G_; c = c_; wgm = wgm_; }
    __device__ __forceinline__ bool next(int i, Unit& u) const {
        const long L = (long)i * G + c; if (L >= nwg) return false;
        int wgid = (int)L; { const int q = nwg / NXCD, r = nwg % NXCD, xcd = wgid % NXCD, off = wgid / NXCD; wgid = (xcd < r ? xcd * (q + 1) : r * (q + 1) + (xcd - r) * q) + off; }
        const int nig = wgm * nN, gid = wgid / nig, fm = gid * wgm, gsz = (nM - fm) < wgm ? (nM - fm) : wgm;
        u.pm = fm + ((wgid % nig) % gsz); u.pn = (wgid % nig) / gsz; return true;
    }
};

template <class Epi, bool MID = false>
__device__ __forceinline__ void gemm_phase(const Ctx cx, LAS unsigned char* lds, const Gemm g, const Epi& E) {
    const int tid = cx.tid, wid = __builtin_amdgcn_readfirstlane(tid >> 6), lane = tid & 63, wr = wid >> 2, wc = wid & 3, fr = lane & 15, fq = lane >> 4;
    const int K = g.K, nt = K / BK;
    StaticOrder S; S.init(g.M, g.N, cx.nblk, cx.bid, g.wgm);
    unsigned voffA[2], voffB[2];
#pragma unroll
    for (int i = 0; i < 2; ++i) { int R, C; stage_rc(tid * 16 + i * 8192, R, C); const int Rb = Epi::PERM ? ((R & ~31) + perm32(R & 31)) : R;
        voffA[i] = (unsigned)(R * g.lda + C) * 2u; voffB[i] = (unsigned)(Rb * g.ldb + C) * 2u; }
    const size_t kstep = (size_t)(BK * 2);
    const size_t hstepA = (size_t)HALF * g.lda * 2, hstepB = (size_t)HALF * g.ldb * 2;
    const size_t tstepA = 2 * hstepA, tstepB = 2 * hstepB;
    const unsigned ldsw = (unsigned)wid * 1024u;
    const int aoff = lds_byte(wr * 64 + fr, fq * 8), boff = lds_byte(wc * 32 + fr, fq * 8);
#define PG8_SA(b, h) (((b) * 2 + (h)) * HTB)
#define PG8_SB(b, h) ((4 + (b) * 2 + (h)) * HTB)
#define PG8_STAGE(bufoff, gbase, voff) do { _Pragma("unroll") for (int _i = 0; _i < 2; ++_i) \
        __builtin_amdgcn_global_load_lds((const unsigned*)((const char*)(gbase) + (voff)[_i]), (LAS unsigned*)(lds + (bufoff) + ldsw + _i * 8192), 16, 0, 0); } while (0)
#define PG8_LDA(dst, b, h) do { _Pragma("unroll") for (int m = 0; m < 4; ++m) _Pragma("unroll") for (int k = 0; k < 2; ++k) dst[m][k] = *(const LAS bf16x8*)(lds + PG8_SA(b, h) + aoff + m * 2048 + k * 1024); } while (0)
#define PG8_LDB(dst, b, h) do { _Pragma("unroll") for (int n = 0; n < 2; ++n) _Pragma("unroll") for (int k = 0; k < 2; ++k) dst[n][k] = *(const LAS bf16x8*)(lds + PG8_SB(b, h) + boff + n * 2048 + k * 1024); } while (0)
#define PG8_MMA(ai, bj, At, Bt) do { __builtin_amdgcn_s_setprio(1); _Pragma("unroll") for (int m = 0; m < 4; ++m) _Pragma("unroll") for (int n = 0; n < 2; ++n) _Pragma("unroll") for (int k = 0; k < 2; ++k) \
        acc[ai][bj][m][n] = __builtin_amdgcn_mfma_f32_16x16x32_bf16(Bt[n][k], At[m][k], acc[ai][bj][m][n], 0, 0, 0); __builtin_amdgcn_s_setprio(0); } while (0)
#define PG8_WAIT_V(n) asm volatile("s_waitcnt vmcnt(" #n ")" ::: "memory")
#define PG8_WAIT_L(n) asm volatile("s_waitcnt lgkmcnt(" #n ")" ::: "memory")
#define PG8_BAR __builtin_amdgcn_s_barrier()
#define PG8_SCHED __builtin_amdgcn_sched_barrier(0)
    Unit cur, nxt; int ui = 0;
    if (!S.next(0, cur)) return;
    f32x4 acc[2][2][4][2];
#pragma unroll
    for (int a = 0; a < 2; ++a)
#pragma unroll
        for (int b = 0; b < 2; ++b)
#pragma unroll
            for (int m = 0; m < 4; ++m)
#pragma unroll
                for (int n = 0; n < 2; ++n) acc[a][b][m][n] = (f32x4){0.f, 0.f, 0.f, 0.f};
    bf16x8 At[4][2], B0[2][2], B1[2][2];
    const char* cA = (const char*)g.A + (size_t)cur.pm * tstepA + (size_t)cur.pn * (size_t)g.a_pn_step * 2; const char* cB = (const char*)g.Bt + (size_t)cur.pn * tstepB;
    PG8_STAGE(PG8_SB(0, 0), cB, voffB); PG8_STAGE(PG8_SA(0, 0), cA, voffA); PG8_STAGE(PG8_SB(0, 1), cB + hstepB, voffB); PG8_STAGE(PG8_SA(0, 1), cA + hstepA, voffA);
    if (wr == 1) PG8_BAR;
    PG8_WAIT_V(4); PG8_BAR;
    PG8_STAGE(PG8_SB(1, 0), cB + kstep, voffB); PG8_STAGE(PG8_SA(1, 0), cA + kstep, voffA); PG8_STAGE(PG8_SB(1, 1), cB + hstepB + kstep, voffB);
    PG8_WAIT_V(6); PG8_BAR;
    for (;;) {
        const bool has_next = S.next(ui + 1, nxt);
        const char* nA = has_next ? (const char*)g.A + (size_t)nxt.pm * tstepA + (size_t)nxt.pn * (size_t)g.a_pn_step * 2 : cA; const char* nB = has_next ? (const char*)g.Bt + (size_t)nxt.pn * tstepB : cB;
        for (int t = 0; t < nt; t += 2) {
            const bool last = (t == nt - 2);
            const char* a1 = cA + (size_t)(t + 1) * kstep;
            const char* a2 = last ? nA : cA + (size_t)(t + 2) * kstep; const char* b2 = last ? nB : cB + (size_t)(t + 2) * kstep;
            const char* a3 = a2 + kstep; const char* b3 = b2 + kstep;
            if constexpr (MID) if (t == (nt >> 1)) { int fr_ = fr, fq_ = fq; asm volatile("" : "+v"(fr_), "+v"(fq_)); E.mid(acc, cur, wr, wc, fr_, fq_); }
            PG8_LDB(B0, 0, 0); PG8_SCHED; PG8_LDA(At, 0, 0); PG8_STAGE(PG8_SA(1, 1), a1 + hstepA, voffA);
            PG8_WAIT_L(8); PG8_BAR; PG8_WAIT_L(0); PG8_MMA(0, 0, At, B0); PG8_BAR; PG8_SCHED;
            PG8_LDB(B1, 0, 1); PG8_STAGE(PG8_SB(0, 0), b2, voffB);
            PG8_BAR; PG8_WAIT_L(0); PG8_MMA(0, 1, At, B1); PG8_BAR;
            PG8_LDA(At, 0, 1); PG8_STAGE(PG8_SA(0, 0), a2, voffA);
            PG8_BAR; PG8_WAIT_L(0); PG8_MMA(1, 0, At, B0); PG8_BAR; PG8_SCHED;
            PG8_STAGE(PG8_SB(0, 1), b2 + hstepB, voffB);
            PG8_WAIT_V(6); PG8_BAR; PG8_MMA(1, 1, At, B1); PG8_BAR;
            PG8_LDB(B0, 1, 0); PG8_SCHED; PG8_LDA(At, 1, 0); PG8_STAGE(PG8_SA(0, 1), a2 + hstepA, voffA);
            PG8_WAIT_L(8); PG8_BAR; PG8_WAIT_L(0); PG8_MMA(0, 0, At, B0); PG8_BAR; PG8_SCHED;
            PG8_LDB(B1, 1, 1); PG8_STAGE(PG8_SB(1, 0), b3, voffB);
            PG8_BAR; PG8_WAIT_L(0); PG8_MMA(0, 1, At, B1); PG8_BAR;
            PG8_LDA(At, 1, 1); PG8_STAGE(PG8_SA(1, 0), a3, voffA);
            PG8_BAR; PG8_WAIT_L(0); PG8_MMA(1, 0, At, B0); PG8_BAR; PG8_SCHED;
            PG8_STAGE(PG8_SB(1, 1), b3 + hstepB, voffB);
            PG8_WAIT_V(6); PG8_BAR; PG8_MMA(1, 1, At, B1); PG8_BAR;
        }
        { int fr_ = fr, fq_ = fq; asm volatile("" : "+v"(fr_), "+v"(fq_));
          E(acc, cur, wr, wc, fr_, fq_); }
        if (!has_next) break;
#pragma unroll
        for (int a = 0; a < 2; ++a)
#pragma unroll
            for (int b = 0; b < 2; ++b)
#pragma unroll
                for (int m = 0; m < 4; ++m)
#pragma unroll
                    for (int n = 0; n < 2; ++n) acc[a][b][m][n] = (f32x4){0.f, 0.f, 0.f, 0.f};
        cur = nxt; cA = nA; cB = nB; ++ui;
    }
    PG8_WAIT_V(0);
    if (wr == 0) PG8_BAR;
    PG8_BAR;
#undef PG8_SA
#undef PG8_SB
#undef PG8_STAGE
#undef PG8_LDA
#undef PG8_LDB
#undef PG8_MMA
#undef PG8_WAIT_V
#undef PG8_WAIT_L
#undef PG8_BAR
#undef PG8_SCHED
}

typedef const f32x4 (&AccRef)[2][2][4][2];
__device__ __forceinline__ u32x4 pack8(f32x4 v0, f32x4 v1) { u32x4 w; w.x = cvt_pk_bf16(v0[0], v0[1]); w.y = cvt_pk_bf16(v0[2], v0[3]); w.z = cvt_pk_bf16(v1[0], v1[1]); w.w = cvt_pk_bf16(v1[2], v1[3]); return w; }
__device__ __forceinline__ void unpack8(u32x4 w, f32x4& v0, f32x4& v1) {
    v0[0] = __uint_as_float(w.x << 16); v0[1] = __uint_as_float(w.x & 0xffff0000u); v0[2] = __uint_as_float(w.y << 16); v0[3] = __uint_as_float(w.y & 0xffff0000u);
    v1[0] = __uint_as_float(w.z << 16); v1[1] = __uint_as_float(w.z & 0xffff0000u); v1[2] = __uint_as_float(w.w << 16); v1[3] = __uint_as_float(w.w & 0xffff0000u);
}

struct EpiUPG {
    static constexpr bool PERM = true; bf16_t* UP; bf16_t* G;
    __device__ __forceinline__ void operator()(AccRef acc, const Unit& u, int wr, int wc, int fr, int fq) const {
        const int row0 = u.pm * BM + wr * 64 + fr; const bool sg = u.pn >= 4;
        bf16_t* base = sg ? G : UP; const int ldc = sg ? 4096 : 1024; const int col0 = (sg ? u.pn * BM - 1024 : u.pn * BM) + wc * 32 + 8 * fq;
#pragma unroll
        for (int ai = 0; ai < 2; ++ai)
#pragma unroll
            for (int m = 0; m < 4; ++m) { bf16_t* rowp = base + (size_t)(row0 + ai * HALF + m * 16) * ldc + col0;
#pragma unroll
                for (int bj = 0; bj < 2; ++bj) { f32x4 v0 = acc[ai][bj][m][0], v1 = acc[ai][bj][m][1];
                    if (sg) {
#pragma unroll
                        for (int j = 0; j < 4; ++j) { v0[j] = sigmoidf_(v0[j]); v1[j] = sigmoidf_(v1[j]); } }
                    *(u32x4*)(rowp + bj * HALF) = pack8(v0, v1); }
                __builtin_amdgcn_sched_barrier(0); }
    }
};
struct EpiRaw {
    static constexpr bool PERM = true; bf16_t* O; int ldc;
    __device__ __forceinline__ void operator()(AccRef acc, const Unit& u, int wr, int wc, int fr, int fq) const {
        const int row0 = u.pm * BM + wr * 64 + fr; const int col0 = u.pn * BM + wc * 32 + 8 * fq;
#pragma unroll
        for (int ai = 0; ai < 2; ++ai)
#pragma unroll
            for (int m = 0; m < 4; ++m) { bf16_t* rowp = O + (size_t)(row0 + ai * HALF + m * 16) * ldc + col0;
#pragma unroll
                for (int bj = 0; bj < 2; ++bj) *(u32x4*)(rowp + bj * HALF) = pack8(acc[ai][bj][m][0], acc[ai][bj][m][1]);
                __builtin_amdgcn_sched_barrier(0); }
    }
};
struct EpiPool {
    static constexpr bool PERM = true; bf16_t* O; const float* scale;
    __device__ __forceinline__ void operator()(AccRef acc, const Unit& u, int wr, int wc, int fr, int fq) const {
        const int row0 = u.pm * BM + wr * 64 + fr; const int col0 = u.pn * BM + wc * 32 + 8 * fq;
        f32x4 s[2][2];
#pragma unroll
        for (int bj = 0; bj < 2; ++bj) { s[bj][0] = *(const f32x4*)(scale + col0 + bj * HALF); s[bj][1] = *(const f32x4*)(scale + col0 + bj * HALF + 4); }
#pragma unroll
        for (int ai = 0; ai < 2; ++ai)
#pragma unroll
            for (int m = 0; m < 4; ++m) { bf16_t* rowp = O + (size_t)(row0 + ai * HALF + m * 16) * 2048 + col0;
#pragma unroll
                for (int bj = 0; bj < 2; ++bj) *(u32x4*)(rowp + bj * HALF) = pack8(acc[ai][bj][m][0] * s[bj][0], acc[ai][bj][m][1] * s[bj][1]);
                __builtin_amdgcn_sched_barrier(0); }
    }
};
template <bool ADD> struct EpiGate {
    static constexpr bool PERM = true; const bf16_t* Gt; const bf16_t* T; bf16_t* O;
    __device__ __forceinline__ void operator()(AccRef acc, const Unit& u, int wr, int wc, int fr, int fq) const {
        const int row0 = u.pm * BM + wr * 64 + fr; const int col0 = u.pn * BM + wc * 32 + 8 * fq;
#pragma unroll
        for (int ai = 0; ai < 2; ++ai) {
            u32x4 gw[4][2], tw[4][2];
#pragma unroll
            for (int m = 0; m < 4; ++m)
#pragma unroll
                for (int bj = 0; bj < 2; ++bj) { const size_t row = (size_t)(row0 + ai * HALF + m * 16);
                    gw[m][bj] = *(const u32x4*)(Gt + row * 4096 + col0 + bj * HALF);
                    if (ADD) tw[m][bj] = *(const u32x4*)(T + row * 2048 + col0 + bj * HALF); }
#pragma unroll
            for (int m = 0; m < 4; ++m)
#pragma unroll
                for (int bj = 0; bj < 2; ++bj) { const size_t row = (size_t)(row0 + ai * HALF + m * 16);
                    f32x4 g0, g1; unpack8(gw[m][bj], g0, g1);
                    f32x4 v0 = acc[ai][bj][m][0] * g0, v1 = acc[ai][bj][m][1] * g1;
                    if (ADD) { f32x4 t0, t1; unpack8(tw[m][bj], t0, t1); v0 += t0; v1 += t1; }
                    *(u32x4*)(O + row * 2048 + col0 + bj * HALF) = pack8(v0, v1); }
            __builtin_amdgcn_sched_barrier(0);
        }
    }
};
struct EpiMerge {
    static constexpr bool PERM = true; const bf16_t* G; bf16_t* O;
    __device__ __forceinline__ void mid(f32x4 (&acc)[2][2][4][2], const Unit& u, int wr, int wc, int fr, int fq) const {
        const int row0 = u.pm * BM + wr * 64 + fr; const int col0 = u.pn * BM + wc * 32 + 8 * fq;
        u32x4 ga[2][2][2], gb[2][2][2];
#define MRG_LOAD(buf, k) do { _Pragma("unroll") for (int mm = 0; mm < 2; ++mm) _Pragma("unroll") for (int bj = 0; bj < 2; ++bj) { \
            const bf16_t* gp = G + (size_t)(row0 + ((k) >> 1) * HALF + (((k) & 1) * 2 + mm) * 16) * 4096 + col0 + bj * HALF; \
            ga[buf][mm][bj] = *(const u32x4*)gp; gb[buf][mm][bj] = *(const u32x4*)(gp + 2048); } } while (0)
        MRG_LOAD(0, 0);
#pragma unroll
        for (int k = 0; k < 4; ++k) {
            if (k < 3) MRG_LOAD((k + 1) & 1, k + 1);
            const int ai = k >> 1, mp = k & 1;
#pragma unroll
            for (int mm = 0; mm < 2; ++mm)
#pragma unroll
                for (int bj = 0; bj < 2; ++bj) { f32x4 a0, a1, b0, b1; unpack8(ga[k & 1][mm][bj], a0, a1); unpack8(gb[k & 1][mm][bj], b0, b1);
#pragma unroll
                    for (int j = 0; j < 4; ++j) { acc[ai][bj][mp * 2 + mm][0][j] *= a0[j] * __builtin_amdgcn_rcpf(b0[j]); acc[ai][bj][mp * 2 + mm][1][j] *= a1[j] * __builtin_amdgcn_rcpf(b1[j]); } }
            __builtin_amdgcn_sched_barrier(0);
        }
#undef MRG_LOAD
    }
    __device__ __forceinline__ void operator()(AccRef acc, const Unit& u, int wr, int wc, int fr, int fq) const {
        const int row0 = u.pm * BM + wr * 64 + fr; const int col0 = u.pn * BM + wc * 32 + 8 * fq;
#pragma unroll
        for (int ai = 0; ai < 2; ++ai) {
            u32x4 gw[4][2];
#pragma unroll
            for (int m = 0; m < 4; ++m)
#pragma unroll
                for (int bj = 0; bj < 2; ++bj) gw[m][bj] = *(const u32x4*)(G + (size_t)(row0 + ai * HALF + m * 16) * 4096 + 2048 + col0 + bj * HALF);
#pragma unroll
            for (int m = 0; m < 4; ++m)
#pragma unroll
                for (int bj = 0; bj < 2; ++bj) { f32x4 g0, g1; unpack8(gw[m][bj], g0, g1);
                    *(u32x4*)(O + (size_t)(row0 + ai * HALF + m * 16) * 2048 + col0 + bj * HALF) = pack8(acc[ai][bj][m][0] * g0, acc[ai][bj][m][1] * g1); }
            __builtin_amdgcn_sched_barrier(0);
        }
    }
};
struct EpiRes {
    static constexpr bool PERM = false; const float* R; float* O;
    __device__ __forceinline__ void operator()(AccRef acc, const Unit& u, int wr, int wc, int fr, int fq) const {
        const int row0 = u.pm * BM + wr * 64 + fr; const int col0 = u.pn * BM + wc * 32 + 4 * fq;
#pragma unroll
        for (int ai = 0; ai < 2; ++ai) {
            f32x4 r[4][2][2];
#pragma unroll
            for (int m = 0; m < 4; ++m)
#pragma unroll
                for (int bj = 0; bj < 2; ++bj)
#pragma unroll
                    for (int n = 0; n < 2; ++n) r[m][bj][n] = *(const f32x4*)(R + (size_t)(row0 + ai * HALF + m * 16) * 2048 + col0 + bj * HALF + n * 16);
#pragma unroll
            for (int m = 0; m < 4; ++m)
#pragma unroll
                for (int bj = 0; bj < 2; ++bj)
#pragma unroll
                    for (int n = 0; n < 2; ++n) *(f32x4*)(O + (size_t)(row0 + ai * HALF + m * 16) * 2048 + col0 + bj * HALF + n * 16) = r[m][bj][n] + acc[ai][bj][m][n];
            __builtin_amdgcn_sched_barrier(0);
        }
    }
};
struct EpiSwiGLU {
    static constexpr bool PERM = true; bf16_t* O;
    __device__ __forceinline__ void operator()(AccRef acc, const Unit& u, int wr, int wc, int fr, int fq) const {
        const int row0 = u.pm * BM + wr * 64 + fr; const int col0 = u.pn * HALF + wc * 32 + 8 * fq;
#pragma unroll
        for (int ai = 0; ai < 2; ++ai)
#pragma unroll
            for (int m = 0; m < 4; ++m) { f32x4 v0, v1;
#pragma unroll
                for (int j = 0; j < 4; ++j) { const float a0 = acc[ai][0][m][0][j], a1 = acc[ai][0][m][1][j];
                    v0[j] = a0 * sigmoidf_(a0) * acc[ai][1][m][0][j]; v1[j] = a1 * sigmoidf_(a1) * acc[ai][1][m][1][j]; }
                *(u32x4*)(O + (size_t)(row0 + ai * HALF + m * 16) * DFF + col0) = pack8(v0, v1);
                __builtin_amdgcn_sched_barrier(0); }
    }
};

__device__ __forceinline__ int rowmap(int mode, int n) {
    switch (mode) {
        case 1: return n < 1024 ? n : (n < 4096 ? n + 4096 : n - 3072);
        case 2: return ((n >> 7) << 8) + (n & 127);
        case 3: return ((n >> 7) << 8) + 128 + (n & 127);
        default: return n;
    }
}
__device__ __forceinline__ void transpose_cvt(const Ctx cx, LAS float* tile, const float* src, int K, int N, bf16_t* dst, int mode, int ldd, int koff) {
    constexpr int TB = 4;
    const int tid = cx.tid; const int tn = N >> 6, ntile = (K >> 6) * tn;
    for (int t4 = cx.bid * TB; t4 < ntile; t4 += cx.nblk * TB) {
        f32x4 v[TB][2];
#pragma unroll
        for (int u = 0; u < TB; ++u) { const int t = t4 + u, k0 = (t / tn) << 6, n0 = (t % tn) << 6;
#pragma unroll
            for (int i = 0; i < 2; ++i) { const int kk = (tid >> 4) + i * 32, nc = (tid & 15) << 2; v[u][i] = *(const f32x4*)(src + (size_t)(k0 + kk) * N + n0 + nc); } }
#pragma unroll
        for (int u = 0; u < TB; ++u)
#pragma unroll
            for (int i = 0; i < 2; ++i) { const int kk = (tid >> 4) + i * 32, nc = (tid & 15) << 2; LAS float* tp = tile + u * (64 * 65) + kk * 65 + nc;
                tp[0] = v[u][i][0]; tp[1] = v[u][i][1]; tp[2] = v[u][i][2]; tp[3] = v[u][i][3]; }
        __syncthreads();
#pragma unroll
        for (int u = 0; u < TB; ++u) { const int t = t4 + u, k0 = (t / tn) << 6, n0 = (t % tn) << 6;
            const int nn = tid >> 3, kc = (tid & 7) << 3; f32x4 a, b; const LAS float* tp = tile + u * (64 * 65);
#pragma unroll
            for (int j = 0; j < 4; ++j) { a[j] = tp[(kc + j) * 65 + nn]; b[j] = tp[(kc + 4 + j) * 65 + nn]; }
            *(u32x4*)(dst + (size_t)rowmap(mode, n0 + nn) * ldd + koff + k0 + kc) = pack8(a, b); }
        __syncthreads();
    }
}

__device__ __forceinline__ void filter_features(const Ctx cx, LAS float* sm, const float* fw1, const float* fb1, const float* ff1, const float* fw2, const float* fb2, const float* ff2, int L, bf16_t* Hfb) {
    const int tid = cx.tid, tt = tid >> 6, j = tid & 63;
    LAS float* zf = sm; LAS float* h1s = sm + 8 * 36;
    const float b1 = fb1[j], f1 = ff1[j], b2 = fb2[j], f2 = ff2[j];
    for (int t0 = cx.bid * 8; t0 < L; t0 += cx.nblk * 8) {
        const int t = t0 + tt;
        if (j < 33) { float z;
            if (j == 0) z = (float)t / (float)(L - 1);
            else { const int k = (j - 1) & 15; const float band = 1e-4f + (float)k * ((15.0f - 1e-4f) / 15.0f);
                double rv = (double)band * (double)t / (double)L; rv -= floor(rv); const float r = (float)rv;
                z = (j <= 16) ? __builtin_amdgcn_cosf(r) : -__builtin_amdgcn_sinf(r); }
            zf[tt * 36 + j] = z; }
        __syncthreads();
        { float a = b1; for (int i = 0; i < 33; ++i) a += zf[tt * 36 + i] * fw1[i * 64 + j];
          h1s[tt * 64 + j] = __builtin_amdgcn_sinf(f1 * a * 0.15915494309189535f); }
        __syncthreads();
        { float a = b2; for (int i = 0; i < 64; ++i) a += h1s[tt * 64 + i] * fw2[i * 64 + j];
          Hfb[(size_t)t * 64 + j] = (bf16_t)(cvt_pk_bf16(__builtin_amdgcn_sinf(f2 * a * 0.15915494309189535f), 0.f) & 0xffffu); }
        __syncthreads();
    }
}

__device__ __forceinline__ int PX(int i) { const int h = i >> 5; return i + h + (h << 2); }
__device__ __forceinline__ f32x2 cmul(f32x2 a, f32x2 b) { return (f32x2){a.x * b.x - a.y * b.y, a.x * b.y + a.y * b.x}; }
__device__ __forceinline__ f32x2 cis_rev(float rev) { return (f32x2){__builtin_amdgcn_cosf(rev), __builtin_amdgcn_sinf(rev)}; }
__device__ __forceinline__ f32x2 rot8(f32x2 v, int k, bool inv) {
    const float c = 0.70710678118654752f;
    if (!inv) { switch (k) { case 1: return (f32x2){c * (v.x + v.y), c * (v.y - v.x)}; case 2: return (f32x2){v.y, -v.x}; case 3: return (f32x2){c * (v.y - v.x), -c * (v.x + v.y)}; default: return v; } }
    else      { switch (k) { case 1: return (f32x2){c * (v.x - v.y), c * (v.x + v.y)}; case 2: return (f32x2){-v.y, v.x}; case 3: return (f32x2){-c * (v.x + v.y), c * (v.x - v.y)}; default: return v; } }
}
template <int LOGR> __device__ __forceinline__ void dif_bfly(f32x2 (&v)[1 << LOGR], int r, int logm) {
    constexpr int R = 1 << LOGR;
    f32x2 W = cis_rev(-(float)r * __uint_as_float((unsigned)(126 - logm) << 23));
#pragma unroll
    for (int s = 0; s < LOGR; ++s) {
        const int half = R >> (s + 1);
#pragma unroll
        for (int q = 0; q < R; ++q) if ((q & half) == 0) {
            const int qq = q & (half - 1);
            const f32x2 a = v[q], b = v[q + half];
            v[q] = a + b;
            v[q + half] = rot8(cmul(a - b, W), (qq << s) * (8 / R), false);
        }
        W = cmul(W, W);
    }
}
template <int LOGR> __device__ __forceinline__ void dit_bfly(f32x2 (&v)[1 << LOGR], int r, int logm0) {
    constexpr int R = 1 << LOGR;
    f32x2 Wt[LOGR];
    Wt[LOGR - 1] = cis_rev((float)r * __uint_as_float((unsigned)(127 - (logm0 + LOGR)) << 23));
#pragma unroll
    for (int s = LOGR - 2; s >= 0; --s) Wt[s] = cmul(Wt[s + 1], Wt[s + 1]);
#pragma unroll
    for (int s = 0; s < LOGR; ++s) {
        const int half = 1 << s;
        const f32x2 W = Wt[s];
#pragma unroll
        for (int q = 0; q < R; ++q) if ((q & half) == 0) {
            const int qq = q & (half - 1);
            const f32x2 a = v[q], b = rot8(cmul(v[q + half], W), qq * (4 >> s), true);
            v[q] = a + b; v[q + half] = a - b;
        }
    }
}
template <int LOGR> __device__ __forceinline__ void dif_pass(const Ctx cx, LAS f32x2* X, int logN, int logm) {
    constexpr int R = 1 << LOGR;
    const int logsub = logm - LOGR + 1, sub = 1 << logsub, ngroups = 1 << (logN - LOGR), psub = PX(sub);
#pragma unroll 2
    for (int g = cx.tid; g < ngroups; g += 512) {
        const int r = g & (sub - 1), blk = g >> logsub, base = (blk << (logm + 1)) + r, pb = PX(base);
        f32x2 v[R];
#pragma unroll
        for (int q = 0; q < R; ++q) v[q] = X[pb + ((sub >= 32) ? q * psub : (q * sub + 5 * ((q * sub) >> 5)))];
        dif_bfly<LOGR>(v, r, logm);
#pragma unroll
        for (int q = 0; q < R; ++q) X[pb + ((sub >= 32) ? q * psub : (q * sub + 5 * ((q * sub) >> 5)))] = v[q];
    }
}
template <int LOGR> __device__ __forceinline__ void dit_pass(const Ctx cx, LAS f32x2* X, int logN, int logm0) {
    constexpr int R = 1 << LOGR;
    const int sub = 1 << logm0, ngroups = 1 << (logN - LOGR), psub = PX(sub);
#pragma unroll 2
    for (int g = cx.tid; g < ngroups; g += 512) {
        const int r = g & (sub - 1), blk = g >> logm0, base = (blk << (logm0 + LOGR)) + r, pb = PX(base);
        f32x2 v[R];
#pragma unroll
        for (int q = 0; q < R; ++q) v[q] = X[pb + ((sub >= 32) ? q * psub : (q * sub + 5 * ((q * sub) >> 5)))];
        dit_bfly<LOGR>(v, r, logm0);
#pragma unroll
        for (int q = 0; q < R; ++q) X[pb + ((sub >= 32) ? q * psub : (q * sub + 5 * ((q * sub) >> 5)))] = v[q];
    }
}
__device__ __forceinline__ void fft_fwd(const Ctx cx, LAS f32x2* X, int logN) {
    int n8 = 0, n4 = 0; for (int rem = logN; rem > 0;) { if (rem > 4 || rem == 3) { ++n8; rem -= 3; } else { ++n4; rem -= 2; } }
    int logm = logN - 1;
    for (int i = 0; i < n8; ++i) { dif_pass<3>(cx, X, logN, logm); logm -= 3; __syncthreads(); }
    for (int i = 0; i < n4; ++i) { dif_pass<2>(cx, X, logN, logm); logm -= 2; __syncthreads(); }
}
__device__ __forceinline__ void fft_inv(const Ctx cx, LAS f32x2* X, int logN) {
    int n8 = 0, n4 = 0; for (int rem = logN; rem > 0;) { if (rem > 4 || rem == 3) { ++n8; rem -= 3; } else { ++n4; rem -= 2; } }
    int lm = 0;
    for (int i = 0; i < n4; ++i) { dit_pass<2>(cx, X, logN, lm); lm += 2; __syncthreads(); }
    for (int i = 0; i < n8; ++i) { dit_pass<3>(cx, X, logN, lm); lm += 3; __syncthreads(); }
}
__device__ __forceinline__ int fft_partner(int pp) { if (pp == 0) return 0; const int j = 31 - __builtin_clz(pp); return (3 << j) - 1 - pp; }

__device__ __forceinline__ void filter_spectrum(const Ctx cx, LAS unsigned char* lds, const bf16_t* W3T, const float* hbias, int L, int logN2, const bf16_t* Hfb, f32x2* FS) {
    const int tid = cx.tid, N2 = 2 * L, wid = tid >> 6, lane = tid & 63, fr = lane & 15, fq = lane >> 4;
    LAS f32x2* X = (LAS f32x2*)lds; LAS float* red = (LAS float*)(lds + LDS_X_BYTES);
    const float min_decay = -3.0701134573253944f, max_decay = -15.350567286626972f;
    const float tscale = 1.0f / (float)(L - 1);
    for (int c = cx.bid; c < 1024; c += cx.nblk) {
        bf16x8 wf0 = (bf16x8){0, 0, 0, 0, 0, 0, 0, 0}, wf1 = wf0;
        if (fr < 4) { wf0 = *(const bf16x8*)(W3T + (size_t)c * 256 + fr * 64 + fq * 8); wf1 = *(const bf16x8*)(W3T + (size_t)c * 256 + fr * 64 + 32 + fq * 8); }
        if (tid == 0) X[PX(L)] = (f32x2){0.f, 0.f};
        const float delta = fabsf(min_decay + (max_decay - min_decay) * ((float)c / 1023.0f));
        float ss0 = 0.f, ss1 = 0.f;
#pragma unroll 8
        for (int tl = wid; tl < (L >> 4); tl += 8) {
            const int n = (tl << 4) + fr;
            const bf16x8 h0 = *(const bf16x8*)(Hfb + (size_t)n * 64 + fq * 8), h1 = *(const bf16x8*)(Hfb + (size_t)n * 64 + 32 + fq * 8);
            f32x4 acc = (f32x4){0.f, 0.f, 0.f, 0.f};
            acc = __builtin_amdgcn_mfma_f32_16x16x32_bf16(wf0, h0, acc, 0, 0, 0);
            acc = __builtin_amdgcn_mfma_f32_16x16x32_bf16(wf1, h1, acc, 0, 0, 0);
            if (fq == 0) {
                const float dec = __expf(-((float)n * tscale) * delta);
                const float f00 = acc[0] * dec, f01 = acc[1] * dec, f10 = acc[2] * dec, f11 = acc[3] * dec;
                if (n == 0) { const f32x2 v = (f32x2){f00 + f01, f10 + f11}; X[PX(0)] = v; ss0 += v.x * v.x; ss1 += v.y * v.y; }
                else { X[PX(n)] = (f32x2){f00, f10}; X[PX(N2 - n)] = (f32x2){f01, f11}; ss0 += f00 * f00 + f01 * f01; ss1 += f10 * f10 + f11 * f11; }
            }
        }
        ss0 = wave_sum(tid, ss0); ss1 = wave_sum(tid, ss1);
        if (lane == 0) { red[wid * 2] = ss0; red[wid * 2 + 1] = ss1; }
        __syncthreads();
        float t0 = 0.f, t1 = 0.f;
#pragma unroll
        for (int w = 0; w < 8; ++w) { t0 += red[w * 2]; t1 += red[w * 2 + 1]; }
        const float sc = 0.5f / (float)N2; const f32x2 rs = (f32x2){rsqrtf(t0 + 1e-6f) * sc, rsqrtf(t1 + 1e-6f) * sc};
        for (int n = tid; n < N2; n += 512) X[PX(n)] *= rs;
        __syncthreads();
        fft_fwd(cx, X, logN2);
        f32x2* dst = FS + (size_t)c * N2;
        const f32x2 dbias = (f32x2){hbias[c] * sc, hbias[1024 + c] * sc};
        for (int n = tid; n < N2; n += 512) dst[n] = X[PX(n)] + dbias;
        __syncthreads();
    }
}

__device__ __forceinline__ float sconv(const bf16_t* row, int n, int L, float w0, float w1, float w2, float b) {
    const float um = n > 0 ? bf2f(row[n - 1]) : 0.f, u0 = bf2f(row[n]), up = (n + 1 < L) ? bf2f(row[n + 1]) : 0.f;
    return um * w0 + u0 * w1 + up * w2 + b;
}
template <int GW> __device__ __forceinline__ void convN(const bf16_t* row, int n0, int L, float w0, float w1, float w2, float b, float (&o)[GW]) {
    float u[GW + 2];
    { const int il = n0 > 0 ? n0 - 1 : 0, ir = (n0 + GW < L) ? n0 + GW : n0;
      const float ul = bf2f(row[il]), ur = bf2f(row[ir]); u[0] = n0 > 0 ? ul : 0.f; u[GW + 1] = (n0 + GW < L) ? ur : 0.f; }
    if (GW == 4) { const u32x2 w = *(const u32x2*)(row + n0); u[1] = __uint_as_float(w.x << 16); u[2] = __uint_as_float(w.x & 0xffff0000u); u[3] = __uint_as_float(w.y << 16); u[GW] = __uint_as_float(w.y & 0xffff0000u); }
    else { const unsigned w = *(const unsigned*)(row + n0); u[1] = __uint_as_float(w << 16); u[2] = __uint_as_float(w & 0xffff0000u); }
#pragma unroll
    for (int i = 0; i < GW; ++i) o[i] = u[i] * w0 + u[i + 1] * w1 + u[i + 2] * w2 + b;
}
template <int GW> __device__ __forceinline__ void hyena_p1(int tid, LAS f32x2* X, int logN2, int L, int order, const bf16_t* rowA, const bf16_t* rowB, float w0, float w1, float w2, float wb, f32x2* Z1) {
    const int lsub = logN2 - 3, sub = 1 << lsub;
    for (int t = tid; t < (sub / GW); t += 512) {
        const int r0 = t * GW, pb0 = PX(r0), psub = PX(sub);
        f32x2 v[GW][8];
#pragma unroll
        for (int q = 0; q < 4; ++q) { const int n0 = r0 + q * sub;
            if (order == 0) { float a[GW], b[GW]; convN<GW>(rowA, n0, L, w0, w1, w2, wb, a); convN<GW>(rowB, n0, L, w0, w1, w2, wb, b);
#pragma unroll
                for (int i = 0; i < GW; ++i) v[i][q] = (f32x2){a[i], b[i]};
 }
            else {
#pragma unroll
                for (int i = 0; i < GW / 2; ++i) { const f32x4 z = ((const f32x4*)(Z1 + n0))[i]; v[2 * i][q] = (f32x2){z[0], z[1]}; v[2 * i + 1][q] = (f32x2){z[2], z[3]}; } } }
#pragma unroll
        for (int i = 0; i < GW; ++i) {
#pragma unroll
            for (int q = 4; q < 8; ++q) v[i][q] = (f32x2){0.f, 0.f};
            dif_bfly<3>(v[i], r0 + i, logN2 - 1); }
#pragma unroll
        for (int q = 0; q < 8; ++q)
#pragma unroll
            for (int i = 0; i < GW; ++i) X[pb0 + i + q * psub] = v[i][q];
    }
}
template <int GW> __device__ __forceinline__ void hyena_p9(int tid, LAS f32x2* X, int logN2, int L, int order, const bf16_t* rowA, const bf16_t* rowB, float w0, float w1, float w2, float wb, float hb, f32x2* Z1, bf16_t* outA, bf16_t* outB) {
    const int lsub = logN2 - 3, sub = 1 << lsub;
    for (int t = tid; t < (sub / GW); t += 512) {
        const int r0 = t * GW, pb0 = PX(r0), psub = PX(sub);
        float xga[4][GW], xgb[4][GW];
#pragma unroll
        for (int q = 0; q < 4; ++q) { convN<GW>(rowA, r0 + q * sub, L, w0, w1, w2, wb, xga[q]); convN<GW>(rowB, r0 + q * sub, L, w0, w1, w2, wb, xgb[q]); }
        f32x2 v[GW][8];
#pragma unroll
        for (int q = 0; q < 8; ++q)
#pragma unroll
            for (int i = 0; i < GW; ++i) v[i][q] = X[pb0 + i + q * psub];
#pragma unroll
        for (int i = 0; i < GW; ++i) dit_bfly<3>(v[i], r0 + i, lsub);
#pragma unroll
        for (int q = 0; q < 4; ++q) { const int n0 = r0 + q * sub;
            f32x2 zo[GW];
#pragma unroll
            for (int i = 0; i < GW; ++i) zo[i] = (f32x2){xga[q][i] * v[i][q].x, xgb[q][i] * v[i][q].y};
            if (order == 0) {
#pragma unroll
                for (int i = 0; i < GW; ++i) v[i][q] = zo[i]; }
            else if (GW == 4) { u32x2 wa, wb2; wa.x = cvt_pk_bf16(zo[0].x, zo[1].x); wa.y = cvt_pk_bf16(zo[2].x, zo[GW - 1].x); wb2.x = cvt_pk_bf16(zo[0].y, zo[1].y); wb2.y = cvt_pk_bf16(zo[2].y, zo[GW - 1].y);
                *(u32x2*)(outA + n0) = wa; *(u32x2*)(outB + n0) = wb2; }
            else { *(unsigned*)(outA + n0) = cvt_pk_bf16(zo[0].x, zo[1].x); *(unsigned*)(outB + n0) = cvt_pk_bf16(zo[0].y, zo[1].y); }
        }
        if (order == 0) {
#pragma unroll
            for (int i = 0; i < GW; ++i) {
#pragma unroll
                for (int q = 4; q < 8; ++q) v[i][q] = (f32x2){0.f, 0.f};
                dif_bfly<3>(v[i], r0 + i, logN2 - 1); }
#pragma unroll
            for (int q = 0; q < 8; ++q)
#pragma unroll
                for (int i = 0; i < GW; ++i) X[pb0 + i + q * psub] = v[i][q];
        }
    }
}
__device__ __forceinline__ void hyena_phase(const Ctx cx, LAS unsigned char* lds, const float* conv_w, const float* conv_b, const float* hbias, int L, int logN2, int nbatch, const f32x2* FS, const bf16_t* UH, bf16_t* BT, f32x2* Z1) {
    const int tid = cx.tid, N2 = 2 * L;
    LAS f32x2* X = (LAS f32x2*)lds;
    int n8 = 0, n4 = 0; for (int rem = logN2; rem > 0;) { if (rem > 4 || rem == 3) { ++n8; rem -= 3; } else { ++n4; rem -= 2; } }
    const int lsub = logN2 - 3, sub = 1 << lsub;
    for (int c = cx.bid; c < 1024; c += cx.nblk) {
        const f32x2* FSc = FS + (size_t)c * N2;
        const float v0 = conv_w[c], v1 = conv_w[3072 + c], v2 = conv_w[6144 + c], v3 = conv_b[c];
        const float bias0 = hbias[c], bias1 = hbias[1024 + c];
        const bf16_t* uv = UH + (size_t)c * NTG;
        for (int pair = 0; pair < nbatch / 2; ++pair) {
            const int tA = (2 * pair) * L, tB = tA + L;
            for (int order = 0; order < 2; ++order) {
                const int gch = (order + 1) * 1024 + c;
                const bf16_t* ug = UH + (size_t)gch * NTG;
                const float g0 = conv_w[gch], g1 = conv_w[3072 + gch], g2 = conv_w[6144 + gch], g3 = conv_b[gch];
                const float hb = order ? bias1 : bias0;
                if (order == 0) {
                    if (logN2 == 14) hyena_p1<4>(tid, X, logN2, L, 0, uv + tA, uv + tB, v0, v1, v2, v3, Z1);
                    else             hyena_p1<2>(tid, X, logN2, L, 0, uv + tA, uv + tB, v0, v1, v2, v3, Z1);
                    __syncthreads(); }
                { int logm = logN2 - 4;
                  for (int i = 1; i < n8; ++i) { dif_pass<3>(cx, X, logN2, logm); logm -= 3; __syncthreads(); }
                  for (int i = 0; i < n4 - 1; ++i) { dif_pass<2>(cx, X, logN2, logm); logm -= 2; __syncthreads(); } }
#pragma unroll 2
                for (int g = tid; g < (N2 >> 2); g += 512) {
                    const int base = g << 2, pbase = PX(base);
                    f32x2 v[4];
#pragma unroll
                    for (int q = 0; q < 4; ++q) v[q] = X[pbase + q];
                    const int pb = base ? ((3 << (31 - __builtin_clz(base))) - 4 - base) : 0;
                    const f32x4 a01 = *(const f32x4*)(FSc + base), a23 = *(const f32x4*)(FSc + base + 2);
                    const f32x4 b01 = *(const f32x4*)(FSc + pb), b23 = *(const f32x4*)(FSc + pb + 2);
                    { f32x2 a = v[0], b = v[2]; v[0] = a + b; v[2] = a - b; a = v[1]; b = v[3]; v[1] = a + b; v[3] = rot8(a - b, 2, false);
                      a = v[0]; b = v[1]; v[0] = a + b; v[1] = a - b; a = v[2]; b = v[3]; v[2] = a + b; v[3] = a - b; }
                    f32x2 A[4], Bn[4];
                    A[0] = (f32x2){a01[0], a01[1]}; A[1] = (f32x2){a01[2], a01[3]}; A[2] = (f32x2){a23[0], a23[1]}; A[3] = (f32x2){a23[2], a23[3]};
                    if (base) { Bn[0] = (f32x2){b23[2], b23[3]}; Bn[1] = (f32x2){b23[0], b23[1]}; Bn[2] = (f32x2){b01[2], b01[3]}; Bn[3] = (f32x2){b01[0], b01[1]}; }
                    else      { Bn[0] = (f32x2){b01[0], b01[1]}; Bn[1] = (f32x2){b01[2], b01[3]}; Bn[2] = (f32x2){b23[2], b23[3]}; Bn[3] = (f32x2){b23[0], b23[1]}; }
#pragma unroll
                    for (int q = 0; q < 4; ++q) { const f32x2 Hq = order ? (f32x2){A[q].y + Bn[q].y, Bn[q].x - A[q].x} : (f32x2){A[q].x + Bn[q].x, A[q].y - Bn[q].y};
                        v[q] = cmul(v[q], Hq); }
                    { f32x2 a = v[0], b = v[1]; v[0] = a + b; v[1] = a - b; a = v[2]; b = v[3]; v[2] = a + b; v[3] = a - b;
                      a = v[0]; b = v[2]; v[0] = a + b; v[2] = a - b; a = v[1]; b = rot8(v[3], 2, true); v[1] = a + b; v[3] = a - b; }
#pragma unroll
                    for (int q = 0; q < 4; ++q) X[pbase + q] = v[q];
                }
                __syncthreads();
                { int lm = 2;
                  for (int i = 1; i < n4; ++i) { dit_pass<2>(cx, X, logN2, lm); lm += 2; __syncthreads(); }
                  for (int i = 0; i < n8 - 1; ++i) { dit_pass<3>(cx, X, logN2, lm); lm += 3; __syncthreads(); } }
                if (logN2 == 14) hyena_p9<4>(tid, X, logN2, L, order, ug + tA, ug + tB, g0, g1, g2, g3, hb, Z1, BT + (size_t)c * NTG + tA, BT + (size_t)c * NTG + tB);
                else             hyena_p9<2>(tid, X, logN2, L, order, ug + tA, ug + tB, g0, g1, g2, g3, hb, Z1, BT + (size_t)c * NTG + tA, BT + (size_t)c * NTG + tB);
                __syncthreads();
            }
        }
    }
}

template <int HW> __device__ __forceinline__ void pool_item(const bf16_t* UP, bf16_t* PL, int L, int tok, int ch0) {
    const int t = tok & (L - 1);
    const bf16_t* basep = UP + (size_t)(tok - t) * 1024 + ch0;
    u32x4 w[2 * HW];
#pragma unroll
    for (int i = 0; i < 2 * HW; ++i) { const int s = t - HW + i; const int sc = s < 0 ? 0 : (s >= L ? L - 1 : s); w[i] = *(const u32x4*)(basep + (size_t)sc * 1024); }
    f32x4 s0 = (f32x4){0.f, 0.f, 0.f, 0.f}, s1 = s0;
#pragma unroll
    for (int i = 0; i < 2 * HW; ++i) { const int s = t - HW + i; f32x4 a, b; unpack8(w[i], a, b); const float m = (s >= 0 && s < L) ? 1.0f : 0.0f; s0 += a * m; s1 += b * m; }
    f32x4 a, b; unpack8(w[HW], a, b);
    const int lo = (t - HW) < 0 ? 0 : (t - HW), hi = (t + HW) > L ? L : (t + HW);
    const float inv = 1.0f / (float)(hi - lo);
    *(u32x4*)(PL + (size_t)tok * 2048 + ch0) = pack8(s0 * inv - a, s1 * inv - b);
}
__device__ __forceinline__ void pool_phase(const Ctx cx, const bf16_t* UP, bf16_t* PL, int L) {
    const int total = NTG * 128;
    for (int idx = cx.bid * 512 + cx.tid; idx < total; idx += cx.nblk * 512) {
        const int grp = idx / (NTG * 32), rem = idx - grp * (NTG * 32), tok = rem >> 5, ch0 = grp * 256 + ((rem & 31) << 3);
        switch (grp) {
            case 0: pool_item<1>(UP, PL, L, tok, ch0); break;
            case 1: pool_item<2>(UP, PL, L, tok, ch0); break;
            case 2: pool_item<4>(UP, PL, L, tok, ch0); break;
            default: pool_item<8>(UP, PL, L, tok, ch0); break;
        }
    }
}

__device__ __forceinline__ void bt_transpose(const Ctx cx, LAS unsigned short* tile, const bf16_t* BT, bf16_t* AB) {
    constexpr int TB = 4;
    const int tid = cx.tid;
    constexpr int NTT = NTG / 64;
    for (int t4 = cx.bid * TB; t4 < 16 * NTT; t4 += cx.nblk * TB) {
        u32x4 w[TB];
#pragma unroll
        for (int u = 0; u < TB; ++u) { const int t = t4 + u, c0 = (t / NTT) << 6, k0 = (t % NTT) << 6; const int r = tid >> 3, cc = (tid & 7) << 3;
            w[u] = *(const u32x4*)(BT + (size_t)(c0 + r) * NTG + k0 + cc); }
#pragma unroll
        for (int u = 0; u < TB; ++u) { const int r = tid >> 3, cc = (tid & 7) << 3; LAS unsigned short* d = tile + u * (64 * 72) + r * 72 + cc;
            d[0] = (unsigned short)(w[u].x & 0xffff); d[1] = (unsigned short)(w[u].x >> 16); d[2] = (unsigned short)(w[u].y & 0xffff); d[3] = (unsigned short)(w[u].y >> 16);
            d[4] = (unsigned short)(w[u].z & 0xffff); d[5] = (unsigned short)(w[u].z >> 16); d[6] = (unsigned short)(w[u].w & 0xffff); d[7] = (unsigned short)(w[u].w >> 16); }
        __syncthreads();
#pragma unroll
        for (int u = 0; u < TB; ++u) { const int t = t4 + u, c0 = (t / NTT) << 6, k0 = (t % NTT) << 6; const int tk = tid >> 3, ch = (tid & 7) << 3; const LAS unsigned short* tp = tile + u * (64 * 72); u32x4 o;
            o.x = (unsigned)tp[(ch + 0) * 72 + tk] | ((unsigned)tp[(ch + 1) * 72 + tk] << 16); o.y = (unsigned)tp[(ch + 2) * 72 + tk] | ((unsigned)tp[(ch + 3) * 72 + tk] << 16);
            o.z = (unsigned)tp[(ch + 4) * 72 + tk] | ((unsigned)tp[(ch + 5) * 72 + tk] << 16); o.w = (unsigned)tp[(ch + 6) * 72 + tk] | ((unsigned)tp[(ch + 7) * 72 + tk] << 16);
            *(u32x4*)(AB + (size_t)(k0 + tk) * 2048 + 1024 + c0 + ch) = o; }
        __syncthreads();
    }
}

template <bool OUTF32> __device__ __forceinline__ void rmsnorm_phase(const Ctx cx, const float* x, const float* g, void* outp, int nrows) {
    constexpr int RB = 4;
    const int wave = cx.tid >> 6, lane = cx.tid & 63;
    const int nw = cx.nblk * 8;
    for (int row0 = (cx.bid * 8 + wave) * RB; row0 < nrows; row0 += nw * RB) {
        f32x4 v[RB][8];
#pragma unroll
        for (int rb = 0; rb < RB; ++rb) { const f32x4* xr = (const f32x4*)(x + (size_t)(row0 + rb) * DM);
#pragma unroll
            for (int i = 0; i < 8; ++i) v[rb][i] = __builtin_nontemporal_load(xr + lane + 64 * i); }
        float rs[RB];
#pragma unroll
        for (int rb = 0; rb < RB; ++rb) { float ss = 0.f;
#pragma unroll
            for (int i = 0; i < 8; ++i) ss += v[rb][i][0] * v[rb][i][0] + v[rb][i][1] * v[rb][i][1] + v[rb][i][2] * v[rb][i][2] + v[rb][i][3] * v[rb][i][3];
            ss = wave_sum(cx.tid, ss); rs[rb] = rsqrtf(ss * (1.0f / DM) + 1e-6f); }
#pragma unroll
        for (int i = 0; i < 8; ++i) { const f32x4 gv = ((const f32x4*)g)[lane + 64 * i];
#pragma unroll
            for (int rb = 0; rb < RB; ++rb) { const f32x4 o = v[rb][i] * rs[rb] * gv;
                if (OUTF32) __builtin_nontemporal_store(o, (f32x4*)((float*)outp + (size_t)(row0 + rb) * DM) + lane + 64 * i);
                else { u32x2 w; w.x = cvt_pk_bf16(o[0], o[1]); w.y = cvt_pk_bf16(o[2], o[3]); ((u32x2*)((bf16_t*)outp + (size_t)(row0 + rb) * DM))[lane + 64 * i] = w; } } }
    }
}

#define XB_TMO      128
#define XB_XCNT(j)  (256  + 64 * (j))
#define XB_XSUB(j)  (1280 + 64 * (j))
#define XB_XGEN(j)  (2304 + 64 * (j))
#define XB_TOP      3328
#define XB_TOPGEN   3392
#define XCD_BAR_WORDS 3456
#define XB_SPIN_CAP (1u << 18)
__device__ __forceinline__ unsigned xb_ld(unsigned* p)              { return __hip_atomic_load(p, __ATOMIC_RELAXED, __HIP_MEMORY_SCOPE_AGENT); }
__device__ __forceinline__ unsigned xb_add(unsigned* p, unsigned v) { return __hip_atomic_fetch_add(p, v, __ATOMIC_RELAXED, __HIP_MEMORY_SCOPE_AGENT); }
__device__ __forceinline__ unsigned xb_xcc_id() { return (unsigned)__builtin_amdgcn_s_getreg((3 << 11) | 20) & 0xFu; }
#define XB_SPIN(cond, bar) do { unsigned _sp = 0; while (cond) { __builtin_amdgcn_s_sleep(1); \
    if ((++_sp & 255u) == 0u) { if (xb_ld(&(bar)[XB_TMO])) break; if (_sp > XB_SPIN_CAP) { atomicAdd(&(bar)[XB_TMO], 1u); break; } } } } while (0)
__device__ __forceinline__ void xcd_barrier_complete(unsigned* bar, unsigned x, unsigned G, unsigned& nloc, unsigned& nx) {
    unsigned sum, cnt, mine, sp = 0u;
    for (;;) {
        sum = 0u; cnt = 0u; mine = 0u;
#pragma unroll
        for (unsigned j = 0; j < 16; ++j) { const unsigned c = xb_ld(&bar[XB_XCNT(j)]); sum += c; cnt += (c > 0u) ? 1u : 0u; mine = (j == x) ? c : mine; }
        if (sum == G) break;
        __builtin_amdgcn_s_sleep(1);
        if ((++sp & 255u) == 0u) { if (xb_ld(&bar[XB_TMO])) break; if (sp > XB_SPIN_CAP) { atomicAdd(&bar[XB_TMO], 1u); break; } }
    }
    nloc = mine > 0u ? mine : 1u; nx = cnt > 0u ? cnt : 1u;
}
__device__ __forceinline__ void xcd_barrier(unsigned* bar, volatile LAS unsigned* st, bool leader, unsigned G) {
    asm volatile("s_waitcnt vmcnt(0)" ::: "memory");
    __syncthreads();
    if (leader) {
        __builtin_amdgcn_s_waitcnt(0);
        const unsigned x = xb_xcc_id();
        unsigned nloc = st[0], nx = st[1];
        if (nloc == 0u) { xcd_barrier_complete(bar, x, G, nloc, nx); st[0] = nloc; st[1] = nx; }
        const unsigned old = xb_add(&bar[XB_XSUB(x)], 1u);
        const unsigned gen = old / nloc;
        if (old + 1u == (gen + 1u) * nloc) {
            __builtin_amdgcn_fence(__ATOMIC_RELEASE, "agent");
            asm volatile("s_waitcnt vmcnt(0)" ::: "memory");
            const unsigned og = xb_add(&bar[XB_TOP], 1u);
            const unsigned tg = og / nx;
            if (og + 1u == (tg + 1u) * nx) xb_add(&bar[XB_TOPGEN], 1u);
            else XB_SPIN(xb_ld(&bar[XB_TOPGEN]) == tg, bar);
            __builtin_amdgcn_fence(__ATOMIC_ACQUIRE, "agent");
            xb_add(&bar[XB_XGEN(x)], 1u);
            asm volatile("s_waitcnt vmcnt(0)" ::: "memory");
        } else {
            XB_SPIN(xb_ld(&bar[XB_XGEN(x)]) == gen, bar);
            __builtin_amdgcn_fence(__ATOMIC_ACQUIRE, "agent");
            asm volatile("s_waitcnt vmcnt(0)" ::: "memory");
        }
    }
    __syncthreads();
}

typedef const __attribute__((address_space(4))) Params* PP;
__device__ __forceinline__ const float* grp_x(PP p, int g) { return g == 0 ? p->x_prompt : p->x_sample; }

__device__ __forceinline__ void run_phase(const Ctx cx, PP p, int ph, LAS unsigned char* lds) {
    unsigned char* ws = p->ws;
    bf16_t* WinT = (bf16_t*)(ws + WS_WIN); bf16_t* WpT = (bf16_t*)(ws + WS_WPOOL); bf16_t* WaT = (bf16_t*)(ws + WS_WA); bf16_t* WbT = (bf16_t*)(ws + WS_WB);
    bf16_t* WoT = (bf16_t*)(ws + WS_WO); bf16_t* WguT = (bf16_t*)(ws + WS_WGU); bf16_t* WdT = (bf16_t*)(ws + WS_WD);
    bf16_t* HF8 = (bf16_t*)(ws + WS_HF8); bf16_t* HF4 = (bf16_t*)(ws + WS_HF4); bf16_t* W3T = (bf16_t*)(ws + WS_W3T); f32x2* FS8 = (f32x2*)(ws + WS_FS8); f32x2* FS4 = (f32x2*)(ws + WS_FS4);
    f32x2* Z1 = (f32x2*)(ws + WS_Z1) + (size_t)cx.bid * 8192;
    bf16_t* H = (bf16_t*)(ws + WS_H); bf16_t* UP = (bf16_t*)(ws + WS_UP); bf16_t* G = (bf16_t*)(ws + WS_G); bf16_t* UH = (bf16_t*)(ws + WS_UH);
    bf16_t* PL = (bf16_t*)(ws + WS_PL); bf16_t* BT = (bf16_t*)(ws + WS_BT); bf16_t* AB = (bf16_t*)(ws + WS_AB); bf16_t* ACT = (bf16_t*)(ws + WS_ACT);
    if (EN(100) && ph == 0) {
        LAS float* tile = (LAS float*)lds;
        for (int job = 0; job < 7; ++job) {
            const float* s; int K, N, mode = 0, ldd = 0, koff = 0; bf16_t* d;
            switch (job) {
                case 0: s = p->w_in; K = 2048; N = 8192; d = WinT; mode = 1; break;
                case 1: s = p->w_a; K = 1024; N = 2048; d = UP; break;
                case 2: s = p->w_b; K = 1024; N = 2048; d = WaT; ldd = 2048; koff = 1024; break;
                case 3: s = p->w_out; K = 2048; N = 2048; d = WoT; break;
                case 4: s = p->w_gate; K = 2048; N = DFF; d = WguT; mode = 2; break;
                case 5: s = p->w_up; K = 2048; N = DFF; d = WguT; mode = 3; break;
                case 6: s = p->w_down; K = DFF; N = 2048; d = WdT; break;
                default: s = p->pool_w + (size_t)(job - 7) * 65536; K = 256; N = 256; d = WpT + (size_t)(job - 7) * 65536; break;
            }
            transpose_cvt(cx, tile, s, K, N, d, mode, ldd ? ldd : K, koff);
        }
        for (int idx = cx.bid * 512 + cx.tid; idx < 262144; idx += cx.nblk * 512)
            WpT[idx] = (bf16_t)(cvt_pk_bf16(p->pool_w[idx] * p->pool_scale[((idx >> 16) << 8) + (idx & 255)], 0.f) & 0xffffu);
        for (int idx = cx.bid * 512 + cx.tid; idx < 262144; idx += cx.nblk * 512)
            W3T[idx] = (bf16_t)(cvt_pk_bf16(p->filt_w3[(size_t)(idx & 63) * 4096 + ((idx >> 6) & 3) * 1024 + (idx >> 8)], 0.f) & 0xffffu);
        for (int v = 0; v < 2; ++v)
            filter_features(cx, (LAS float*)lds, p->filt_w1, p->filt_b1, p->filt_f1, p->filt_w2, p->filt_b2, p->filt_f2, v ? 4096 : 8192, v ? HF4 : HF8);
        return;
    }
    if (EN(101) && ph == 1) {
        { Gemm gf{UP, WpT, 2048, 1024, 256, 1024, 256, 256, WGM}; EpiRaw ef{WaT, 2048}; gemm_phase(cx, lds, gf, ef); }
        for (int v = 0; v < 2; ++v) filter_spectrum(cx, lds, W3T, p->hyena_bias, v ? 4096 : 8192, v ? 13 : 14, v ? HF4 : HF8, v ? FS4 : FS8);
        rmsnorm_phase<false>(cx, grp_x(p, 0), p->g_mix, H, NTG);
        return;
    }
    const int g = (ph - 2) / 9, k = (ph - 2) % 9;
    const int L = g == 0 ? 8192 : 4096, logN2 = g == 0 ? 14 : 13, nb = g == 0 ? 4 : 8;
    float* outg = p->out + (size_t)g * NTG * DM;
    switch (k) {
        case 0: if (EN(0)) {
            Gemm ga{H, WinT, NTG, 5120, 2048, 2048, 2048, 0, WGM}; EpiUPG ea{UP, G}; gemm_phase(cx, lds, ga, ea);
            Gemm gb{WinT + (size_t)5120 * 2048, H, 3072, NTG, 2048, 2048, 2048, 0, 6}; EpiRaw eb{UH, NTG}; gemm_phase(cx, lds, gb, eb);
        } break;
        case 1: if (EN(1)) {
            hyena_phase(cx, lds, p->conv_w, p->conv_b, p->hyena_bias, L, logN2, nb, g == 0 ? FS8 : FS4, UH, BT, Z1);
        } break;
        case 2: if (EN(2)) {
            pool_phase(cx, UP, AB, L);
            bt_transpose(cx, (LAS unsigned short*)lds, BT, AB);
        } break;
        case 3: if (EN(3)) {
            Gemm g1{AB, WaT, NTG, 2048, 2048, 2048, 2048, 0, WGM}; EpiMerge e1{G, H}; gemm_phase<EpiMerge, true>(cx, lds, g1, e1);
        } break;
        case 4: if (EN(4)) {
            Gemm go{H, WoT, NTG, 2048, 2048, 2048, 2048, 0, WGM}; EpiRes eo{grp_x(p, g), outg}; gemm_phase(cx, lds, go, eo);
        } break;
        case 5: if (EN(5)) rmsnorm_phase<false>(cx, outg, p->g_ffn, H, NTG); break;
        case 6: if (EN(6)) {
            Gemm gg{H, WguT, NTG, 11264, 2048, 2048, 2048, 0, 8}; EpiSwiGLU eg{ACT}; gemm_phase(cx, lds, gg, eg);
        } break;
        case 7: if (EN(7)) {
            Gemm gd{ACT, WdT, NTG, 2048, DFF, DFF, DFF, 0, WGM}; EpiRes ed{outg, outg}; gemm_phase(cx, lds, gd, ed);
        } break;
        case 8: if (EN(8)) {
            rmsnorm_phase<true>(cx, outg, p->g_final, outg, NTG);
            if (g + 1 < NGRP) rmsnorm_phase<false>(cx, grp_x(p, g + 1), p->g_mix, H, NTG);
        } break;
    }
}

__global__ __launch_bounds__(512, 2) void mega(Params p, int ph_lo, int ph_hi) {
    extern __shared__ __attribute__((aligned(16))) unsigned char smem_raw[];
    LAS unsigned char* lds = (LAS unsigned char*)smem_raw;
    const int wid_s = __builtin_amdgcn_readfirstlane((int)threadIdx.x >> 6);
    volatile LAS unsigned* bst = (volatile LAS unsigned*)(lds + LDS_X_BYTES + 1024);
    { unsigned* bar0 = (unsigned*)(((PP)__builtin_amdgcn_kernarg_segment_ptr())->ws + WS_BAR);
      if (threadIdx.x == 0) { bst[0] = 0u; bst[1] = 0u; (void)xb_add(&bar0[XB_XCNT(xb_xcc_id())], 1u); }
      __syncthreads(); }
    for (int ph = ph_lo; ph < ph_hi; ++ph) {
        int nrep = 1;
#ifdef PROBE_DUP
        if ((PROBE_DUP >= 100 && ph == PROBE_DUP - 100) || (PROBE_DUP < 100 && ph >= 2 && (ph - 2) % 9 == PROBE_DUP)) nrep = 2;
#endif
        for (int r = 0; r < nrep; ++r) {
            if (r) __syncthreads();
            PP pp = (PP)__builtin_amdgcn_kernarg_segment_ptr(); asm volatile("" : "+s"(pp));
            Ctx cx; cx.bid = blockIdx.x; cx.nblk = gridDim.x;
            { int lane_; asm volatile("v_mbcnt_lo_u32_b32 %0, -1, 0\n\tv_mbcnt_hi_u32_b32 %0, -1, %0" : "=&v"(lane_)); cx.tid = (wid_s << 6) | lane_; }
            asm volatile("" : "+v"(cx.tid)); asm volatile("" : "+s"(cx.bid)); asm volatile("" : "+s"(cx.nblk));
            run_phase(cx, pp, ph, lds);
        }
        if (ph + 1 < ph_hi) {
            if (ph_lo < 0) cg::this_grid().sync();
            { int lane_; asm volatile("v_mbcnt_lo_u32_b32 %0, -1, 0\n\tv_mbcnt_hi_u32_b32 %0, -1, %0" : "=&v"(lane_));
                   unsigned* bar = (unsigned*)(((PP)__builtin_amdgcn_kernarg_segment_ptr())->ws + WS_BAR);
                   xcd_barrier(bar, bst, wid_s == 0 && lane_ == 0, gridDim.x); }
        }
    }
}

extern "C" void kernel_launch(void* const* d_in, const int* in_sizes, int n_in, void* d_out, int out_size, void* d_ws, size_t ws_size, hipStream_t stream) {
    static int grid = 0;
    if (grid == 0) {
        if (n_in != 24 || ws_size < WS_END) { fprintf(stderr, "kernel_launch: unexpected n_in %d or ws_size %zu (< %zu)\n", n_in, ws_size, (size_t)WS_END); grid = -1; return; }
        int dev = 0, cus = 0, per_cu = 0;
        hipGetDevice(&dev); hipDeviceGetAttribute(&cus, hipDeviceAttributeMultiprocessorCount, dev);
        if (hipFuncSetAttribute((const void*)mega, hipFuncAttributeMaxDynamicSharedMemorySize, LDS_BYTES) != hipSuccess) { fprintf(stderr, "kernel_launch: hipFuncSetAttribute failed\n"); grid = -1; return; }
        if (hipOccupancyMaxActiveBlocksPerMultiprocessor(&per_cu, (const void*)mega, 512, LDS_BYTES) != hipSuccess || per_cu < 1) { fprintf(stderr, "kernel_launch: occupancy query says %d\n", per_cu); per_cu = 1; }
        (void)hipGetLastError();
        grid = cus; if (grid > 256) grid = 256; if (grid < 1) grid = 256;
    }
    if (grid < 0) return;
    Params p{};
    const float** pp = (const float**)&p;
    for (int i = 0; i < 24; ++i) pp[i] = (const float*)d_in[i];
    p.out = (float*)d_out; p.ws = (unsigned char*)d_ws;
    if (hipMemsetAsync((char*)d_ws + WS_BAR, 0, 16384, stream) != hipSuccess) { fprintf(stderr, "kernel_launch: memset of barrier words failed\n"); return; }
#if MULTI_LAUNCH
    for (int ph = 0; ph < NPH; ++ph) hipLaunchKernelGGL(mega, dim3(grid), dim3(512), LDS_BYTES, stream, p, ph, ph + 1);
#else
    int lo = 0, hi = NPH; void* args[] = {&p, &lo, &hi};
    hipError_t e = hipLaunchCooperativeKernel((const void*)mega, dim3(grid), dim3(512), args, LDS_BYTES, stream);
    if (e != hipSuccess) fprintf(stderr, "kernel_launch: cooperative launch failed: %s (grid %d)\n", hipGetErrorString(e), grid);
#endif
}
```
